# Optimizing an MI355X kernel written in HIP

```python
import math
import jax
import jax.numpy as jnp
from jax import lax
import numpy as np

D_MODEL = 1024
BATCH = 1
SEQ = 16384
DEPTH = 2

HEAD_DIM = 64
GDN_HEADS = 8
RWKV_HEADS = 8
HGRN_HEADS = 8
GDN_WIDTH = GDN_HEADS * HEAD_DIM
RWKV_WIDTH = RWKV_HEADS * HEAD_DIM
HGRN_EXPAND = 64
HGRN_FDIM = HGRN_HEADS * HGRN_EXPAND
HGRN_WIDTH = HGRN_HEADS * HEAD_DIM
D_MIX = GDN_WIDTH + RWKV_WIDTH + HGRN_WIDTH
CONV_WIDTH = 4
RWKV_DECAY_LORA = 64
RWKV_ICLR_LORA = 64
CHUNK = 64
NORM_EPS = 1e-6
L2_EPS = 1e-6
RWKV_GN_EPS = 64e-5

GDN_SPLIT = (GDN_WIDTH, GDN_WIDTH, GDN_WIDTH, GDN_HEADS, GDN_HEADS, GDN_WIDTH)
RWKV_SPLIT = (RWKV_WIDTH, RWKV_WIDTH, RWKV_WIDTH, RWKV_DECAY_LORA, RWKV_ICLR_LORA, RWKV_WIDTH)
HGRN_SPLIT = (HGRN_FDIM, HGRN_FDIM, HGRN_WIDTH, HGRN_WIDTH)
GDN_PROJ = sum(GDN_SPLIT)
RWKV_PROJ = sum(RWKV_SPLIT)
HGRN_PROJ = sum(HGRN_SPLIT)
PROJ_DIM = GDN_PROJ + RWKV_PROJ + HGRN_PROJ

kernel_name = 'hybrid_gdn_rwkv7_hgrn2_parallel_heads'

F32 = jnp.float32


def _split(t, sizes):
    out, start = [], 0
    for s in sizes:
        out.append(t[..., start:start + s])
        start += s
    return out


def _heads(t, h):
    return t.reshape(t.shape[:-1] + (h, t.shape[-1] // h))


def _rmsnorm(x, w):
    xf = x.astype(F32)
    y = xf * lax.rsqrt(jnp.mean(xf * xf, axis=-1, keepdims=True) + NORM_EPS)
    return (y * w.astype(F32)).astype(x.dtype)


def _l2norm(x):
    return x * lax.rsqrt(jnp.sum(x * x, axis=-1, keepdims=True) + L2_EPS)


def _causal_conv(x, w):
    return lax.conv_general_dilated(x, w[:, None, :], window_strides=(1,),
                                    padding=[(CONV_WIDTH - 1, 0)],
                                    dimension_numbers=('NWC', 'WIO', 'NWC'),
                                    feature_group_count=x.shape[-1])


def _token_shift(p, mu):
    prev = jnp.pad(p, ((0, 0), (1, 0), (0, 0)))[:, :-1]
    return p + mu * (prev - p)


def _gdn_chunked(q, k, v, beta, g):
    B, T, H, Dk = q.shape
    Dv = v.shape[-1]
    N = T // CHUNK

    def to_chunks(t):
        t = t.reshape((B, N, CHUNK, H) + t.shape[3:])
        return jnp.moveaxis(t, 3, 1)

    q, k, v, beta, g = (to_chunks(t) for t in (q, k, v, beta, g))
    gc = jnp.cumsum(g, axis=-1)
    causal = jnp.tril(jnp.ones((CHUNK, CHUNK), bool))
    strict = jnp.tril(jnp.ones((CHUNK, CHUNK), bool), -1)
    diff = gc[..., :, None] - gc[..., None, :]
    decay_mat = jnp.where(causal, jnp.exp(jnp.where(causal, diff, 0.0)), 0.0)
    k_beta = k * beta[..., None]
    A = jnp.where(strict, jnp.einsum('bhnik,bhnjk->bhnij', k_beta, k) * decay_mat, 0.0)
    eye = jnp.eye(CHUNK, dtype=A.dtype)
    Tm = lax.linalg.triangular_solve(eye + A, jnp.broadcast_to(eye, A.shape),
                                     left_side=True, lower=True)
    u = jnp.einsum('bhnij,bhnjd->bhnid', Tm, v * beta[..., None])
    w = jnp.einsum('bhnij,bhnjd->bhnid', Tm, k_beta * jnp.exp(gc)[..., None])
    qk = jnp.einsum('bhnik,bhnjk->bhnij', q, k) * decay_mat
    q_dec = q * jnp.exp(gc)[..., None]
    k_dec = k * jnp.exp(gc[..., -1:] - gc)[..., None]
    last = jnp.exp(gc[..., -1])

    def step(S, xs):
        u_n, w_n, qk_n, qd_n, kd_n, last_n = xs
        v_new = u_n - jnp.einsum('bhck,bhkv->bhcv', w_n, S)
        o = jnp.einsum('bhck,bhkv->bhcv', qd_n, S) + jnp.einsum('bhij,bhjv->bhiv', qk_n, v_new)
        S = S * last_n[..., None, None] + jnp.einsum('bhck,bhcv->bhkv', kd_n, v_new)
        return S, o

    xs = tuple(jnp.moveaxis(t, 2, 0) for t in (u, w, qk, q_dec, k_dec, last))
    S0 = jnp.zeros((B, H, Dk, Dv), q.dtype)
    _, o = lax.scan(step, S0, xs)
    o = jnp.moveaxis(o, 0, 2)
    return jnp.moveaxis(o, 1, 3).reshape(B, T, H, Dv)


def _gdn_branch(p, conv_w, a_log, dt_bias, norm_w):
    q, k, v, b_raw, a_raw, gate = _split(p, GDN_SPLIT)
    qkv = jax.nn.silu(_causal_conv(jnp.concatenate([q, k, v], axis=-1), conv_w.astype(F32)))
    q, k, v = _split(qkv, (GDN_WIDTH, GDN_WIDTH, GDN_WIDTH))
    q = _l2norm(_heads(q, GDN_HEADS)) * (HEAD_DIM ** -0.5)
    k = _l2norm(_heads(k, GDN_HEADS))
    v = _heads(v, GDN_HEADS)
    beta = jax.nn.sigmoid(b_raw)
    g = -jnp.exp(a_log.astype(F32)) * jax.nn.softplus(a_raw + dt_bias.astype(F32))
    o = _gdn_chunked(q, k, v, beta, g)
    o = _rmsnorm(o, norm_w).reshape(o.shape[:2] + (GDN_WIDTH,))
    return o * jax.nn.silu(gate)


def _rwkv7_scan(r, decay, k, v, kk, a):
    B, T, H, D = r.shape

    def step(S, xs):
        r_t, w_t, k_t, v_t, kk_t, a_t = xs
        sa = jnp.einsum('bhvk,bhk->bhv', S, -kk_t)
        S = (S * w_t[:, :, None, :] + sa[..., :, None] * (kk_t * a_t)[..., None, :]
             + v_t[..., :, None] * k_t[..., None, :])
        return S, jnp.einsum('bhvk,bhk->bhv', S, r_t)

    xs = tuple(jnp.moveaxis(t, 1, 0) for t in (r, decay, k, v, kk, a))
    S0 = jnp.zeros((B, H, D, D), r.dtype)
    _, o = lax.scan(step, S0, xs)
    return jnp.moveaxis(o, 0, 1)


def _rwkv7_branch(p, mu, w0, w_up, a0, a_up, k_k, k_a, r_k, ln_w, ln_b):
    p = _token_shift(p, mu.astype(F32))
    r, k, v, wd, ad, gate = _split(p, RWKV_SPLIT)
    w_raw = -jax.nn.softplus(-(w0.astype(F32) + jnp.tanh(wd) @ w_up.astype(F32))) - 0.5
    decay = jnp.exp(-jnp.exp(w_raw))
    a = jax.nn.sigmoid(a0.astype(F32) + ad @ a_up.astype(F32))
    kk = _l2norm(_heads(k * k_k.astype(F32), RWKV_HEADS))
    k = k * (1.0 + (a - 1.0) * k_a.astype(F32))
    rh, kh, vh = _heads(r, RWKV_HEADS), _heads(k, RWKV_HEADS), _heads(v, RWKV_HEADS)
    o = _rwkv7_scan(rh, _heads(decay, RWKV_HEADS), kh, vh, kk, _heads(a, RWKV_HEADS))
    mean = jnp.mean(o, axis=-1, keepdims=True)
    var = jnp.mean(jnp.square(o - mean), axis=-1, keepdims=True)
    o = (o - mean) * lax.rsqrt(var + RWKV_GN_EPS)
    o = o.reshape(o.shape[:2] + (RWKV_WIDTH,)) * ln_w.astype(F32) + ln_b.astype(F32)
    bonus = jnp.sum(rh * kh * r_k.astype(F32), axis=-1, keepdims=True) * vh
    o = o + bonus.reshape(o.shape)
    return o * jax.nn.silu(gate)


def _hgrn2_chunked(q, k, v, log_g):
    B, T, H, Dk = q.shape
    Dv = v.shape[-1]
    N = T // CHUNK

    def to_chunks(t):
        return t.reshape(B, N, CHUNK, H, t.shape[-1]).transpose(1, 0, 3, 2, 4)

    q, k, v, lg = (to_chunks(t) for t in (q, k, v, log_g))
    bcum = jnp.cumsum(lg, axis=3)
    causal = jnp.tril(jnp.ones((CHUNK, CHUNK), bool))[:, :, None]

    def step(S, xs):
        q_n, k_n, v_n, b_n = xs
        diff = b_n[..., :, None, :] - b_n[..., None, :, :]
        dec = jnp.where(causal, jnp.exp(jnp.where(causal, diff, 0.0)), 0.0)
        att = jnp.einsum('bhik,bhijk,bhjk->bhij', q_n, dec, k_n)
        o = (jnp.einsum('bhij,bhjv->bhiv', att, v_n)
             + jnp.einsum('bhik,bhkv->bhiv', q_n * jnp.exp(b_n), S))
        b_last = b_n[..., -1:, :]
        S = (S * jnp.exp(b_last)[..., 0, :, None]
             + jnp.einsum('bhjk,bhjv->bhkv', k_n * jnp.exp(b_last - b_n), v_n))
        return S, o

    S0 = jnp.zeros((B, H, Dk, Dv), q.dtype)
    _, o = lax.scan(step, S0, (q, k, v, bcum))
    return o.transpose(1, 0, 3, 2, 4).reshape(B, T, H, Dv)


def _hgrn2_branch(p, lb, norm_w):
    q, f, i, gate = _split(p, HGRN_SPLIT)
    q = jax.nn.silu(_heads(q, HGRN_HEADS))
    lb = _heads(lb, HGRN_HEADS)
    f = _heads(f, HGRN_HEADS)
    log_g = jax.nn.log_sigmoid(f) + jnp.log1p(lb * jnp.exp(-f))
    k = (1.0 - lb) * jax.nn.sigmoid(-f)
    o = _hgrn2_chunked(q, k, _heads(i, HGRN_HEADS), log_g)
    o = _rmsnorm(o.reshape(o.shape[:2] + (HGRN_WIDTH,)), norm_w)
    return o * jax.nn.silu(gate)


def setup_inputs(seed: int = 0) -> dict:
    key = jax.random.key(seed)
    ks = jax.random.split(key, 24)

    def nrm(k, shape, s):
        return s * jax.random.normal(k, shape, F32)

    x = jax.random.normal(ks[0], (BATCH, SEQ, D_MODEL), F32)
    norm_w = 1.0 + nrm(ks[1], (DEPTH, D_MODEL), 0.02)
    w_in = nrm(ks[2], (DEPTH, D_MODEL, PROJ_DIM), D_MODEL ** -0.5)
    gdn_conv_w = nrm(ks[3], (DEPTH, CONV_WIDTH, 3 * GDN_WIDTH), CONV_WIDTH ** -0.5)
    gdn_a_log = jnp.log(jax.random.uniform(ks[4], (DEPTH, GDN_HEADS), F32, 1.0, 16.0))
    dt = jnp.exp(jax.random.uniform(ks[5], (DEPTH, GDN_HEADS), F32, math.log(1e-3), math.log(1e-1)))
    gdn_dt_bias = dt + jnp.log(-jnp.expm1(-dt))
    gdn_norm_w = 1.0 + nrm(ks[6], (DEPTH, HEAD_DIM), 0.02)
    rwkv_mu = jax.random.uniform(ks[7], (DEPTH, RWKV_PROJ), F32, 0.0, 1.0)
    rwkv_w0 = jax.random.uniform(ks[8], (DEPTH, RWKV_WIDTH), F32, -6.0, -1.0)
    rwkv_w_up = nrm(ks[9], (DEPTH, RWKV_DECAY_LORA, RWKV_WIDTH), 0.5 * RWKV_DECAY_LORA ** -0.5)
    rwkv_a0 = nrm(ks[10], (DEPTH, RWKV_WIDTH), 0.1)
    rwkv_a_up = nrm(ks[11], (DEPTH, RWKV_ICLR_LORA, RWKV_WIDTH), 0.5 * RWKV_ICLR_LORA ** -0.5)
    rwkv_k_k = 0.85 + nrm(ks[12], (DEPTH, RWKV_WIDTH), 0.02)
    rwkv_k_a = 1.0 + nrm(ks[13], (DEPTH, RWKV_WIDTH), 0.02)
    rwkv_r_k = -0.04 + nrm(ks[14], (DEPTH, RWKV_HEADS, HEAD_DIM), 0.1)
    rwkv_ln_w = 1.0 + nrm(ks[15], (DEPTH, RWKV_WIDTH), 0.02)
    rwkv_ln_b = nrm(ks[16], (DEPTH, RWKV_WIDTH), 0.02)
    hgrn_lower_bounds = nrm(ks[17], (DEPTH, HGRN_FDIM), 0.5)
    hgrn_norm_w = 1.0 + nrm(ks[18], (DEPTH, HGRN_WIDTH), 0.02)
    w_out = nrm(ks[19], (DEPTH, D_MIX, D_MODEL), D_MIX ** -0.5)
    final_norm_w = 1.0 + nrm(ks[20], (D_MODEL,), 0.02)
    return {'x': x, 'norm_w': norm_w, 'w_in': w_in, 'gdn_conv_w': gdn_conv_w,
            'gdn_a_log': gdn_a_log, 'gdn_dt_bias': gdn_dt_bias, 'gdn_norm_w': gdn_norm_w,
            'rwkv_mu': rwkv_mu, 'rwkv_w0': rwkv_w0, 'rwkv_w_up': rwkv_w_up, 'rwkv_a0': rwkv_a0,
            'rwkv_a_up': rwkv_a_up, 'rwkv_k_k': rwkv_k_k, 'rwkv_k_a': rwkv_k_a, 'rwkv_r_k': rwkv_r_k,
            'rwkv_ln_w': rwkv_ln_w, 'rwkv_ln_b': rwkv_ln_b, 'hgrn_lower_bounds': hgrn_lower_bounds,
            'hgrn_norm_w': hgrn_norm_w, 'w_out': w_out, 'final_norm_w': final_norm_w}


def reference(x, norm_w, w_in, gdn_conv_w, gdn_a_log, gdn_dt_bias, gdn_norm_w,
              rwkv_mu, rwkv_w0, rwkv_w_up, rwkv_a0, rwkv_a_up, rwkv_k_k, rwkv_k_a, rwkv_r_k,
              rwkv_ln_w, rwkv_ln_b, hgrn_lower_bounds, hgrn_norm_w, w_out, final_norm_w):
    lb_soft = jax.nn.softmax(hgrn_lower_bounds.astype(F32), axis=0)
    lb_all = jnp.cumsum(lb_soft, axis=0) - lb_soft[0]
    for l in range(DEPTH):
        h = _rmsnorm(x, norm_w[l])
        proj = (h @ w_in[l]).astype(F32)
        p_gdn, p_rwkv, p_hgrn = _split(proj, (GDN_PROJ, RWKV_PROJ, HGRN_PROJ))
        y_a = _gdn_branch(p_gdn, gdn_conv_w[l], gdn_a_log[l], gdn_dt_bias[l], gdn_norm_w[l])
        y_b = _rwkv7_branch(p_rwkv, rwkv_mu[l], rwkv_w0[l], rwkv_w_up[l], rwkv_a0[l], rwkv_a_up[l],
                            rwkv_k_k[l], rwkv_k_a[l], rwkv_r_k[l], rwkv_ln_w[l], rwkv_ln_b[l])
        y_c = _hgrn2_branch(p_hgrn, lb_all[l], hgrn_norm_w[l])
        y = jnp.concatenate([y_a, y_b, y_c], axis=-1).astype(x.dtype)
        x = x + y @ w_out[l]
    return _rmsnorm(x, final_norm_w)
```

```cpp
#include <hip/hip_runtime.h>
#include <hip/hip_cooperative_groups.h>
#include <cstdio>
namespace cg = cooperative_groups;

typedef unsigned short bf16r;
using bf16x8 = __attribute__((ext_vector_type(8))) short;
using f32x4 = __attribute__((ext_vector_type(4))) float;

constexpr int T = 16384, DM = 1024, NCOL = 6288, PDP = 6400, DMIX = 1536;
constexpr int PD = 6272;
constexpr int GDN_GATE = 1536, RWKV_B = 2048, HGRN_B = 4224;
constexpr int NTHR = 512;
constexpr size_t OFF_PROJ = 0;
constexpr size_t OFF_WOUT = 206045184;
constexpr size_t OFF_GSC = OFF_WOUT + 3145728;
constexpr size_t OFF_HALO = OFF_GSC + 1048576;
constexpr size_t OFF_LB = OFF_HALO + 1179648;
constexpr size_t OFF_LORA = OFF_LB + 4096;
constexpr size_t OFF_BAR = OFF_LORA + 131072;
constexpr size_t OFF_SCR = OFF_BAR + 16384;
constexpr size_t OFF_HBF = OFF_SCR;
constexpr size_t OFF_WIN = OFF_SCR + 33554432;
constexpr int SMEM_BYTES = 131072;
constexpr int CH = 128, NSEG = 2;
constexpr size_t OFF_MBUF = OFF_SCR;
constexpr size_t OFF_GAM = OFF_MBUF + (size_t)16 * CH * 8192;
constexpr size_t OFF_NBUF = OFF_GAM + (size_t)8 * CH * 256;
constexpr size_t OFF_HTBUF = OFF_NBUF;
constexpr size_t OFF_HSTATE = OFF_NBUF + (size_t)24 * CH * 8192;
constexpr size_t OFF_HALO2 = OFF_SCR + 49807360;
constexpr size_t OFF_BON = OFF_HALO2 + 2359296;
constexpr size_t OFF_SSP = OFF_BON + 524288;
constexpr size_t OFF_RS = OFF_SSP + 1048576;
constexpr int LS = 72;
constexpr int FS = 68;

struct Params {
  const float* x; const float* norm_w; const float* w_in; const float* conv_w; const float* a_log;
  const float* dt_bias; const float* gdn_norm_w; const float* mu; const float* w0; const float* w_up;
  const float* a0; const float* a_up; const float* k_k; const float* k_a; const float* r_k;
  const float* ln_w; const float* ln_b; const float* lbnd; const float* hgrn_norm_w; const float* w_out;
  const float* final_norm_w;
  float* out; unsigned char* ws;
};

typedef float f32x2_t __attribute__((ext_vector_type(2)));
typedef __bf16 bf16x2_t __attribute__((ext_vector_type(2)));
__device__ __forceinline__ unsigned char* wsp(const Params& p) {
  size_t z = 0;
  asm volatile("" : "+s"(z));
  return p.ws + z;
}
__device__ __forceinline__ unsigned cvt_pk_bf16(float lo, float hi) {
  f32x2_t f = {lo, hi};
  bf16x2_t b = __builtin_convertvector(f, bf16x2_t);
  return __builtin_bit_cast(unsigned, b);
}
__device__ __forceinline__ bf16r f2bf(float f) { return (bf16r)(cvt_pk_bf16(f, f) & 0xffffu); }
__device__ __forceinline__ int opaque(int v) { asm volatile("" : "+v"(v)); return v; }
__device__ __forceinline__ float bf2f(bf16r h) { return __uint_as_float(((unsigned)h) << 16); }
__device__ __forceinline__ float sigmoidf_(float x) { return __builtin_amdgcn_rcpf(1.f + __expf(-x)); }
__device__ __forceinline__ float siluf_(float x) { return x * __builtin_amdgcn_rcpf(1.f + __expf(-x)); }
__device__ __forceinline__ float softplusf_(float x) { return x > 20.f ? x : __logf(1.f + __expf(x)); }
template <int CTRL> __device__ __forceinline__ float dpp_mov(float v) {
  return __int_as_float(__builtin_amdgcn_update_dpp(0, __float_as_int(v), CTRL, 0xf, 0xf, true));
}
__device__ __forceinline__ float red8(float v) {
  v += dpp_mov<0xB1>(v);
  v += dpp_mov<0x4E>(v);
  v += dpp_mov<0x141>(v);
  return v;
}
__device__ __forceinline__ float red64(float v) {
  v = red8(v);
  v += dpp_mov<0x128>(v);
  v += __shfl_xor(v, 16); v += __shfl_xor(v, 32); return v;
}
__device__ __forceinline__ void unpack8(uint4 u, float* f) {
  f[0] = __uint_as_float(u.x << 16); f[1] = __uint_as_float(u.x & 0xffff0000u);
  f[2] = __uint_as_float(u.y << 16); f[3] = __uint_as_float(u.y & 0xffff0000u);
  f[4] = __uint_as_float(u.z << 16); f[5] = __uint_as_float(u.z & 0xffff0000u);
  f[6] = __uint_as_float(u.w << 16); f[7] = __uint_as_float(u.w & 0xffff0000u);
}
__device__ __forceinline__ uint4 pack8(const float* f) {
  uint4 u;
  u.x = cvt_pk_bf16(f[0], f[1]);
  u.y = cvt_pk_bf16(f[2], f[3]);
  u.z = cvt_pk_bf16(f[4], f[5]);
  u.w = cvt_pk_bf16(f[6], f[7]);
  return u;
}

template <bool SCALE>
__device__ void transpose_tile(const float* __restrict__ src, bf16r* __restrict__ dst, int K, int N, int k0, int n0,
                               unsigned char* smem, const float* __restrict__ kscale) {
  float* tile = (float*)smem;
  const int tid = opaque(threadIdx.x);
  __syncthreads();
#pragma unroll
  for (int i = 0; i < 2; ++i) {
    const int kk = i * 32 + (tid >> 4), n4 = (tid & 15) * 4;
    float4 v = (n0 + n4 < N) ? *(const float4*)(src + (size_t)(k0 + kk) * N + n0 + n4) : float4{0.f, 0.f, 0.f, 0.f};
    if (SCALE) { const float ks = kscale[k0 + kk]; v.x *= ks; v.y *= ks; v.z *= ks; v.w *= ks; }
    tile[kk * 65 + n4 + 0] = v.x; tile[kk * 65 + n4 + 1] = v.y; tile[kk * 65 + n4 + 2] = v.z; tile[kk * 65 + n4 + 3] = v.w;
  }
  __syncthreads();
  int n = tid >> 3, ks = tid & 7;
  float f[8];
#pragma unroll
  for (int j = 0; j < 8; ++j) f[j] = tile[(ks * 8 + j) * 65 + n];
  *(uint4*)(dst + (size_t)(n0 + n) * K + k0 + ks * 8) = pack8(f);
}

template <int MODE>
__device__ void gemm_tile(const Params& p, const float* __restrict__ xin, int mt, int nt, unsigned char* smem) {
  constexpr int K = (MODE == 1) ? 1024 : 1536;
  bf16r* As = (bf16r*)smem;
  bf16r* Bs = As + 256 * LS;
  const bf16r* proj = (const bf16r*)(wsp(p) + OFF_PROJ);
  const bf16r* hbf = (const bf16r*)(wsp(p) + OFF_HBF);
  const bf16r* Bm = (MODE == 1) ? (const bf16r*)(wsp(p) + OFF_WIN) : (const bf16r*)(wsp(p) + OFF_WOUT);
  const int tid = opaque(threadIdx.x), lane = tid & 63, wid = tid >> 6;
  const int wr = wid >> 1, wc = wid & 1, fr = lane & 15, fq = lane >> 4;
  const int m0 = mt * 256, n0 = nt * 128;
  f32x4 acc[4][4];
#pragma unroll
  for (int i = 0; i < 4; ++i)
#pragma unroll
    for (int j = 0; j < 4; ++j) acc[i][j] = f32x4{0.f, 0.f, 0.f, 0.f};
  uint4 ra0, ra1, ra2, ra3, rb0, rb1;
  const int lrow = tid >> 3, lkc = tid & 7;
  const bf16r* aptr;
  if (MODE == 1) aptr = hbf + (size_t)(m0 + lrow) * 1024 + lkc * 8;
  else aptr = proj + (size_t)(m0 + lrow) * PD + lkc * 8;
  constexpr size_t ASTR = (MODE == 1) ? (size_t)64 * 1024 : (size_t)64 * PD;
  const bf16r* bptr = Bm + (size_t)(n0 + lrow) * K + lkc * 8;
#define GLOAD(k0_)                                                                              \
  {                                                                                             \
    int kk_ = (k0_);                                                                            \
    if (MODE == 2) { int blk_ = kk_ >> 9; kk_ = (blk_ == 0 ? 1536 : (blk_ == 1 ? 3712 : 5760)) + (kk_ & 511); } \
    ra0 = *(const uint4*)(aptr + kk_);                                                          \
    ra1 = *(const uint4*)(aptr + ASTR + kk_);                                                   \
    ra2 = *(const uint4*)(aptr + 2 * ASTR + kk_);                                               \
    ra3 = *(const uint4*)(aptr + 3 * ASTR + kk_);                                               \
    rb0 = *(const uint4*)(bptr + (k0_));                                                        \
    rb1 = *(const uint4*)(bptr + (size_t)64 * K + (k0_));                                       \
  }
  GLOAD(0);
  constexpr int NK = K / 64;
#pragma unroll 1
  for (int kt = 0; kt < NK; ++kt) {
    __syncthreads();
    *(uint4*)(As + lrow * LS + lkc * 8) = ra0;
    *(uint4*)(As + (lrow + 64) * LS + lkc * 8) = ra1;
    *(uint4*)(As + (lrow + 128) * LS + lkc * 8) = ra2;
    *(uint4*)(As + (lrow + 192) * LS + lkc * 8) = ra3;
    *(uint4*)(Bs + lrow * LS + lkc * 8) = rb0;
    *(uint4*)(Bs + (lrow + 64) * LS + lkc * 8) = rb1;
    __syncthreads();
    if (kt + 1 < NK) GLOAD((kt + 1) * 64);
#pragma unroll
    for (int ks = 0; ks < 2; ++ks) {
      bf16x8 bfr[4];
#pragma unroll
      for (int ni = 0; ni < 4; ++ni)
        bfr[ni] = *(const bf16x8*)(Bs + (wc * 64 + ni * 16 + fr) * LS + ks * 32 + fq * 8);
#pragma unroll
      for (int mi = 0; mi < 4; ++mi) {
        bf16x8 afr = *(const bf16x8*)(As + (wr * 64 + mi * 16 + fr) * LS + ks * 32 + fq * 8);
#pragma unroll
        for (int ni = 0; ni < 4; ++ni)
          acc[mi][ni] = __builtin_amdgcn_mfma_f32_16x16x32_bf16(afr, bfr[ni], acc[mi][ni], 0, 0, 0);
      }
    }
  }
#undef GLOAD
  if (MODE == 1) {
    bf16r* projw = (bf16r*)(wsp(p) + OFF_PROJ);
    float* gsc = (float*)(wsp(p) + OFF_GSC);
    bf16r* halo = (bf16r*)(wsp(p) + OFF_HALO);
#pragma unroll
    for (int mi = 0; mi < 4; ++mi)
#pragma unroll
      for (int ni = 0; ni < 4; ++ni) {
        int col = n0 + wc * 64 + ni * 16 + fr;
        if (col < NCOL) {
#pragma unroll
          for (int j = 0; j < 4; ++j) {
            int row = m0 + wr * 64 + mi * 16 + fq * 4 + j;
            float v = acc[mi][ni][j];
            bf16r b = f2bf(v);
            projw[(size_t)row * PD + col] = b;
            if (col >= 1536 && col < 1552) gsc[row * 16 + col - 1536] = v;
            if ((row & 63) == 63 && col >= RWKV_B && col < HGRN_B) halo[(row >> 6) * 2176 + col - RWKV_B] = b;
          }
        }
      }
  } else {
#pragma unroll
    for (int mi = 0; mi < 4; ++mi)
#pragma unroll
      for (int ni = 0; ni < 4; ++ni) {
        int col = n0 + wc * 64 + ni * 16 + fr;
#pragma unroll
        for (int j = 0; j < 4; ++j) {
          int row = m0 + wr * 64 + mi * 16 + fq * 4 + j;
          size_t o = (size_t)row * DM + col;
          p.out[o] = xin[o] + acc[mi][ni][j];
        }
      }
  }
}

namespace pg8 {
#define PG8_LAS __attribute__((address_space(3)))
constexpr int BM = 256, BK = 64, HALF = 128, HTB = HALF * BK * 2, STAGE_BYTES = 8 * HTB, NXCD = 8, WGM = 8;
__device__ __forceinline__ int lds_byte(int r, int c) { const int st = (r >> 4) * 2 + (c >> 5), rr = r & 15, cc = c & 31, ob = rr * 64 + cc * 2; return st * 1024 + (ob ^ (((ob >> 9) & 1) << 5)); }
__device__ __forceinline__ void stage_rc(int b, int& R, int& C) { const int st = b / 1024, sb = b % 1024, swz = sb ^ (((sb >> 9) & 1) << 5); R = (st >> 1) * 16 + swz / 64; C = (st & 1) * 32 + (swz % 64) / 2; }
__device__ __forceinline__ int perm32(int rho) { const int n = rho >> 4, i = rho & 15; return 8 * (i >> 2) + 4 * n + (i & 3); }
struct Unit { int pm, pn; };
struct StaticOrder {
  int nM, nN, nwg, G, c;
  __device__ void init(int M, int N, int G_, int c_) { nM = M / BM; nN = N / BM; nwg = nM * nN; G = G_; c = c_; }
  __device__ bool next(int i, Unit& u) const {
    const long L = (long)i * G + c; if (L >= nwg) return false;
    int wgid = (int)L; { const int q = nwg / NXCD, r = nwg % NXCD, xcd = wgid % NXCD, off = wgid / NXCD; wgid = (xcd < r ? xcd * (q + 1) : r * (q + 1) + (xcd - r) * q) + off; }
    const int nig = WGM * nN, gid = wgid / nig, fm = gid * WGM, gsz = (nM - fm) < WGM ? (nM - fm) : WGM;
    u.pm = fm + ((wgid % nig) % gsz); u.pn = (wgid % nig) / gsz; return true;
  }
};
template <int MODE> __device__ __forceinline__ size_t a_koff(int t) {
  if (MODE == 1) return (size_t)t * (BK * 2);
  const int blk = t >> 3;
  const int cb = (blk == 0 ? 1536 : (blk == 1 ? 3712 : 5760));
  return (size_t)cb * 2 + (size_t)(t & 7) * (BK * 2);
}
template <int MODE, class Epi>
__device__ __forceinline__ void gemm_phase(PG8_LAS unsigned char* lds, const unsigned short* A, const unsigned short* Bt, int M, int N, const StaticOrder& S, const Epi& E) {
  constexpr int K = (MODE == 1) ? 1024 : 1536;
  constexpr int LDA = (MODE == 1) ? 1024 : PD;
  const int tid = opaque(threadIdx.x), wid = __builtin_amdgcn_readfirstlane(tid >> 6), lane = tid & 63, wr = wid >> 2, wc = wid & 3, fr = lane & 15, fq = lane >> 4;
  constexpr int nt = K / BK;
  unsigned voffA[2], voffB[2];
#pragma unroll
  for (int i = 0; i < 2; ++i) { int R, C; stage_rc(tid * 16 + i * 8192, R, C); const int Rb = Epi::PERM ? ((R & ~31) + perm32(R & 31)) : R;
    voffA[i] = (unsigned)(R * LDA + C) * 2u; voffB[i] = (unsigned)(Rb * K + C) * 2u; }
  const size_t kstep = (size_t)(BK * 2);
  const size_t hstepA = (size_t)HALF * LDA * 2, hstepB = (size_t)HALF * K * 2;
  const size_t tstepA = 2 * hstepA, tstepB = 2 * hstepB;
  const unsigned ldsw = (unsigned)wid * 1024u;
  const int aoff = lds_byte(wr * 64 + fr, fq * 8), boff = lds_byte(wc * 32 + fr, fq * 8);
#define PG8_SA(b, h) (((b) * 2 + (h)) * HTB)
#define PG8_SB(b, h) ((4 + (b) * 2 + (h)) * HTB)
#define PG8_STAGE(bufoff, gbase, voff) do { _Pragma("unroll") for (int _i = 0; _i < 2; ++_i) \
    __builtin_amdgcn_global_load_lds((const unsigned*)((const char*)(gbase) + (voff)[_i]), (PG8_LAS unsigned*)(lds + (bufoff) + ldsw + _i * 8192), 16, 0, 0); } while (0)
#define PG8_LDA(dst, b, h) do { _Pragma("unroll") for (int m = 0; m < 4; ++m) _Pragma("unroll") for (int k = 0; k < 2; ++k) dst[m][k] = *(const PG8_LAS bf16x8*)(lds + PG8_SA(b, h) + aoff + m * 2048 + k * 1024); } while (0)
#define PG8_LDB(dst, b, h) do { _Pragma("unroll") for (int n = 0; n < 2; ++n) _Pragma("unroll") for (int k = 0; k < 2; ++k) dst[n][k] = *(const PG8_LAS bf16x8*)(lds + PG8_SB(b, h) + boff + n * 2048 + k * 1024); } while (0)
#define PG8_MMA(ai, bj, At, Bt_) do { __builtin_amdgcn_s_setprio(1); _Pragma("unroll") for (int m = 0; m < 4; ++m) _Pragma("unroll") for (int n = 0; n < 2; ++n) _Pragma("unroll") for (int k = 0; k < 2; ++k) \
    acc[ai][bj][m][n] = __builtin_amdgcn_mfma_f32_16x16x32_bf16(Bt_[n][k], At[m][k], acc[ai][bj][m][n], 0, 0, 0); __builtin_amdgcn_s_setprio(0); } while (0)
#define PG8_WAIT_V(n) asm volatile("s_waitcnt vmcnt(" #n ")" ::: "memory")
#define PG8_WAIT_L(n) asm volatile("s_waitcnt lgkmcnt(" #n ")" ::: "memory")
#define PG8_BAR __builtin_amdgcn_s_barrier()
#define PG8_SCHED __builtin_amdgcn_sched_barrier(0)
  Unit cur, nxt; int ui = 0;
  if (!S.next(0, cur)) return;
  f32x4 acc[2][2][4][2];
#pragma unroll
  for (int a = 0; a < 2; ++a)
#pragma unroll
    for (int b = 0; b < 2; ++b)
#pragma unroll
      for (int m = 0; m < 4; ++m)
#pragma unroll
        for (int n = 0; n < 2; ++n) acc[a][b][m][n] = (f32x4){0.f, 0.f, 0.f, 0.f};
  bf16x8 At[4][2], B0[2][2], B1[2][2];
  const char* cA = (const char*)A + (size_t)cur.pm * tstepA; const char* cB = (const char*)Bt + (size_t)cur.pn * tstepB;
  PG8_STAGE(PG8_SB(0, 0), cB, voffB); PG8_STAGE(PG8_SA(0, 0), cA + a_koff<MODE>(0), voffA); PG8_STAGE(PG8_SB(0, 1), cB + hstepB, voffB); PG8_STAGE(PG8_SA(0, 1), cA + a_koff<MODE>(0) + hstepA, voffA);
  if (wr == 1) PG8_BAR;
  PG8_WAIT_V(4); PG8_BAR;
  PG8_STAGE(PG8_SB(1, 0), cB + kstep, voffB); PG8_STAGE(PG8_SA(1, 0), cA + a_koff<MODE>(1), voffA); PG8_STAGE(PG8_SB(1, 1), cB + hstepB + kstep, voffB);
  PG8_WAIT_V(6); PG8_BAR;
  for (;;) {
    const bool has_next = S.next(ui + 1, nxt);
    const char* nA = has_next ? (const char*)A + (size_t)nxt.pm * tstepA : cA; const char* nB = has_next ? (const char*)Bt + (size_t)nxt.pn * tstepB : cB;
#pragma unroll 1
    for (int t = 0; t < nt; t += 2) {
      const bool last = (t == nt - 2);
      const char* a1 = cA + a_koff<MODE>(t + 1);
      const char* a2 = last ? nA + a_koff<MODE>(0) : cA + a_koff<MODE>(t + 2);
      const char* a3 = last ? nA + a_koff<MODE>(1) : cA + a_koff<MODE>(t + 3);
      const char* b2 = last ? nB : cB + (size_t)(t + 2) * kstep;
      const char* b3 = b2 + kstep;
      PG8_LDB(B0, 0, 0); PG8_SCHED; PG8_LDA(At, 0, 0); PG8_STAGE(PG8_SA(1, 1), a1 + hstepA, voffA);
      PG8_WAIT_L(8); PG8_BAR; PG8_WAIT_L(0); PG8_MMA(0, 0, At, B0); PG8_BAR; PG8_SCHED;
      PG8_LDB(B1, 0, 1); PG8_STAGE(PG8_SB(0, 0), b2, voffB);
      PG8_BAR; PG8_WAIT_L(0); PG8_MMA(0, 1, At, B1); PG8_BAR;
      PG8_LDA(At, 0, 1); PG8_STAGE(PG8_SA(0, 0), a2, voffA);
      PG8_BAR; PG8_WAIT_L(0); PG8_MMA(1, 0, At, B0); PG8_BAR; PG8_SCHED;
      PG8_STAGE(PG8_SB(0, 1), b2 + hstepB, voffB);
      PG8_WAIT_V(6); PG8_BAR; PG8_MMA(1, 1, At, B1); PG8_BAR;
      PG8_LDB(B0, 1, 0); PG8_SCHED; PG8_LDA(At, 1, 0); PG8_STAGE(PG8_SA(0, 1), a2 + hstepA, voffA);
      PG8_WAIT_L(8); PG8_BAR; PG8_WAIT_L(0); PG8_MMA(0, 0, At, B0); PG8_BAR; PG8_SCHED;
      PG8_LDB(B1, 1, 1); PG8_STAGE(PG8_SB(1, 0), b3, voffB);
      PG8_BAR; PG8_WAIT_L(0); PG8_MMA(0, 1, At, B1); PG8_BAR;
      PG8_LDA(At, 1, 1); PG8_STAGE(PG8_SA(1, 0), a3, voffA);
      PG8_BAR; PG8_WAIT_L(0); PG8_MMA(1, 0, At, B0); PG8_BAR; PG8_SCHED;
      PG8_STAGE(PG8_SB(1, 1), b3 + hstepB, voffB);
      PG8_WAIT_V(6); PG8_BAR; PG8_MMA(1, 1, At, B1); PG8_BAR;
    }
    E(acc, cur, wr, wc, fr, fq);
    if (!has_next) break;
#pragma unroll
    for (int a = 0; a < 2; ++a)
#pragma unroll
      for (int b = 0; b < 2; ++b)
#pragma unroll
        for (int m = 0; m < 4; ++m)
#pragma unroll
          for (int n = 0; n < 2; ++n) acc[a][b][m][n] = (f32x4){0.f, 0.f, 0.f, 0.f};
    cur = nxt; cA = nA; cB = nB; ++ui;
  }
  PG8_WAIT_V(0);
  if (wr == 0) PG8_BAR;
  PG8_BAR;
#undef PG8_SA
#undef PG8_SB
#undef PG8_STAGE
#undef PG8_LDA
#undef PG8_LDB
#undef PG8_MMA
#undef PG8_WAIT_V
#undef PG8_WAIT_L
#undef PG8_BAR
#undef PG8_SCHED
}
struct EpiProj {
  static constexpr bool PERM = true;
  unsigned char* ws;
  __device__ __forceinline__ void operator()(const f32x4 (&acc)[2][2][4][2], const Unit& u, int wr, int wc, int fr, int fq) const {
    bf16r* projw = (bf16r*)(ws + OFF_PROJ);
    float* gsc = (float*)(ws + OFF_GSC);
    bf16r* halo = (bf16r*)(ws + OFF_HALO);
#pragma unroll
    for (int ai = 0; ai < 2; ++ai)
#pragma unroll
      for (int m = 0; m < 4; ++m) {
        const int row = u.pm * BM + ai * HALF + wr * 64 + m * 16 + fr;
        const float rsr = ((const float*)(ws + OFF_RS))[row];
#pragma unroll
        for (int bj = 0; bj < 2; ++bj) {
          const int c0 = u.pn * BM + bj * HALF + wc * 32 + 8 * fq;
          if (c0 < NCOL) {
            const f32x4 v0 = acc[ai][bj][m][0] * rsr, v1 = acc[ai][bj][m][1] * rsr;
            if (c0 >= 1536 && c0 < 1552) {
              *(f32x4*)(gsc + row * 16 + (c0 - 1536)) = v0;
              *(f32x4*)(gsc + row * 16 + (c0 - 1536) + 4) = v1;
            } else {
              const int cs = (c0 < 1536) ? c0 : c0 - 16;
              uint4 pk;
              pk.x = cvt_pk_bf16(v0[0], v0[1]); pk.y = cvt_pk_bf16(v0[2], v0[3]);
              pk.z = cvt_pk_bf16(v1[0], v1[1]); pk.w = cvt_pk_bf16(v1[2], v1[3]);
              *(uint4*)(projw + (size_t)row * PD + cs) = pk;
              if ((row & 63) == 63 && cs >= RWKV_B && cs < HGRN_B) *(uint4*)(halo + (size_t)(row >> 6) * 2176 + (cs - RWKV_B)) = pk;
              if ((row & 63) >= 61 && cs < 1536) *(uint4*)((bf16r*)(ws + OFF_HALO2) + ((size_t)(row >> 6) * 3 + ((row & 63) - 61)) * 1536 + cs) = pk;
            }
          }
        }
      }
  }
};
struct EpiResid {
  static constexpr bool PERM = false;
  const float* xin; float* out; unsigned char* ws; bool next_in;
  __device__ __forceinline__ void operator()(const f32x4 (&acc)[2][2][4][2], const Unit& u, int wr, int wc, int fr, int fq) const {
    bf16r* hbf = (bf16r*)(ws + OFF_HBF);
    float* ssp = (float*)(ws + OFF_SSP) + (size_t)(u.pn * 4 + wc) * T;
#pragma unroll
    for (int ai = 0; ai < 2; ++ai)
#pragma unroll
      for (int m = 0; m < 4; ++m) {
        const int row = u.pm * BM + ai * HALF + wr * 64 + m * 16 + fr;
        float ss = 0.f;
#pragma unroll
        for (int bj = 0; bj < 2; ++bj)
#pragma unroll
          for (int n = 0; n < 2; ++n) {
            const int c0 = u.pn * BM + bj * HALF + wc * 32 + 16 * n + 4 * fq;
            const size_t o = (size_t)row * DM + c0;
            const f32x4 x = *(const f32x4*)(xin + o);
            const f32x4 y = x + acc[ai][bj][m][n];
            *(f32x4*)(out + o) = y;
            if (next_in) {
              ss += y[0] * y[0] + y[1] * y[1] + y[2] * y[2] + y[3] * y[3];
              *(uint2*)(hbf + o) = uint2{cvt_pk_bf16(y[0], y[1]), cvt_pk_bf16(y[2], y[3])};
            }
          }
        if (next_in) {
          ss += __shfl_xor(ss, 16);
          ss += __shfl_xor(ss, 32);
          if (fq == 0) ssp[row] = ss;
        }
      }
  }
};
}

__device__ void rows_bf16_rs(const float* __restrict__ xin, bf16r* __restrict__ dst, float* __restrict__ rsout) {
  const int tid_ = opaque(threadIdx.x);
  const int lane = tid_ & 63;
  const int gw = blockIdx.x * (NTHR / 64) + (tid_ >> 6);
  const int nw = gridDim.x * (NTHR / 64);
  for (int row = gw; row < T; row += nw) {
    const float4* xr = (const float4*)(xin + (size_t)row * DM);
    float4 v[4];
    float ss = 0.f;
#pragma unroll
    for (int i = 0; i < 4; ++i) {
      v[i] = xr[lane + 64 * i];
      ss += v[i].x * v[i].x + v[i].y * v[i].y + v[i].z * v[i].z + v[i].w * v[i].w;
    }
    ss = red64(ss);
    if (lane == 0) rsout[row] = rsqrtf(ss * (1.f / DM) + 1e-6f);
#pragma unroll
    for (int i = 0; i < 4; ++i) {
      uint2 o;
      o.x = cvt_pk_bf16(v[i].x, v[i].y);
      o.y = cvt_pk_bf16(v[i].z, v[i].w);
      *(uint2*)(dst + (size_t)row * DM + (lane + 64 * i) * 4) = o;
    }
  }
}
__device__ void reduce_rs(const float* __restrict__ ssp, float* __restrict__ rsout) {
  const int tid_ = opaque(threadIdx.x);
  for (int row = blockIdx.x * NTHR + tid_; row < T; row += gridDim.x * NTHR) {
    float ss = 0.f;
#pragma unroll
    for (int i = 0; i < 16; ++i) ss += ssp[(size_t)i * T + row];
    rsout[row] = rsqrtf(ss * (1.f / DM) + 1e-6f);
  }
}

__device__ __forceinline__ void shifted8(const bf16r* pc, const bf16r* pp, const float* mu, bool hasprev, int col, float* o8) {
  float cur[8], prv[8];
  unpack8(*(const uint4*)(pc + col), cur);
  uint4 z = hasprev ? *(const uint4*)(pp + col) : uint4{0u, 0u, 0u, 0u};
  unpack8(z, prv);
#pragma unroll
  for (int j = 0; j < 8; ++j) o8[j] = cur[j] + mu[col + j] * (prv[j] - cur[j]);
}

__device__ void mixer_naive(const Params& p, int l, int br, int h, unsigned char* smem) {
  float* sW = (float*)smem;
  float* sA = sW + 4096;
  float* sB = sA + 4096;
  float* sK = sB + 4096;
  float* sQ = sK + 4096;
  float* sV = sQ + 4096;
  float* sO = sV + 4096;
  float* sX = sO + 4096;
  bf16r* proj = (bf16r*)(wsp(p) + OFF_PROJ);
  const float* gsc = (const float*)(wsp(p) + OFF_GSC);
  const bf16r* halo = (const bf16r*)(wsp(p) + OFF_HALO);
  const float* lb = (const float*)(wsp(p) + OFF_LB) + l * 512;
  const int tid = opaque(threadIdx.x), lane = tid & 63, wid = tid >> 6;
  const int tt = tid >> 3, js = tid & 7, j0 = js * 8;
  const int rv = wid * 8 + (lane >> 3);
  const int kq = (lane & 7) * 8;
  float s[8];
#pragma unroll
  for (int i = 0; i < 8; ++i) s[i] = 0.f;

#pragma unroll 1
  for (int c = 0; c < T / 64; ++c) {
    const int t = c * 64 + tt;
    __syncthreads();
    if (br == 0) {
      float cq[8], ck[8], cv[8];
#pragma unroll
      for (int j = 0; j < 8; ++j) { cq[j] = 0.f; ck[j] = 0.f; cv[j] = 0.f; }
      const float* cw = p.conv_w + (size_t)l * 4 * 1536;
#pragma unroll
      for (int i = 0; i < 4; ++i) {
        int ts = t - 3 + i;
        if (ts >= 0) {
          float fq_[8], fk_[8], fv_[8];
          const bf16r* pr = proj + (size_t)ts * PD + h * 64 + j0;
          unpack8(*(const uint4*)(pr), fq_);
          unpack8(*(const uint4*)(pr + 512), fk_);
          unpack8(*(const uint4*)(pr + 1024), fv_);
#pragma unroll
          for (int j = 0; j < 8; ++j) {
            cq[j] += cw[i * 1536 + h * 64 + j0 + j] * fq_[j];
            ck[j] += cw[i * 1536 + 512 + h * 64 + j0 + j] * fk_[j];
            cv[j] += cw[i * 1536 + 1024 + h * 64 + j0 + j] * fv_[j];
          }
        }
      }
      float sq = 0.f, sk = 0.f;
#pragma unroll
      for (int j = 0; j < 8; ++j) {
        cq[j] = siluf_(cq[j]); ck[j] = siluf_(ck[j]); cv[j] = siluf_(cv[j]);
        sq += cq[j] * cq[j]; sk += ck[j] * ck[j];
      }
      sq = red8(sq); sk = red8(sk);
      float nq = rsqrtf(sq + 1e-6f) * 0.125f, nk = rsqrtf(sk + 1e-6f);
      float beta = sigmoidf_(gsc[t * 16 + h]);
      float g = -__expf(p.a_log[l * 8 + h]) * softplusf_(gsc[t * 16 + 8 + h] + p.dt_bias[l * 8 + h]);
      float eg = __expf(g);
#pragma unroll
      for (int j = 0; j < 8; ++j) {
        float kn = ck[j] * nk;
        int o = tt * 64 + j0 + j;
        sQ[o] = cq[j] * nq; sA[o] = kn; sK[o] = beta * kn; sB[o] = -eg * beta * kn; sW[o] = eg; sV[o] = cv[j];
      }
    } else if (br == 1) {
      const float* mu = p.mu + (size_t)l * 2176;
      const bf16r* pc = proj + (size_t)t * PD + RWKV_B;
      const bf16r* pp = (tt == 0) ? (halo + (size_t)(c - 1) * 2176) : (pc - PD);
      const bool hasprev = (t > 0);
      {
        float wd[8], ad[8];
        shifted8(pc, pp, mu, hasprev, 1536 + j0, wd);
        shifted8(pc, pp, mu, hasprev, 1600 + j0, ad);
#pragma unroll
        for (int j = 0; j < 8; ++j) { sO[tt * 64 + j0 + j] = tanhf(wd[j]); sX[tt * 64 + j0 + j] = ad[j]; }
      }
      __syncthreads();
      float aw[8], aa[8];
      const int ch0 = h * 64 + j0;
#pragma unroll
      for (int j = 0; j < 8; ++j) { aw[j] = p.w0[l * 512 + ch0 + j]; aa[j] = p.a0[l * 512 + ch0 + j]; }
      const float* wu = p.w_up + (size_t)l * 64 * 512 + ch0;
      const float* au = p.a_up + (size_t)l * 64 * 512 + ch0;
#pragma unroll 2
      for (int i = 0; i < 64; ++i) {
        float xw = sO[tt * 64 + i], xa = sX[tt * 64 + i];
        float4 w1 = *(const float4*)(wu + i * 512), w2 = *(const float4*)(wu + i * 512 + 4);
        float4 a1 = *(const float4*)(au + i * 512), a2 = *(const float4*)(au + i * 512 + 4);
        aw[0] += xw * w1.x; aw[1] += xw * w1.y; aw[2] += xw * w1.z; aw[3] += xw * w1.w;
        aw[4] += xw * w2.x; aw[5] += xw * w2.y; aw[6] += xw * w2.z; aw[7] += xw * w2.w;
        aa[0] += xa * a1.x; aa[1] += xa * a1.y; aa[2] += xa * a1.z; aa[3] += xa * a1.w;
        aa[4] += xa * a2.x; aa[5] += xa * a2.y; aa[6] += xa * a2.z; aa[7] += xa * a2.w;
      }
      float r8[8], k8[8], v8[8];
      shifted8(pc, pp, mu, hasprev, ch0, r8); shifted8(pc, pp, mu, hasprev, 512 + ch0, k8); shifted8(pc, pp, mu, hasprev, 1024 + ch0, v8);
      float kk[8], ssk = 0.f;
#pragma unroll
      for (int j = 0; j < 8; ++j) { kk[j] = k8[j] * p.k_k[l * 512 + ch0 + j]; ssk += kk[j] * kk[j]; }
      ssk = red8(ssk);
      float nk = rsqrtf(ssk + 1e-6f);
      __syncthreads();
#pragma unroll
      for (int j = 0; j < 8; ++j) {
        float w_raw = -softplusf_(-aw[j]) - 0.5f;
        float dec = __expf(-__expf(w_raw));
        float ic = sigmoidf_(aa[j]);
        float kn = kk[j] * nk;
        int o = tt * 64 + j0 + j;
        sW[o] = dec; sA[o] = -kn; sB[o] = kn * ic;
        sK[o] = k8[j] * (1.f + (ic - 1.f) * p.k_a[l * 512 + ch0 + j]);
        sV[o] = v8[j]; sQ[o] = r8[j];
      }
    } else {
      const bf16r* pc = proj + (size_t)t * PD + HGRN_B + h * 64 + j0;
      float q8[8], f8[8], i8[8];
      unpack8(*(const uint4*)(pc), q8);
      unpack8(*(const uint4*)(pc + 512), f8);
      unpack8(*(const uint4*)(pc + 1024), i8);
#pragma unroll
      for (int j = 0; j < 8; ++j) {
        float lbv = lb[h * 64 + j0 + j];
        float sg = sigmoidf_(f8[j]);
        int o = tt * 64 + j0 + j;
        sW[o] = lbv + (1.f - lbv) * sg;
        sA[o] = 0.f; sB[o] = 0.f;
        sK[o] = (1.f - lbv) * (1.f - sg);
        sQ[o] = siluf_(q8[j]); sV[o] = i8[j];
      }
    }
    __syncthreads();
#pragma unroll 2
    for (int st = 0; st < 64; ++st) {
      const float4* w4 = (const float4*)(sW + st * 64 + kq);
      const float4* a4 = (const float4*)(sA + st * 64 + kq);
      const float4* b4 = (const float4*)(sB + st * 64 + kq);
      const float4* k4 = (const float4*)(sK + st * 64 + kq);
      const float4* q4 = (const float4*)(sQ + st * 64 + kq);
      float4 wa = w4[0], wb = w4[1], aa_ = a4[0], ab = a4[1], ba = b4[0], bb = b4[1];
      float4 ka = k4[0], kb = k4[1], qa = q4[0], qb = q4[1];
      float vv = sV[st * 64 + rv];
      float d = s[0] * aa_.x + s[1] * aa_.y + s[2] * aa_.z + s[3] * aa_.w + s[4] * ab.x + s[5] * ab.y + s[6] * ab.z + s[7] * ab.w;
      d = red8(d);
      s[0] = s[0] * wa.x + d * ba.x + vv * ka.x;
      s[1] = s[1] * wa.y + d * ba.y + vv * ka.y;
      s[2] = s[2] * wa.z + d * ba.z + vv * ka.z;
      s[3] = s[3] * wa.w + d * ba.w + vv * ka.w;
      s[4] = s[4] * wb.x + d * bb.x + vv * kb.x;
      s[5] = s[5] * wb.y + d * bb.y + vv * kb.y;
      s[6] = s[6] * wb.z + d * bb.z + vv * kb.z;
      s[7] = s[7] * wb.w + d * bb.w + vv * kb.w;
      float od = s[0] * qa.x + s[1] * qa.y + s[2] * qa.z + s[3] * qa.w + s[4] * qb.x + s[5] * qb.y + s[6] * qb.z + s[7] * qb.w;
      od = red8(od);
      if ((lane & 7) == 0) sO[st * 64 + rv] = od;
    }
    __syncthreads();
    float o8[8];
#pragma unroll
    for (int j = 0; j < 8; ++j) o8[j] = sO[tt * 64 + j0 + j];
    if (br == 0) {
      float ss = 0.f;
#pragma unroll
      for (int j = 0; j < 8; ++j) ss += o8[j] * o8[j];
      ss = red8(ss);
      float rs = rsqrtf(ss * (1.f / 64.f) + 1e-6f);
      bf16r* gp = proj + (size_t)t * PD + GDN_GATE + h * 64 + j0;
      float g8[8], y8[8];
      unpack8(*(const uint4*)gp, g8);
#pragma unroll
      for (int j = 0; j < 8; ++j) y8[j] = o8[j] * rs * p.gdn_norm_w[l * 64 + j0 + j] * siluf_(g8[j]);
      *(uint4*)gp = pack8(y8);
    } else if (br == 1) {
      float sm = 0.f;
#pragma unroll
      for (int j = 0; j < 8; ++j) sm += o8[j];
      sm = red8(sm);
      float mean = sm * (1.f / 64.f);
      float sv = 0.f;
#pragma unroll
      for (int j = 0; j < 8; ++j) { float d = o8[j] - mean; sv += d * d; }
      sv = red8(sv);
      float rs = rsqrtf(sv * (1.f / 64.f) + 64e-5f);
      float bs = 0.f;
      const int ch0 = h * 64 + j0;
#pragma unroll
      for (int j = 0; j < 8; ++j) bs += sQ[tt * 64 + j0 + j] * sK[tt * 64 + j0 + j] * p.r_k[l * 512 + ch0 + j];
      bs = red8(bs);
      const float* mu = p.mu + (size_t)l * 2176;
      bf16r* gp = proj + (size_t)t * PD + RWKV_B + 1664 + ch0;
      const bf16r* gpp = (tt == 0) ? (halo + (size_t)(c - 1) * 2176 + 1664 + ch0) : (gp - PD);
      float cur[8], prv[8], y8[8];
      unpack8(*(const uint4*)gp, cur);
      if (t > 0) unpack8(*(const uint4*)gpp, prv);
      else {
#pragma unroll
        for (int j = 0; j < 8; ++j) prv[j] = 0.f;
      }
#pragma unroll
      for (int j = 0; j < 8; ++j) {
        float gt = cur[j] + mu[1664 + ch0 + j] * (prv[j] - cur[j]);
        float on = (o8[j] - mean) * rs * p.ln_w[l * 512 + ch0 + j] + p.ln_b[l * 512 + ch0 + j];
        on += bs * sV[tt * 64 + j0 + j];
        y8[j] = on * siluf_(gt);
      }
      __syncthreads();
      *(uint4*)gp = pack8(y8);
    } else {
      bf16r* op = proj + (size_t)t * PD + HGRN_B + h * 64 + j0;
      *(uint4*)op = pack8(o8);
    }
  }
}

__device__ void hgrn_norm_phase(const Params& p, int l) {
  bf16r* proj = (bf16r*)(wsp(p) + OFF_PROJ);
  const int tid_ = opaque(threadIdx.x);
  const int lane = tid_ & 63;
  const int gw = blockIdx.x * (NTHR / 64) + (tid_ >> 6);
  const int nw = gridDim.x * (NTHR / 64);
  for (int t = gw; t < T; t += nw) {
    float o8[8], g8[8], y8[8];
    unpack8(*(const uint4*)(proj + (size_t)t * PD + HGRN_B + lane * 8), o8);
    bf16r* gp = proj + (size_t)t * PD + HGRN_B + 1536 + lane * 8;
    unpack8(*(const uint4*)gp, g8);
    float ss = 0.f;
#pragma unroll
    for (int j = 0; j < 8; ++j) ss += o8[j] * o8[j];
    ss = red64(ss);
    float rs = rsqrtf(ss * (1.f / 512.f) + 1e-6f);
#pragma unroll
    for (int j = 0; j < 8; ++j) y8[j] = o8[j] * rs * p.hgrn_norm_w[l * 512 + lane * 8 + j] * siluf_(g8[j]);
    *(uint4*)gp = pack8(y8);
  }
}


__device__ __forceinline__ void mm64(const bf16r* A, const bf16r* Bt, int lane, int wid, f32x4& c0, f32x4& c1) {
  const int fr = lane & 15, fq = lane >> 4, rt = wid >> 1, ct = (wid & 1) * 2;
#pragma unroll
  for (int s2 = 0; s2 < 2; ++s2) {
    bf16x8 a = *(const bf16x8*)(A + (rt * 16 + fr) * LS + s2 * 32 + fq * 8);
    bf16x8 b0 = *(const bf16x8*)(Bt + (ct * 16 + fr) * LS + s2 * 32 + fq * 8);
    bf16x8 b1 = *(const bf16x8*)(Bt + ((ct + 1) * 16 + fr) * LS + s2 * 32 + fq * 8);
    c0 = __builtin_amdgcn_mfma_f32_16x16x32_bf16(a, b0, c0, 0, 0, 0);
    c1 = __builtin_amdgcn_mfma_f32_16x16x32_bf16(a, b1, c1, 0, 0, 0);
  }
}

typedef short s16x4 __attribute__((ext_vector_type(4)));
__device__ __forceinline__ bf16x8 frag_tr(const bf16r* img, int ntile, int s2, int lane) {
  const int g = lane >> 4, q = (lane & 15) >> 2, pp = lane & 3;
  const bf16r* a0 = img + (32 * s2 + 8 * g + q) * LS + 16 * ntile + 4 * pp;
  s16x4 lo = __builtin_amdgcn_ds_read_tr16_b64_v4i16((__attribute__((address_space(3))) s16x4*)a0);
  s16x4 hi = __builtin_amdgcn_ds_read_tr16_b64_v4i16((__attribute__((address_space(3))) s16x4*)(a0 + 4 * LS));
  return bf16x8{lo[0], lo[1], lo[2], lo[3], hi[0], hi[1], hi[2], hi[3]};
}
template <bool ATR, bool BTR>
__device__ __forceinline__ void mm64t(const bf16r* A, const bf16r* B, int lane, int wid, f32x4& c0, f32x4& c1) {
  const int fr = lane & 15, fq = lane >> 4, rt = wid >> 1, ct = (wid & 1) * 2;
#pragma unroll
  for (int s2 = 0; s2 < 2; ++s2) {
    bf16x8 a, b0, b1;
    if (ATR) a = frag_tr(A, rt, s2, lane);
    else a = *(const bf16x8*)(A + (rt * 16 + fr) * LS + s2 * 32 + fq * 8);
    if (BTR) { b0 = frag_tr(B, ct, s2, lane); b1 = frag_tr(B, ct + 1, s2, lane); }
    else {
      b0 = *(const bf16x8*)(B + (ct * 16 + fr) * LS + s2 * 32 + fq * 8);
      b1 = *(const bf16x8*)(B + ((ct + 1) * 16 + fr) * LS + s2 * 32 + fq * 8);
    }
    c0 = __builtin_amdgcn_mfma_f32_16x16x32_bf16(a, b0, c0, 0, 0, 0);
    c1 = __builtin_amdgcn_mfma_f32_16x16x32_bf16(a, b1, c1, 0, 0, 0);
  }
}

__device__ __forceinline__ void cumsum_tokens(float* v, float* tot, float* sTot, int lane, int wid, int j0) {
#pragma unroll
  for (int d = 8; d < 64; d <<= 1) {
#pragma unroll
    for (int j = 0; j < 8; ++j) {
      float x = __shfl_up(v[j], d);
      if (lane >= d) v[j] += x;
    }
  }
  if ((lane >> 3) == 7) {
#pragma unroll
    for (int j = 0; j < 8; ++j) sTot[wid * 64 + j0 + j] = v[j];
  }
  __syncthreads();
#pragma unroll
  for (int j = 0; j < 8; ++j) tot[j] = 0.f;
#pragma unroll
  for (int w = 0; w < 8; ++w) {
#pragma unroll
    for (int j = 0; j < 8; ++j) {
      float x = sTot[w * 64 + j0 + j];
      if (w < wid) v[j] += x;
      tot[j] += x;
    }
  }
}

__device__ __forceinline__ void store_nacc(bf16r* nb, int lane, int wid, const f32x4& c0, const f32x4& c1) {
  const int rt = wid >> 1, ct = (wid & 1) * 2;
  *(uint2*)(nb + ((ct * 4 + rt) * 64 + lane) * 4) = uint2{cvt_pk_bf16(c0[0], c0[1]), cvt_pk_bf16(c0[2], c0[3])};
  *(uint2*)(nb + (((ct + 1) * 4 + rt) * 64 + lane) * 4) = uint2{cvt_pk_bf16(c1[0], c1[1]), cvt_pk_bf16(c1[2], c1[3])};
}

__device__ __forceinline__ void touch_prep(const Params& p, int c, int hh, int tid, unsigned& ta, unsigned& tb) {
  const bf16r* proj = (const bf16r*)(wsp(p) + OFF_PROJ) + (size_t)c * 64 * PD;
  const int br = hh >> 3, h = hh & 7;
  const int nper = (br == 1) ? 6 : 3;
  if (tid < 64 * nper) {
    const int row = (br == 1) ? tid / 6 : tid / 3, si = tid - row * nper;
    int col;
    if (br == 0) col = si * 512 + h * 64;
    else if (br == 2) col = HGRN_B + si * 512 + h * 64;
    else col = RWKV_B + (si < 3 ? si * 512 + h * 64 : (si == 3 ? 1664 + h * 64 : (si == 4 ? 1536 : 1600)));
    const unsigned* a = (const unsigned*)(proj + (size_t)row * PD + col);
    ta = a[0];
    tb = a[31];
  }
}

__device__ __forceinline__ void hgrn_load(const Params& p, int l, int t, int h, int j0, float* q, float* lg, float* k, float* v) {
  const bf16r* proj = (const bf16r*)(wsp(p) + OFF_PROJ);
  const float* lb = (const float*)(wsp(p) + OFF_LB) + l * 512;
  const bf16r* pc = proj + (size_t)t * PD + HGRN_B + h * 64 + j0;
  float q8[8], f8[8];
  unpack8(*(const uint4*)(pc), q8);
  unpack8(*(const uint4*)(pc + 512), f8);
  unpack8(*(const uint4*)(pc + 1024), v);
#pragma unroll
  for (int j = 0; j < 8; ++j) {
    float lbv = lb[h * 64 + j0 + j];
    float f = f8[j];
    float sg = sigmoidf_(f);
    float g = lbv + (1.f - lbv) * sg;
    lg[j] = __logf(fmaxf(g, 1e-37f));
    k[j] = (1.f - lbv) * (1.f - sg);
    q[j] = siluf_(q8[j]);
  }
}

__device__ void hgrn_prep(const Params& p, int l, int c, int cl, int h, unsigned char* smem, int nc, int nhh) {
  unsigned ta = 0u, tb = 0u;
  bf16r* sKT = (bf16r*)smem;
  bf16r* sVT = sKT + 64 * LS;
  bf16r* sQt = sVT + 64 * LS;
  bf16r* sKt = sQt + 64 * LS;
  bf16r* sAtt = sKt + 4 * 64 * LS;
  float* sTot = (float*)(sAtt + 64 * LS);
  bf16r* sO0 = sQt;
  const int tid = opaque(threadIdx.x), lane = tid & 63, wid = tid >> 6;
  const int tt = tid >> 3, j0 = (tid & 7) * 8;
  const int fr = lane & 15, fq = lane >> 4, rt = wid >> 1, ct = (wid & 1) * 2;
  const int t = c * 64 + tt;
  float q[8], b[8], k[8], v[8], tot[8];
  hgrn_load(p, l, t, h, j0, q, b, k, v);
  __syncthreads();
  cumsum_tokens(b, tot, sTot, lane, wid, j0);
  float P[4][8];
#pragma unroll
  for (int j = 0; j < 8; ++j) {
    float a0 = sTot[0 * 64 + j0 + j] + sTot[1 * 64 + j0 + j];
    float a1 = sTot[2 * 64 + j0 + j] + sTot[3 * 64 + j0 + j];
    float a2 = sTot[4 * 64 + j0 + j] + sTot[5 * 64 + j0 + j];
    P[0][j] = 0.f; P[1][j] = a0; P[2][j] = a0 + a1; P[3][j] = a0 + a1 + a2;
  }
  const int I = tt >> 4;
  bf16r* pr = (bf16r*)(wsp(p) + OFF_PROJ) + (size_t)t * PD + HGRN_B + h * 64 + j0;
  {
    float qd[8], qt[8], kh[8];
#pragma unroll
    for (int j = 0; j < 8; ++j) {
      float pi = (I == 0) ? P[0][j] : (I == 1 ? P[1][j] : (I == 2 ? P[2][j] : P[3][j]));
      qd[j] = q[j] * __expf(b[j]);
      qt[j] = q[j] * __expf(b[j] - pi);
      kh[j] = k[j] * __expf(tot[j] - b[j]);
    }
    *(uint4*)(sKT + tt * LS + j0) = pack8(kh);
    *(uint4*)(sVT + tt * LS + j0) = pack8(v);
    *(uint4*)(pr) = pack8(qd);
    *(uint4*)(sQt + tt * LS + j0) = pack8(qt);
#pragma unroll
    for (int ii = 0; ii < 4; ++ii) {
      if (ii >= I) {
        float kt[8];
#pragma unroll
        for (int j = 0; j < 8; ++j) kt[j] = k[j] * __expf(fminf(P[ii][j] - b[j], 80.f));
        *(uint4*)(sKt + ii * 64 * LS + tt * LS + j0) = pack8(kt);
      }
    }
    if (tt == 63) {
      float* gam = (float*)(wsp(p) + OFF_GAM) + ((size_t)h * CH + cl) * 64;
#pragma unroll
      for (int j = 0; j < 8; ++j) gam[j0 + j] = __expf(tot[j]);
    }
  }
  __syncthreads();
  {
    f32x4 a0 = {0.f, 0.f, 0.f, 0.f}, a1 = {0.f, 0.f, 0.f, 0.f};
    if (ct <= rt) mm64(sQt, sKt + rt * 64 * LS, lane, wid, a0, a1);
#pragma unroll
    for (int j = 0; j < 4; ++j) {
      int row = rt * 16 + fq * 4 + j;
      int col0 = ct * 16 + fr, col1 = col0 + 16;
      float x0 = (col0 <= row && ct <= rt) ? a0[j] : 0.f;
      float x1 = (col1 <= row && ct + 1 <= rt) ? a1[j] : 0.f;
      sAtt[row * LS + col0] = f2bf(x0);
      sAtt[row * LS + col1] = f2bf(x1);
    }
    f32x4 n0 = {0.f, 0.f, 0.f, 0.f}, n1 = {0.f, 0.f, 0.f, 0.f};
    mm64t<true, true>(sKT, sVT, lane, wid, n0, n1);
    bf16r* nb = (bf16r*)(wsp(p) + OFF_NBUF) + ((size_t)(16 + h) * CH + cl) * 4096;
    store_nacc(nb, lane, wid, n0, n1);
  }
  __syncthreads();
  if (nhh >= 0) touch_prep(p, nc, nhh, tid, ta, tb);
  {
    f32x4 o0 = {0.f, 0.f, 0.f, 0.f}, o1 = {0.f, 0.f, 0.f, 0.f};
    mm64t<false, true>(sAtt, sVT, lane, wid, o0, o1);
#pragma unroll
    for (int j = 0; j < 4; ++j) {
      int row = rt * 16 + fq * 4 + j;
      sO0[row * LS + ct * 16 + fr] = f2bf(o0[j]);
      sO0[row * LS + (ct + 1) * 16 + fr] = f2bf(o1[j]);
    }
  }
  __syncthreads();
  *(uint4*)(pr + 1024) = *(const uint4*)(sO0 + tt * LS + j0);
  asm volatile("" ::"v"(ta), "v"(tb));
}

__device__ void hgrn_output(const Params& p, int l, int c, int cl, int h, unsigned char* smem) {
  bf16r* sP = (bf16r*)smem;
  bf16r* sHT = sP + 64 * LS;
  float* sO = (float*)(sHT + 64 * LS);
  const int tid = opaque(threadIdx.x), lane = tid & 63, wid = tid >> 6;
  const int tt = tid >> 3, j0 = (tid & 7) * 8;
  const int fr = lane & 15, fq = lane >> 4, rt = wid >> 1, ct = (wid & 1) * 2;
  const int t = c * 64 + tt;
  bf16r* pr = (bf16r*)(wsp(p) + OFF_PROJ) + (size_t)t * PD + HGRN_B + h * 64 + j0;
  const uint4 p_raw = *(const uint4*)(pr);
  const uint4 o0_raw = *(const uint4*)(pr + 1024);
  const uint4 ht_raw = *(const uint4*)((const bf16r*)(wsp(p) + OFF_HTBUF) + ((size_t)(16 + h) * CH + cl) * 4096 + tt * 64 + j0);
  __syncthreads();
  *(uint4*)(sP + tt * LS + j0) = p_raw;
  *(uint4*)(sHT + tt * LS + j0) = ht_raw;
  __syncthreads();
  {
    f32x4 c0 = {0.f, 0.f, 0.f, 0.f}, c1 = {0.f, 0.f, 0.f, 0.f};
    mm64(sP, sHT, lane, wid, c0, c1);
#pragma unroll
    for (int j = 0; j < 4; ++j) {
      int row = rt * 16 + fq * 4 + j;
      sO[row * FS + ct * 16 + fr] = c0[j];
      sO[row * FS + (ct + 1) * 16 + fr] = c1[j];
    }
  }
  __syncthreads();
  {
    float o8[8], a8[8];
    unpack8(o0_raw, a8);
#pragma unroll
    for (int j = 0; j < 8; ++j) o8[j] = sO[tt * FS + j0 + j] + a8[j];
    *(uint4*)(pr) = pack8(o8);
  }
}

template <int CTRL> __device__ __forceinline__ float quad_bcast(float v) {
  return __int_as_float(__builtin_amdgcn_update_dpp(__float_as_int(v), __float_as_int(v), CTRL, 0xf, 0xf, false));
}
constexpr int SAS = 68;
template <int J0, int PF>
__device__ __forceinline__ void tri_solve_part(const float* abase, f32x2_t (&x2)[8], f32x4 (&ab)[PF + 1][4]) {
#pragma unroll
  for (int jj = 0; jj < 16; ++jj) {
    const int j = J0 + jj;
    if (j + PF < 64) {
#pragma unroll
      for (int m4 = ((j + PF) >> 4); m4 < 4; ++m4) ab[(j + PF) % (PF + 1)][m4] = *(const f32x4*)(abase + (j + PF) * SAS + m4 * 4);
    }
    __builtin_amdgcn_sched_barrier(0);
    float xj;
    const float xs = (((j >> 2) & 1) == 0) ? x2[j >> 3][0] : x2[j >> 3][1];
    if ((j & 3) == 0) xj = quad_bcast<0x00>(xs);
    else if ((j & 3) == 1) xj = quad_bcast<0x55>(xs);
    else if ((j & 3) == 2) xj = quad_bcast<0xAA>(xs);
    else xj = quad_bcast<0xFF>(xs);
    const f32x2_t xj2 = {xj, xj};
#pragma unroll
    for (int m4 = (j >> 4); m4 < 4; ++m4) {
      const f32x4 a = ab[j % (PF + 1)][m4];
      if (m4 * 4 + 1 >= (j >> 2)) x2[m4 * 2 + 0] = x2[m4 * 2 + 0] - f32x2_t{a[0], a[1]} * xj2;
      if (m4 * 4 + 3 >= (j >> 2)) x2[m4 * 2 + 1] = x2[m4 * 2 + 1] - f32x2_t{a[2], a[3]} * xj2;
    }
  }
}
__device__ __forceinline__ void tri_solve(const float* sAT, int r, float* x) {
  constexpr int PF = 2;
  f32x2_t x2[8];
#pragma unroll
  for (int k = 0; k < 8; ++k) x2[k] = f32x2_t{x[2 * k], x[2 * k + 1]};
  f32x4 ab[PF + 1][4];
  const float* abase = sAT + r * 16;
#pragma unroll
  for (int j = 0; j < PF; ++j) {
#pragma unroll
    for (int m4 = (j >> 4); m4 < 4; ++m4) ab[j % (PF + 1)][m4] = *(const f32x4*)(abase + j * SAS + m4 * 4);
  }
  __builtin_amdgcn_sched_barrier(0);
  tri_solve_part<0, PF>(abase, x2, ab);
  tri_solve_part<16, PF>(abase, x2, ab);
  tri_solve_part<32, PF>(abase, x2, ab);
  tri_solve_part<48, PF>(abase, x2, ab);
#pragma unroll
  for (int k = 0; k < 8; ++k) { x[2 * k] = x2[k][0]; x[2 * k + 1] = x2[k][1]; }
}

__device__ __forceinline__ void gdn_load(const Params& p, int l, int t, int h, int j0, float* cq, float* ck, float* cv,
                                         float& beta, float& g) {
  const bf16r* proj = (const bf16r*)(wsp(p) + OFF_PROJ);
  const float* gsc = (const float*)(wsp(p) + OFF_GSC);
#pragma unroll
  for (int j = 0; j < 8; ++j) { cq[j] = 0.f; ck[j] = 0.f; cv[j] = 0.f; }
  const float* cw = p.conv_w + (size_t)l * 4 * 1536 + h * 64 + j0;
#pragma unroll
  for (int i = 0; i < 4; ++i) {
    int ts = t - 3 + i;
    if (ts >= 0) {
      float fq_[8], fk_[8], fv_[8];
      const int cs = t & ~63;
      const bf16r* pr = (ts >= cs) ? (proj + (size_t)ts * PD + h * 64 + j0)
                                   : ((const bf16r*)(wsp(p) + OFF_HALO2) + ((size_t)((cs >> 6) - 1) * 3 + (ts - cs + 3)) * 1536 + h * 64 + j0);
      unpack8(*(const uint4*)(pr), fq_);
      unpack8(*(const uint4*)(pr + 512), fk_);
      unpack8(*(const uint4*)(pr + 1024), fv_);
#pragma unroll
      for (int j = 0; j < 8; ++j) {
        cq[j] += cw[i * 1536 + j] * fq_[j];
        ck[j] += cw[i * 1536 + 512 + j] * fk_[j];
        cv[j] += cw[i * 1536 + 1024 + j] * fv_[j];
      }
    }
  }
  float sq = 0.f, sk = 0.f;
#pragma unroll
  for (int j = 0; j < 8; ++j) {
    cq[j] = siluf_(cq[j]); ck[j] = siluf_(ck[j]); cv[j] = siluf_(cv[j]);
    sq += cq[j] * cq[j]; sk += ck[j] * ck[j];
  }
  sq = red8(sq); sk = red8(sk);
  float nq = rsqrtf(sq + 1e-6f) * 0.125f, nk = rsqrtf(sk + 1e-6f);
#pragma unroll
  for (int j = 0; j < 8; ++j) { cq[j] *= nq; ck[j] *= nk; }
  beta = sigmoidf_(gsc[t * 16 + h]);
  g = -__expf(p.a_log[l * 8 + h]) * softplusf_(gsc[t * 16 + 8 + h] + p.dt_bias[l * 8 + h]);
}

__device__ __forceinline__ void cumsum_scalar(float g, float* sG, int tt, int js, float& gc, float& gtot) {
  if (js == 0) sG[tt] = g;
  __syncthreads();
  if (threadIdx.x < 64) {
    float v = sG[threadIdx.x];
#pragma unroll
    for (int d = 1; d < 64; d <<= 1) {
      float x = __shfl_up(v, d);
      if ((int)threadIdx.x >= d) v += x;
    }
    sG[64 + threadIdx.x] = v;
  }
  __syncthreads();
  gc = sG[64 + tt];
  gtot = sG[64 + 63];
}

__device__ void gdn_prep(const Params& p, int l, int c, int cl, int h, unsigned char* smem, int nc, int nhh) {
  unsigned ta = 0u, tb = 0u;
  bf16r* sK = (bf16r*)smem;
  bf16r* sKdT = sK + 64 * LS;
  bf16r* sXT = sKdT + 64 * LS;
  bf16r* sQ = sXT + 128 * LS;
  bf16r* sAtt = sQ + 64 * LS;
  float* sAT = (float*)(sAtt + 64 * LS);
  float* sR = sAT + 64 * SAS;
  float* sQdF = sR + 64 * 136;
  float* sG = sQdF + 64 * FS;
  float* sGc = sG + 64;
  float* sBeta = sGc + 64;
  bf16r* sM = sQ;
  bf16r* sP = (bf16r*)sR;
  bf16r* sO0 = sP + 64 * LS;
  const int tid = opaque(threadIdx.x), lane = tid & 63, wid = tid >> 6;
  const int tt = tid >> 3, js = tid & 7, j0 = js * 8;
  const int fr = lane & 15, fq = lane >> 4, rt = wid >> 1, ct = (wid & 1) * 2;
  const int t = c * 64 + tt;
  float q[8], k[8], v[8], beta, g, gc, gtot;
  gdn_load(p, l, t, h, j0, q, k, v, beta, g);
  __syncthreads();
  cumsum_scalar(g, sG, tt, js, gc, gtot);
  {
    if (js == 0) { sGc[tt] = gc; sBeta[tt] = beta; }
    *(uint4*)(sK + tt * LS + j0) = pack8(k);
    *(uint4*)(sQ + tt * LS + j0) = pack8(q);
    const float egc = __expf(gc), ekd = __expf(gtot - gc);
    float kd[8];
#pragma unroll
    for (int j = 0; j < 8; ++j) {
      kd[j] = k[j] * ekd;
      sR[tt * 136 + j0 + j] = beta * v[j];
      sR[tt * 136 + 64 + j0 + j] = beta * k[j] * egc;
      sQdF[tt * FS + j0 + j] = q[j] * egc;
    }
    *(uint4*)(sKdT + tt * LS + j0) = pack8(kd);
  }
  __syncthreads();
  {
    f32x4 a0 = {0.f, 0.f, 0.f, 0.f}, a1 = {0.f, 0.f, 0.f, 0.f};
    f32x4 b0 = {0.f, 0.f, 0.f, 0.f}, b1 = {0.f, 0.f, 0.f, 0.f};
    mm64(sK, sK, lane, wid, a0, a1);
    mm64(sQ, sK, lane, wid, b0, b1);
#pragma unroll
    for (int j = 0; j < 4; ++j) {
      int row = rt * 16 + fq * 4 + j;
      float br_ = sBeta[row], gr = sGc[row];
      int c0i = ct * 16 + fr, c1i = c0i + 16;
      float e0 = __expf(fminf(gr - sGc[c0i], 0.f)), e1 = __expf(fminf(gr - sGc[c1i], 0.f));
      sAT[c0i * SAS + (row & 3) * 16 + (row >> 2)] = (c0i < row) ? br_ * a0[j] * e0 : 0.f;
      sAT[c1i * SAS + (row & 3) * 16 + (row >> 2)] = (c1i < row) ? br_ * a1[j] * e1 : 0.f;
      sAtt[row * LS + c0i] = f2bf((c0i <= row) ? b0[j] * e0 : 0.f);
      sAtt[row * LS + c1i] = f2bf((c1i <= row) ? b1[j] * e1 : 0.f);
    }
  }
  __syncthreads();
  if (nhh >= 0) touch_prep(p, nc, nhh, tid, ta, tb);
  {
    const int col = tid >> 2, r = tid & 3;
    float x[16];
#pragma unroll
    for (int m = 0; m < 16; ++m) x[m] = sR[(4 * m + r) * 136 + col];
    tri_solve(sAT, r, x);
#pragma unroll
    for (int m = 0; m < 16; ++m) sXT[col * LS + 4 * m + r] = f2bf(x[m]);
  }
  __syncthreads();
  {
    f32x4 n0 = {0.f, 0.f, 0.f, 0.f}, n1 = {0.f, 0.f, 0.f, 0.f}, w0 = {0.f, 0.f, 0.f, 0.f}, w1 = {0.f, 0.f, 0.f, 0.f};
    f32x4 p0 = {0.f, 0.f, 0.f, 0.f}, p1 = {0.f, 0.f, 0.f, 0.f}, o0 = {0.f, 0.f, 0.f, 0.f}, o1 = {0.f, 0.f, 0.f, 0.f};
    mm64t<true, false>(sKdT, sXT, lane, wid, n0, n1);
    mm64t<true, false>(sKdT, sXT + 64 * LS, lane, wid, w0, w1);
    mm64(sAtt, sXT + 64 * LS, lane, wid, p0, p1);
    mm64(sAtt, sXT, lane, wid, o0, o1);
    bf16r* nb = (bf16r*)(wsp(p) + OFF_NBUF) + ((size_t)h * CH + cl) * 4096;
    store_nacc(nb, lane, wid, n0, n1);
    const float eg = __expf(gtot);
#pragma unroll
    for (int j = 0; j < 4; ++j) {
      int row = rt * 16 + fq * 4 + j;
      int c0i = ct * 16 + fr, c1i = c0i + 16;
      sM[row * LS + c0i] = f2bf((row == c0i ? eg : 0.f) - w0[j]);
      sM[row * LS + c1i] = f2bf((row == c1i ? eg : 0.f) - w1[j]);
      sP[row * LS + c0i] = f2bf(sQdF[row * FS + c0i] - p0[j]);
      sP[row * LS + c1i] = f2bf(sQdF[row * FS + c1i] - p1[j]);
      sO0[row * LS + c0i] = f2bf(o0[j]);
      sO0[row * LS + c1i] = f2bf(o1[j]);
    }
  }
  __syncthreads();
  {
    const int fi = tid >> 6, s2 = fi & 1, rtm = fi >> 1;
    const int row = rtm * 16 + fr;
    uint2 lo = *(const uint2*)(sM + row * LS + (2 * s2) * 16 + fq * 4);
    uint2 hi = *(const uint2*)(sM + row * LS + (2 * s2 + 1) * 16 + fq * 4);
    bf16r* mb = (bf16r*)(wsp(p) + OFF_MBUF) + ((size_t)h * CH + cl) * 4096;
    *(uint4*)(mb + (fi * 64 + lane) * 8) = uint4{lo.x, lo.y, hi.x, hi.y};
    bf16r* pr = (bf16r*)(wsp(p) + OFF_PROJ) + (size_t)t * PD + h * 64 + j0;
    *(uint4*)(pr) = *(const uint4*)(sP + tt * LS + j0);
    *(uint4*)(pr + 1024) = *(const uint4*)(sO0 + tt * LS + j0);
  }
  asm volatile("" ::"v"(ta), "v"(tb));
}

__device__ void gdn_output(const Params& p, int l, int c, int cl, int h, unsigned char* smem) {
  bf16r* sP = (bf16r*)smem;
  bf16r* sHT = sP + 64 * LS;
  float* sO = (float*)(sHT + 64 * LS);
  const int tid = opaque(threadIdx.x), lane = tid & 63, wid = tid >> 6;
  const int tt = tid >> 3, js = tid & 7, j0 = js * 8;
  const int fr = lane & 15, fq = lane >> 4, rt = wid >> 1, ct = (wid & 1) * 2;
  const int t = c * 64 + tt;
  bf16r* pr = (bf16r*)(wsp(p) + OFF_PROJ) + (size_t)t * PD + h * 64 + j0;
  const uint4 p_raw = *(const uint4*)(pr);
  const uint4 o0_raw = *(const uint4*)(pr + 1024);
  const uint4 ht_raw = *(const uint4*)((const bf16r*)(wsp(p) + OFF_HTBUF) + ((size_t)h * CH + cl) * 4096 + tt * 64 + j0);
  bf16r* gp = pr + GDN_GATE;
  const uint4 gate_raw = *(const uint4*)gp;
  __syncthreads();
  *(uint4*)(sP + tt * LS + j0) = p_raw;
  *(uint4*)(sHT + tt * LS + j0) = ht_raw;
  __syncthreads();
  {
    f32x4 c0 = {0.f, 0.f, 0.f, 0.f}, c1 = {0.f, 0.f, 0.f, 0.f};
    mm64(sP, sHT, lane, wid, c0, c1);
#pragma unroll
    for (int j = 0; j < 4; ++j) {
      int row = rt * 16 + fq * 4 + j;
      sO[row * FS + ct * 16 + fr] = c0[j];
      sO[row * FS + (ct + 1) * 16 + fr] = c1[j];
    }
  }
  __syncthreads();
  {
    float o8[8], a8[8], g8[8], y8[8], ss = 0.f;
    unpack8(o0_raw, a8);
    unpack8(gate_raw, g8);
#pragma unroll
    for (int j = 0; j < 8; ++j) { o8[j] = sO[tt * FS + j0 + j] + a8[j]; ss += o8[j] * o8[j]; }
    ss = red8(ss);
    float rs = rsqrtf(ss * (1.f / 64.f) + 1e-6f);
#pragma unroll
    for (int j = 0; j < 8; ++j) y8[j] = o8[j] * rs * p.gdn_norm_w[l * 64 + j0 + j] * siluf_(g8[j]);
    *(uint4*)gp = pack8(y8);
  }
}

__device__ __forceinline__ float tanh_fast(float x) { return 1.f - 2.f * __builtin_amdgcn_rcpf(1.f + __expf(2.f * x)); }
__device__ __forceinline__ void rwkv_load(const Params& p, int l, int c, int tt, int h, int j0, unsigned char* smem,
                                          float* r8, float* k8, float* v8, float* kk8, float* ic8, float* lw8) {
  bf16r* tA1 = (bf16r*)smem;
  bf16r* tA2 = tA1 + 64 * LS;
  bf16r* tB1 = tA2 + 64 * LS;
  bf16r* tB2 = tB1 + 64 * LS;
  float* res1 = (float*)(tB2 + 64 * LS);
  float* res2 = res1 + 4096;
  const bf16r* proj = (const bf16r*)(wsp(p) + OFF_PROJ);
  const bf16r* halo = (const bf16r*)(wsp(p) + OFF_HALO);
  const bf16r* lora = (const bf16r*)(wsp(p) + OFF_LORA);
  const int t = c * 64 + tt;
  const int tid = tt * 8 + (j0 >> 3), lane = tid & 63, wid = tid >> 6;
  const float* mu = p.mu + (size_t)l * 2176;
  const bf16r* pc = proj + (size_t)t * PD + RWKV_B;
  const bf16r* pp = (tt == 0) ? (halo + (size_t)(c - 1) * 2176) : (pc - PD);
  const bool hasprev = (t > 0);
  const int ch0 = h * 64 + j0;
  {
    float wd[8], ad[8];
    shifted8(pc, pp, mu, hasprev, 1536 + j0, wd);
    shifted8(pc, pp, mu, hasprev, 1600 + j0, ad);
#pragma unroll
    for (int j = 0; j < 8; ++j) wd[j] = tanh_fast(wd[j]);
    *(uint4*)(tA1 + tt * LS + j0) = pack8(wd);
    *(uint4*)(tA2 + tt * LS + j0) = pack8(ad);
    *(uint4*)(tB1 + tt * LS + j0) = *(const uint4*)(lora + (size_t)(h * 64 + tt) * 64 + j0);
    *(uint4*)(tB2 + tt * LS + j0) = *(const uint4*)(lora + (size_t)(512 + h * 64 + tt) * 64 + j0);
  }
  shifted8(pc, pp, mu, hasprev, ch0, r8);
  shifted8(pc, pp, mu, hasprev, 512 + ch0, k8);
  shifted8(pc, pp, mu, hasprev, 1024 + ch0, v8);
  __syncthreads();
  {
    f32x4 a0 = {0.f, 0.f, 0.f, 0.f}, a1 = {0.f, 0.f, 0.f, 0.f}, b0 = {0.f, 0.f, 0.f, 0.f}, b1 = {0.f, 0.f, 0.f, 0.f};
    mm64(tA1, tB1, lane, wid, a0, a1);
    mm64(tA2, tB2, lane, wid, b0, b1);
    const int fr = lane & 15, fq = lane >> 4, rt = wid >> 1, ct = (wid & 1) * 2;
#pragma unroll
    for (int j = 0; j < 4; ++j) {
      int row = rt * 16 + fq * 4 + j;
      res1[row * 64 + ct * 16 + fr] = a0[j];
      res1[row * 64 + (ct + 1) * 16 + fr] = a1[j];
      res2[row * 64 + ct * 16 + fr] = b0[j];
      res2[row * 64 + (ct + 1) * 16 + fr] = b1[j];
    }
  }
  __syncthreads();
  float aw[8], aa[8];
#pragma unroll
  for (int j = 0; j < 8; ++j) {
    aw[j] = p.w0[l * 512 + ch0 + j] + res1[tt * 64 + j0 + j];
    aa[j] = p.a0[l * 512 + ch0 + j] + res2[tt * 64 + j0 + j];
  }
  float ssk = 0.f;
#pragma unroll
  for (int j = 0; j < 8; ++j) { kk8[j] = k8[j] * p.k_k[l * 512 + ch0 + j]; ssk += kk8[j] * kk8[j]; }
  ssk = red8(ssk);
  const float nk = rsqrtf(ssk + 1e-6f);
#pragma unroll
  for (int j = 0; j < 8; ++j) {
    float w_raw = -softplusf_(-aw[j]) - 0.5f;
    lw8[j] = -__expf(w_raw);
    ic8[j] = sigmoidf_(aa[j]);
    kk8[j] *= nk;
    k8[j] = k8[j] * (1.f + (ic8[j] - 1.f) * p.k_a[l * 512 + ch0 + j]);
  }
}

__device__ void rwkv_prep(const Params& p, int l, int c, int cl, int h, unsigned char* smem, int nc, int nhh) {
  unsigned ta = 0u, tb = 0u;
  bf16r* sAt = (bf16r*)smem;
  bf16r* sRt = sAt + 64 * LS;
  bf16r* sBK = sRt + 64 * LS;
  bf16r* sVT = sBK + 128 * LS;
  bf16r* sBhT = sVT + 64 * LS;
  bf16r* sKhT = sBhT + 64 * LS;
  bf16r* sMak = sKhT + 64 * LS;
  bf16r* sMrb = sMak + 64 * LS;
  bf16r* sMrk = sMrb + 64 * LS;
  float* sAT = (float*)(sMrk + 64 * LS);
  float* sR = sAT + 64 * SAS;
  float* sTot = sR + 64 * FS;
  bf16r* sXT = sBK;
  bf16r* sM = sMak;
  bf16r* sP = (bf16r*)sAT;
  bf16r* sO0 = (bf16r*)sR;
  const int tid = opaque(threadIdx.x), lane = tid & 63, wid = tid >> 6;
  const int tt = tid >> 3, js = tid & 7, j0 = js * 8;
  const int fr = lane & 15, fq = lane >> 4, rt = wid >> 1, ct = (wid & 1) * 2;
  const int t = c * 64 + tt;
  float r8[8], k8[8], v8[8], kk8[8], ic8[8], lc[8], tot[8];
  __syncthreads();
  rwkv_load(p, l, c, tt, h, j0, smem, r8, k8, v8, kk8, ic8, lc);
  float lw[8];
#pragma unroll
  for (int j = 0; j < 8; ++j) lw[j] = lc[j];
  cumsum_tokens(lc, tot, sTot, lane, wid, j0);
  uint4 v_pk;
  {
    float at[8], rt_[8], bt[8], kt[8], bh[8], kh[8], bs = 0.f;
#pragma unroll
    for (int j = 0; j < 8; ++j) {
      float eil = __expf(-lc[j]), ekd = __expf(tot[j] - lc[j]);
      at[j] = -kk8[j] * __expf(lc[j] - lw[j]);
      rt_[j] = r8[j] * __expf(lc[j]);
      float b = kk8[j] * ic8[j];
      bt[j] = b * eil;
      kt[j] = k8[j] * eil;
      bs += r8[j] * k8[j] * p.r_k[l * 512 + h * 64 + j0 + j];
      bh[j] = b * ekd;
      kh[j] = k8[j] * ekd;
    }
    bs = red8(bs);
    if (js == 0) ((float*)(wsp(p) + OFF_BON))[t * 8 + h] = bs;
    v_pk = pack8(v8);
    *(uint4*)(sVT + tt * LS + j0) = v_pk;
    *(uint4*)(sBhT + tt * LS + j0) = pack8(bh);
    *(uint4*)(sKhT + tt * LS + j0) = pack8(kh);
    *(uint4*)(sAt + tt * LS + j0) = pack8(at);
    *(uint4*)(sRt + tt * LS + j0) = pack8(rt_);
    *(uint4*)(sBK + tt * LS + j0) = pack8(bt);
    *(uint4*)(sBK + (64 + tt) * LS + j0) = pack8(kt);
  }
  __syncthreads();
  {
    f32x4 a0 = {0.f, 0.f, 0.f, 0.f}, a1 = {0.f, 0.f, 0.f, 0.f}, b0 = {0.f, 0.f, 0.f, 0.f}, b1 = {0.f, 0.f, 0.f, 0.f};
    f32x4 e0 = {0.f, 0.f, 0.f, 0.f}, e1 = {0.f, 0.f, 0.f, 0.f}, f0 = {0.f, 0.f, 0.f, 0.f}, f1 = {0.f, 0.f, 0.f, 0.f};
    mm64(sAt, sBK, lane, wid, a0, a1);
    mm64(sAt, sBK + 64 * LS, lane, wid, b0, b1);
    mm64(sRt, sBK, lane, wid, e0, e1);
    mm64(sRt, sBK + 64 * LS, lane, wid, f0, f1);
#pragma unroll
    for (int j = 0; j < 4; ++j) {
      int row = rt * 16 + fq * 4 + j;
      int c0i = ct * 16 + fr, c1i = c0i + 16;
      sAT[c0i * SAS + (row & 3) * 16 + (row >> 2)] = (c0i < row) ? -a0[j] : 0.f;
      sAT[c1i * SAS + (row & 3) * 16 + (row >> 2)] = (c1i < row) ? -a1[j] : 0.f;
      sMak[row * LS + c0i] = f2bf((c0i < row) ? b0[j] : 0.f);
      sMak[row * LS + c1i] = f2bf((c1i < row) ? b1[j] : 0.f);
      sMrb[row * LS + c0i] = f2bf((c0i <= row) ? e0[j] : 0.f);
      sMrb[row * LS + c1i] = f2bf((c1i <= row) ? e1[j] : 0.f);
      sMrk[row * LS + c0i] = f2bf((c0i <= row) ? f0[j] : 0.f);
      sMrk[row * LS + c1i] = f2bf((c1i <= row) ? f1[j] : 0.f);
    }
  }
  __syncthreads();
  {
    f32x4 y0 = {0.f, 0.f, 0.f, 0.f}, y1 = {0.f, 0.f, 0.f, 0.f};
    mm64t<false, true>(sMak, sVT, lane, wid, y0, y1);
#pragma unroll
    for (int j = 0; j < 4; ++j) {
      int row = rt * 16 + fq * 4 + j;
      sR[row * FS + ct * 16 + fr] = y0[j];
      sR[row * FS + (ct + 1) * 16 + fr] = y1[j];
    }
  }
  __syncthreads();
  if (nhh >= 0) touch_prep(p, nc, nhh, tid, ta, tb);
  {
    const int col = tid >> 2, r = tid & 3;
    float x[16];
    if (col < 64) {
#pragma unroll
      for (int m = 0; m < 16; ++m) x[m] = sR[(4 * m + r) * FS + col];
    } else {
#pragma unroll
      for (int m = 0; m < 16; ++m) x[m] = bf2f(sAt[(4 * m + r) * LS + (col - 64)]);
    }
    tri_solve(sAT, r, x);
#pragma unroll
    for (int m = 0; m < 16; ++m) sXT[col * LS + 4 * m + r] = f2bf(x[m]);
  }
  __syncthreads();
  {
    f32x4 n0 = {0.f, 0.f, 0.f, 0.f}, n1 = {0.f, 0.f, 0.f, 0.f}, w0 = {0.f, 0.f, 0.f, 0.f}, w1 = {0.f, 0.f, 0.f, 0.f};
    f32x4 p0 = {0.f, 0.f, 0.f, 0.f}, p1 = {0.f, 0.f, 0.f, 0.f}, o0 = {0.f, 0.f, 0.f, 0.f}, o1 = {0.f, 0.f, 0.f, 0.f};
    mm64t<true, false>(sBhT, sXT, lane, wid, n0, n1);
    mm64t<true, true>(sKhT, sVT, lane, wid, n0, n1);
    mm64t<true, false>(sBhT, sXT + 64 * LS, lane, wid, w0, w1);
    mm64(sMrb, sXT + 64 * LS, lane, wid, p0, p1);
    mm64(sMrb, sXT, lane, wid, o0, o1);
    mm64t<false, true>(sMrk, sVT, lane, wid, o0, o1);
    bf16r* nb = (bf16r*)(wsp(p) + OFF_NBUF) + ((size_t)(8 + h) * CH + cl) * 4096;
    store_nacc(nb, lane, wid, n0, n1);
#pragma unroll
    for (int j = 0; j < 4; ++j) {
      int row = rt * 16 + fq * 4 + j;
      int c0i = ct * 16 + fr, c1i = c0i + 16;
      float gt = 0.f;
#pragma unroll
      for (int w = 0; w < 8; ++w) gt += sTot[w * 64 + row];
      float eg = __expf(gt);
      sM[row * LS + c0i] = f2bf((row == c0i ? eg : 0.f) + w0[j]);
      sM[row * LS + c1i] = f2bf((row == c1i ? eg : 0.f) + w1[j]);
      sP[row * LS + c0i] = f2bf(bf2f(sRt[row * LS + c0i]) + p0[j]);
      sP[row * LS + c1i] = f2bf(bf2f(sRt[row * LS + c1i]) + p1[j]);
      sO0[row * LS + c0i] = f2bf(o0[j]);
      sO0[row * LS + c1i] = f2bf(o1[j]);
    }
  }
  __syncthreads();
  {
    const int fi = tid >> 6, s2 = fi & 1, rtm = fi >> 1;
    const int row = rtm * 16 + fr;
    uint2 lo = *(const uint2*)(sM + row * LS + (2 * s2) * 16 + fq * 4);
    uint2 hi = *(const uint2*)(sM + row * LS + (2 * s2 + 1) * 16 + fq * 4);
    bf16r* mb = (bf16r*)(wsp(p) + OFF_MBUF) + ((size_t)(8 + h) * CH + cl) * 4096;
    *(uint4*)(mb + (fi * 64 + lane) * 8) = uint4{lo.x, lo.y, hi.x, hi.y};
    bf16r* pr = (bf16r*)(wsp(p) + OFF_PROJ) + (size_t)t * PD + RWKV_B + h * 64 + j0;
    *(uint4*)(pr) = *(const uint4*)(sP + tt * LS + j0);
    *(uint4*)(pr + 512) = *(const uint4*)(sO0 + tt * LS + j0);
    *(uint4*)(pr + 1024) = v_pk;
  }
  asm volatile("" ::"v"(ta), "v"(tb));
}

__device__ void rwkv_output(const Params& p, int l, int c, int cl, int h, unsigned char* smem) {
  bf16r* sP = (bf16r*)smem;
  bf16r* sHT = sP + 64 * LS;
  float* sO = (float*)(sHT + 64 * LS);
  const int tid = opaque(threadIdx.x), lane = tid & 63, wid = tid >> 6;
  const int tt = tid >> 3, js = tid & 7, j0 = js * 8;
  const int fr = lane & 15, fq = lane >> 4, rt = wid >> 1, ct = (wid & 1) * 2;
  const int t = c * 64 + tt;
  const int ch0 = h * 64 + j0;
  bf16r* pr = (bf16r*)(wsp(p) + OFF_PROJ) + (size_t)t * PD + RWKV_B + ch0;
  const uint4 p_raw = *(const uint4*)(pr);
  const uint4 o0_raw = *(const uint4*)(pr + 512);
  const uint4 v_raw = *(const uint4*)(pr + 1024);
  const uint4 ht_raw = *(const uint4*)((const bf16r*)(wsp(p) + OFF_HTBUF) + ((size_t)(8 + h) * CH + cl) * 4096 + tt * 64 + j0);
  bf16r* gp = pr + 1664;
  const uint4 gate_cur = *(const uint4*)gp;
  uint4 gate_prv = uint4{0u, 0u, 0u, 0u};
  if (t > 0) gate_prv = (tt == 0) ? *(const uint4*)((const bf16r*)(wsp(p) + OFF_HALO) + (size_t)(c - 1) * 2176 + 1664 + ch0) : *(const uint4*)(gp - PD);
  const float bs = ((const float*)(wsp(p) + OFF_BON))[t * 8 + h];
  __syncthreads();
  *(uint4*)(sP + tt * LS + j0) = p_raw;
  *(uint4*)(sHT + tt * LS + j0) = ht_raw;
  __syncthreads();
  {
    f32x4 c0 = {0.f, 0.f, 0.f, 0.f}, c1 = {0.f, 0.f, 0.f, 0.f};
    mm64(sP, sHT, lane, wid, c0, c1);
#pragma unroll
    for (int j = 0; j < 4; ++j) {
      int row = rt * 16 + fq * 4 + j;
      sO[row * FS + ct * 16 + fr] = c0[j];
      sO[row * FS + (ct + 1) * 16 + fr] = c1[j];
    }
  }
  __syncthreads();
  {
    float o8[8], a8[8], v8[8], cur[8], prv[8], y8[8], sm = 0.f;
    unpack8(o0_raw, a8);
    unpack8(v_raw, v8);
    unpack8(gate_cur, cur);
    unpack8(gate_prv, prv);
#pragma unroll
    for (int j = 0; j < 8; ++j) { o8[j] = sO[tt * FS + j0 + j] + a8[j]; sm += o8[j]; }
    sm = red8(sm);
    const float mean = sm * (1.f / 64.f);
    float sv = 0.f;
#pragma unroll
    for (int j = 0; j < 8; ++j) { float d = o8[j] - mean; sv += d * d; }
    sv = red8(sv);
    const float rs = rsqrtf(sv * (1.f / 64.f) + 64e-5f);
    const float* mu = p.mu + (size_t)l * 2176;
#pragma unroll
    for (int j = 0; j < 8; ++j) {
      float gt = cur[j] + mu[1664 + ch0 + j] * (prv[j] - cur[j]);
      float on = (o8[j] - mean) * rs * p.ln_w[l * 512 + ch0 + j] + p.ln_b[l * 512 + ch0 + j];
      on += bs * v8[j];
      y8[j] = on * siluf_(gt);
    }
    *(uint4*)gp = pack8(y8);
  }
}

__device__ void scan_phase(const Params& p, int seg, int head, int ns, int lane_) {
  const int lane = opaque(lane_);
  const int fr = lane & 15, fq = lane >> 4;
  const int br = head >> 3;
  f32x4 acc[4];
  float* hst = (float*)(wsp(p) + OFF_HSTATE) + ((size_t)head * 4 + ns) * 1024;
  if (seg == 0) {
#pragma unroll
    for (int rt = 0; rt < 4; ++rt) acc[rt] = f32x4{0.f, 0.f, 0.f, 0.f};
  } else {
#pragma unroll
    for (int rt = 0; rt < 4; ++rt) acc[rt] = *(const f32x4*)(hst + (rt * 64 + lane) * 4);
  }
  const bf16r* nbase = (const bf16r*)(wsp(p) + OFF_NBUF) + (size_t)head * CH * 4096 + (ns * 4 * 64 + lane) * 4;
  bf16r* htbase = (bf16r*)(wsp(p) + OFF_HTBUF) + (size_t)head * CH * 4096 + (ns * 16 + fr) * 64 + fq * 4;
  constexpr int PFD = 4;
  if (br == 2) {
    const float* gbase = (const float*)(wsp(p) + OFF_GAM) + (size_t)(head - 16) * CH * 64 + fq * 4;
    uint2 n[PFD][4];
    f32x4 g[PFD][4];
#pragma unroll
    for (int k = 0; k < PFD; ++k)
#pragma unroll
      for (int rt = 0; rt < 4; ++rt) {
        n[k][rt] = *(const uint2*)(nbase + (size_t)k * 4096 + rt * 256);
        g[k][rt] = *(const f32x4*)(gbase + k * 64 + rt * 16);
      }
#pragma unroll 1
    for (int cl = 0; cl < CH; cl += PFD) {
#pragma unroll
      for (int k = 0; k < PFD; ++k) {
        const int cc = cl + k;
        if (cc >= CH) break;
        uint2 hv[4];
#pragma unroll
        for (int rt = 0; rt < 4; ++rt) {
          hv[rt].x = cvt_pk_bf16(acc[rt][0], acc[rt][1]);
          hv[rt].y = cvt_pk_bf16(acc[rt][2], acc[rt][3]);
          const f32x4 nf = {__uint_as_float(n[k][rt].x << 16), __uint_as_float(n[k][rt].x & 0xffff0000u),
                            __uint_as_float(n[k][rt].y << 16), __uint_as_float(n[k][rt].y & 0xffff0000u)};
          acc[rt] = acc[rt] * g[k][rt] + nf;
        }
#pragma unroll
        for (int rt = 0; rt < 4; ++rt) *(uint2*)(htbase + (size_t)cc * 4096 + rt * 16) = hv[rt];
        const int cn = (cc + PFD < CH) ? cc + PFD : CH - 1;
#pragma unroll
        for (int rt = 0; rt < 4; ++rt) {
          n[k][rt] = *(const uint2*)(nbase + (size_t)cn * 4096 + rt * 256);
          g[k][rt] = *(const f32x4*)(gbase + cn * 64 + rt * 16);
        }
      }
    }
  } else {
    const bf16r* mbase = (const bf16r*)(wsp(p) + OFF_MBUF) + (size_t)head * CH * 4096 + lane * 8;
    uint2 n[PFD][4];
    bf16x8 m[PFD][8];
#pragma unroll
    for (int k = 0; k < PFD; ++k) {
#pragma unroll
      for (int rt = 0; rt < 4; ++rt) n[k][rt] = *(const uint2*)(nbase + (size_t)k * 4096 + rt * 256);
#pragma unroll
      for (int i = 0; i < 8; ++i) m[k][i] = *(const bf16x8*)(mbase + (size_t)k * 4096 + i * 512);
    }
#pragma unroll 1
    for (int cl = 0; cl < CH; cl += PFD) {
#pragma unroll
      for (int k = 0; k < PFD; ++k) {
        const int cc = cl + k;
        if (cc >= CH) break;
        uint4 b0u, b1u;
        b0u.x = cvt_pk_bf16(acc[0][0], acc[0][1]);
        b0u.y = cvt_pk_bf16(acc[0][2], acc[0][3]);
        b0u.z = cvt_pk_bf16(acc[1][0], acc[1][1]);
        b0u.w = cvt_pk_bf16(acc[1][2], acc[1][3]);
        b1u.x = cvt_pk_bf16(acc[2][0], acc[2][1]);
        b1u.y = cvt_pk_bf16(acc[2][2], acc[2][3]);
        b1u.z = cvt_pk_bf16(acc[3][0], acc[3][1]);
        b1u.w = cvt_pk_bf16(acc[3][2], acc[3][3]);
        bf16x8 b0 = *(bf16x8*)&b0u, b1 = *(bf16x8*)&b1u;
#pragma unroll
        for (int rt = 0; rt < 4; ++rt) {
          const f32x4 nf = {__uint_as_float(n[k][rt].x << 16), __uint_as_float(n[k][rt].x & 0xffff0000u),
                            __uint_as_float(n[k][rt].y << 16), __uint_as_float(n[k][rt].y & 0xffff0000u)};
          f32x4 a = __builtin_amdgcn_mfma_f32_16x16x32_bf16(m[k][rt * 2], b0, nf, 0, 0, 0);
          acc[rt] = __builtin_amdgcn_mfma_f32_16x16x32_bf16(m[k][rt * 2 + 1], b1, a, 0, 0, 0);
        }
        *(uint2*)(htbase + (size_t)cc * 4096 + 0) = uint2{b0u.x, b0u.y};
        *(uint2*)(htbase + (size_t)cc * 4096 + 16) = uint2{b0u.z, b0u.w};
        *(uint2*)(htbase + (size_t)cc * 4096 + 32) = uint2{b1u.x, b1u.y};
        *(uint2*)(htbase + (size_t)cc * 4096 + 48) = uint2{b1u.z, b1u.w};
        const int cn = (cc + PFD < CH) ? cc + PFD : CH - 1;
#pragma unroll
        for (int rt = 0; rt < 4; ++rt) n[k][rt] = *(const uint2*)(nbase + (size_t)cn * 4096 + rt * 256);
#pragma unroll
        for (int i = 0; i < 8; ++i) m[k][i] = *(const bf16x8*)(mbase + (size_t)cn * 4096 + i * 512);
      }
    }
  }
#pragma unroll
  for (int rt = 0; rt < 4; ++rt) *(f32x4*)(hst + (rt * 64 + lane) * 4) = acc[rt];
}

__device__ void final_norm_phase(const Params& p) {
  const int tid_ = opaque(threadIdx.x);
  const int lane = tid_ & 63;
  const int gw = blockIdx.x * (NTHR / 64) + (tid_ >> 6);
  const int nw = gridDim.x * (NTHR / 64);
  for (int row = gw; row < T; row += nw) {
    float4* xr = (float4*)(p.out + (size_t)row * DM);
    float4 v[4];
    float ss = 0.f;
#pragma unroll
    for (int i = 0; i < 4; ++i) {
      v[i] = xr[lane + 64 * i];
      ss += v[i].x * v[i].x + v[i].y * v[i].y + v[i].z * v[i].z + v[i].w * v[i].w;
    }
    ss = red64(ss);
    float rs = rsqrtf(ss * (1.f / DM) + 1e-6f);
#pragma unroll
    for (int i = 0; i < 4; ++i) {
      float4 ww = ((const float4*)p.final_norm_w)[lane + 64 * i];
      float4 o;
      o.x = v[i].x * rs * ww.x; o.y = v[i].y * rs * ww.y; o.z = v[i].z * rs * ww.z; o.w = v[i].w * rs * ww.w;
      xr[lane + 64 * i] = o;
    }
  }
}

#define XB_TMO      128
#define XB_XCNT(j)  (256  + 64 * (j))
#define XB_XSUB(j)  (1280 + 64 * (j))
#define XB_XGEN(j)  (2304 + 64 * (j))
#define XB_TOP      3328
#define XB_TOPGEN   3392
#define XCD_BAR_WORDS 3456
#define XB_SPIN_CAP (1u << 18)
#define LAS __attribute__((address_space(3)))
__device__ __forceinline__ unsigned xb_ld(unsigned* p)              { return __hip_atomic_load(p, __ATOMIC_RELAXED, __HIP_MEMORY_SCOPE_AGENT); }
__device__ __forceinline__ unsigned xb_add(unsigned* p, unsigned v) { return __hip_atomic_fetch_add(p, v, __ATOMIC_RELAXED, __HIP_MEMORY_SCOPE_AGENT); }
__device__ __forceinline__ unsigned xb_xcc_id() { return (unsigned)__builtin_amdgcn_s_getreg((3 << 11) | 20) & 0xFu; }
#define XB_SPIN(cond, bar) do { unsigned _sp = 0; while (cond) { __builtin_amdgcn_s_sleep(1); \
    if ((++_sp & 255u) == 0u) { if (xb_ld(&(bar)[XB_TMO])) break; if (_sp > XB_SPIN_CAP) { atomicAdd(&(bar)[XB_TMO], 1u); break; } } } } while (0)
struct XcdBarrier { unsigned* bar; unsigned x; volatile LAS unsigned* st; };
__device__ __forceinline__ XcdBarrier xcd_barrier_post(unsigned* bar, volatile LAS unsigned* st) {
  XcdBarrier b; b.bar = bar; b.x = xb_xcc_id(); b.st = st;
  if (threadIdx.x == 0) (void)xb_add(&bar[XB_XCNT(b.x)], 1u);
  return b;
}
__device__ __forceinline__ void xcd_barrier_complete(unsigned* bar, unsigned x, unsigned& nloc, unsigned& nx) {
  const unsigned G = gridDim.x * gridDim.y * gridDim.z;
  unsigned sum, cnt, mine, sp = 0u;
  for (;;) {
    sum = 0u; cnt = 0u; mine = 0u;
#pragma unroll
    for (unsigned j = 0; j < 16; ++j) { const unsigned c = xb_ld(&bar[XB_XCNT(j)]); sum += c; cnt += (c > 0u) ? 1u : 0u; mine = (j == x) ? c : mine; }
    if (sum == G) break;
    __builtin_amdgcn_s_sleep(1);
    if ((++sp & 255u) == 0u) { if (xb_ld(&bar[XB_TMO])) break; if (sp > XB_SPIN_CAP) { atomicAdd(&bar[XB_TMO], 1u); break; } }
  }
  nloc = mine > 0u ? mine : 1u; nx = cnt > 0u ? cnt : 1u;
}
__device__ __forceinline__ void xcd_barrier(const XcdBarrier& b) {
  asm volatile("s_waitcnt vmcnt(0)" ::: "memory");
  __syncthreads();
  if (threadIdx.x == 0) {
    size_t zb = 0;
    asm volatile("" : "+s"(zb));
    unsigned* bar = b.bar + zb;
    __builtin_amdgcn_s_waitcnt(0);
    unsigned nloc = b.st[0], nx = b.st[1];
    if (nloc == 0u) { xcd_barrier_complete(bar, b.x, nloc, nx); b.st[0] = nloc; b.st[1] = nx; }
    const unsigned old = xb_add(&bar[XB_XSUB(b.x)], 1u);
    const unsigned gen = old / nloc;
    if (old + 1u == (gen + 1u) * nloc) {
      __builtin_amdgcn_fence(__ATOMIC_RELEASE, "agent");
      asm volatile("s_waitcnt vmcnt(0)" ::: "memory");
      const unsigned og = xb_add(&bar[XB_TOP], 1u);
      const unsigned tg = og / nx;
      if (og + 1u == (tg + 1u) * nx) xb_add(&bar[XB_TOPGEN], 1u);
      else XB_SPIN(xb_ld(&bar[XB_TOPGEN]) == tg, bar);
      __builtin_amdgcn_fence(__ATOMIC_ACQUIRE, "agent");
      xb_add(&bar[XB_XGEN(b.x)], 1u);
      asm volatile("s_waitcnt vmcnt(0)" ::: "memory");
    } else {
      XB_SPIN(xb_ld(&bar[XB_XGEN(b.x)]) == gen, bar);
      __builtin_amdgcn_fence(__ATOMIC_ACQUIRE, "agent");
      asm volatile("s_waitcnt vmcnt(0)" ::: "memory");
    }
  }
  __syncthreads();
}

__global__ void __launch_bounds__(NTHR) mega(Params p) {
  cg::grid_group grid = cg::this_grid();
  __shared__ __attribute__((aligned(16))) unsigned char smem[SMEM_BYTES];
  const int nb = gridDim.x, bid = blockIdx.x;
  __shared__ uint4 xb_words;
  if (threadIdx.x == 0) xb_words = make_uint4(0u, 0u, 0u, 0u);
  __syncthreads();
  XcdBarrier xb = xcd_barrier_post((unsigned*)(wsp(p) + OFF_BAR), (volatile LAS unsigned*)&xb_words);
  if (bid == 0) {
    float* lb = (float*)(wsp(p) + OFF_LB);
    int i = threadIdx.x;
    float b0 = p.lbnd[i], b1 = p.lbnd[512 + i];
    float m = fmaxf(b0, b1);
    float e0 = __expf(b0 - m), e1 = __expf(b1 - m);
    lb[i] = 0.f;
    lb[512 + i] = e1 / (e0 + e1);
  }
  grid.sync();
  for (int l = 0; l < 2; ++l) {
    const float* xin = (l == 0) ? p.x : p.out;
    if (l == 0) rows_bf16_rs(xin, (bf16r*)(wsp(p) + OFF_HBF), (float*)(wsp(p) + OFF_RS));
    else reduce_rs((const float*)(wsp(p) + OFF_SSP), (float*)(wsp(p) + OFF_RS));
    for (int tile = bid; tile < 1600 + 384; tile += nb) {
      if (tile < 1600) {
        int kt = tile & 15, ntile = tile >> 4;
        transpose_tile<true>(p.w_in + (size_t)l * DM * NCOL, (bf16r*)(wsp(p) + OFF_WIN), DM, NCOL, kt * 64, ntile * 64, smem, p.norm_w + l * DM);
      } else {
        int tt = tile - 1600;
        int kt = tt % 24, ntile = tt / 24;
        transpose_tile<false>(p.w_out + (size_t)l * DMIX * DM, (bf16r*)(wsp(p) + OFF_WOUT), DMIX, DM, kt * 64, ntile * 64, smem, nullptr);
      }
    }
    {
      bf16r* lora = (bf16r*)(wsp(p) + OFF_LORA);
      for (int e = bid * NTHR + opaque(threadIdx.x); e < 2 * 512 * 8; e += nb * NTHR) {
        int which = e >> 12, ch = (e >> 3) & 511, is = e & 7;
        const float* src = (which ? p.a_up : p.w_up) + (size_t)l * 64 * 512 + ch;
        float f[8];
#pragma unroll
        for (int j = 0; j < 8; ++j) f[j] = src[(is * 8 + j) * 512];
        *(uint4*)(lora + ((size_t)which * 512 + ch) * 64 + is * 8) = pack8(f);
      }
    }
    xcd_barrier(xb);
    {
      pg8::StaticOrder so; so.init(T, PDP, nb, bid);
      pg8::EpiProj ep{wsp(p)};
      __syncthreads();
      pg8::gemm_phase<1>((PG8_LAS unsigned char*)smem, (const bf16r*)(wsp(p) + OFF_HBF), (const bf16r*)(wsp(p) + OFF_WIN), T, PDP, so, ep);
      __syncthreads();
    }
    xcd_barrier(xb);
    for (int seg = 0; seg < NSEG; ++seg) {
      for (int it = bid; it < 24 * CH; it += nb) {
        int hh = it / CH, cl = it % CH;
        if (seg > 0) {
          if (hh < 8) gdn_output(p, l, (seg - 1) * CH + cl, cl, hh, smem);
          else if (hh < 16) rwkv_output(p, l, (seg - 1) * CH + cl, cl, hh - 8, smem);
          else hgrn_output(p, l, (seg - 1) * CH + cl, cl, hh - 16, smem);
        }
        const int it2 = it + nb;
        const int nhh = (it2 < 24 * CH) ? it2 / CH : -1, nc = seg * CH + (it2 % CH);
        if (hh < 8) gdn_prep(p, l, seg * CH + cl, cl, hh, smem, nc, nhh);
        else if (hh < 16) rwkv_prep(p, l, seg * CH + cl, cl, hh - 8, smem, nc, nhh);
        else hgrn_prep(p, l, seg * CH + cl, cl, hh - 16, smem, nc, nhh);
      }
      xcd_barrier(xb);
      if (threadIdx.x < 64 && bid < 96) scan_phase(p, seg, bid >> 2, bid & 3, threadIdx.x);
      xcd_barrier(xb);
    }
    for (int it = bid; it < 24 * CH; it += nb) {
      int hh = it / CH, cl = it % CH;
      if (hh < 8) gdn_output(p, l, (NSEG - 1) * CH + cl, cl, hh, smem);
      else if (hh < 16) rwkv_output(p, l, (NSEG - 1) * CH + cl, cl, hh - 8, smem);
      else hgrn_output(p, l, (NSEG - 1) * CH + cl, cl, hh - 16, smem);
    }
    xcd_barrier(xb);
    hgrn_norm_phase(p, l);
    xcd_barrier(xb);
    {
      pg8::StaticOrder so; so.init(T, DM, nb, bid);
      pg8::EpiResid er{xin, p.out, wsp(p), l == 0};
      __syncthreads();
      pg8::gemm_phase<2>((PG8_LAS unsigned char*)smem, (const bf16r*)(wsp(p) + OFF_PROJ), (const bf16r*)(wsp(p) + OFF_WOUT), T, DM, so, er);
      __syncthreads();
    }
    xcd_barrier(xb);
  }
  final_norm_phase(p);
}

extern "C" void kernel_launch(void* const* d_in, const int* in_sizes, int n_in,
                              void* d_out, int out_size, void* d_ws, size_t ws_size,
                              hipStream_t stream) {
  static int grid_blocks = 0;
  if (!grid_blocks) {
    int dev = 0, cus = 0, per_cu = 0;
    (void)hipGetDevice(&dev);
    (void)hipDeviceGetAttribute(&cus, hipDeviceAttributeMultiprocessorCount, dev);
    (void)hipOccupancyMaxActiveBlocksPerMultiprocessor(&per_cu, mega, NTHR, 0);
    if (per_cu > 1) per_cu = 1;
    if (per_cu < 1) per_cu = 1;
    grid_blocks = cus * per_cu;
  }
  Params p{};
  p.x = (const float*)d_in[0]; p.norm_w = (const float*)d_in[1]; p.w_in = (const float*)d_in[2];
  p.conv_w = (const float*)d_in[3]; p.a_log = (const float*)d_in[4]; p.dt_bias = (const float*)d_in[5];
  p.gdn_norm_w = (const float*)d_in[6]; p.mu = (const float*)d_in[7]; p.w0 = (const float*)d_in[8];
  p.w_up = (const float*)d_in[9]; p.a0 = (const float*)d_in[10]; p.a_up = (const float*)d_in[11];
  p.k_k = (const float*)d_in[12]; p.k_a = (const float*)d_in[13]; p.r_k = (const float*)d_in[14];
  p.ln_w = (const float*)d_in[15]; p.ln_b = (const float*)d_in[16]; p.lbnd = (const float*)d_in[17];
  p.hgrn_norm_w = (const float*)d_in[18]; p.w_out = (const float*)d_in[19]; p.final_norm_w = (const float*)d_in[20];
  p.out = (float*)d_out; p.ws = (unsigned char*)d_ws;
  (void)hipMemsetAsync((unsigned char*)d_ws + OFF_BAR, 0, 16384, stream);
  void* args[] = {&p};
  hipError_t e = hipLaunchCooperativeKernel((void*)mega, dim3(grid_blocks), dim3(NTHR), args, 0, stream);
  if (e != hipSuccess) fprintf(stderr, "coop launch failed: %s\n", hipGetErrorString(e));
}
```

```cpp
#include <hip/hip_runtime.h>
#include <hip/hip_cooperative_groups.h>
#include <cstdio>
namespace cg = cooperative_groups;

typedef unsigned short bf16r;
using bf16x8 = __attribute__((ext_vector_type(8))) short;
using f32x4 = __attribute__((ext_vector_type(4))) float;

constexpr int T = 16384, DM = 1024, NCOL = 6288, PDP = 6400, DMIX = 1536;
constexpr int PD = 6272;
constexpr int GDN_GATE = 1536, RWKV_B = 2048, HGRN_B = 4224;
constexpr int NTHR = 512;
constexpr size_t OFF_PROJ = 0;
constexpr size_t OFF_WOUT = 206045184;
constexpr size_t OFF_GSC = OFF_WOUT + 3145728;
constexpr size_t OFF_HALO = OFF_GSC + 1048576;
constexpr size_t OFF_LB = OFF_HALO + 1179648;
constexpr size_t OFF_LORA = OFF_LB + 4096;
constexpr size_t OFF_BAR = OFF_LORA + 131072;
constexpr size_t OFF_SCR = OFF_BAR + 16384;
constexpr size_t OFF_HBF = OFF_SCR;
constexpr size_t OFF_WIN = OFF_SCR + 33554432;
constexpr int SMEM_BYTES = 131072;
constexpr int CH = 128, NSEG = 2;
constexpr size_t OFF_MBUF = OFF_SCR;
constexpr size_t OFF_GAM = OFF_MBUF + (size_t)16 * CH * 8192;
constexpr size_t OFF_NBUF = OFF_GAM + (size_t)8 * CH * 256;
constexpr size_t OFF_HTBUF = OFF_NBUF;
constexpr size_t OFF_HSTATE = OFF_NBUF + (size_t)24 * CH * 8192;
constexpr size_t OFF_HALO2 = OFF_SCR + 49807360;
constexpr size_t OFF_BON = OFF_HALO2 + 2359296;
constexpr size_t OFF_SSP = OFF_BON + 524288;
constexpr size_t OFF_RS = OFF_SSP + 1048576;
constexpr int LS = 72;
constexpr int FS = 68;

struct Params {
  const float* x; const float* norm_w; const float* w_in; const float* conv_w; const float* a_log;
  const float* dt_bias; const float* gdn_norm_w; const float* mu; const float* w0; const float* w_up;
  const float* a0; const float* a_up; const float* k_k; const float* k_a; const float* r_k;
  const float* ln_w; const float* ln_b; const float* lbnd; const float* hgrn_norm_w; const float* w_out;
  const float* final_norm_w;
  float* out; unsigned char* ws;
};

typedef float f32x2_t __attribute__((ext_vector_type(2)));
typedef __bf16 bf16x2_t __attribute__((ext_vector_type(2)));
__device__ __forceinline__ unsigned char* wsp(const Params& p) {
  size_t z = 0;
  asm volatile("" : "+s"(z));
  return p.ws + z;
}
__device__ __forceinline__ unsigned cvt_pk_bf16(float lo, float hi) {
  f32x2_t f = {lo, hi};
  bf16x2_t b = __builtin_convertvector(f, bf16x2_t);
  return __builtin_bit_cast(unsigned, b);
}
__device__ __forceinline__ bf16r f2bf(float f) { return (bf16r)(cvt_pk_bf16(f, f) & 0xffffu); }
__device__ __forceinline__ int opaque(int v) { asm volatile("" : "+v"(v)); return v; }
__device__ __forceinline__ float bf2f(bf16r h) { return __uint_as_float(((unsigned)h) << 16); }
__device__ __forceinline__ float sigmoidf_(float x) { return __builtin_amdgcn_rcpf(1.f + __expf(-x)); }
__device__ __forceinline__ float siluf_(float x) { return x * __builtin_amdgcn_rcpf(1.f + __expf(-x)); }
__device__ __forceinline__ float softplusf_(float x) { return x > 20.f ? x : __logf(1.f + __expf(x)); }
template <int CTRL> __device__ __forceinline__ float dpp_mov(float v) {
  return __int_as_float(__builtin_amdgcn_update_dpp(0, __float_as_int(v), CTRL, 0xf, 0xf, true));
}
__device__ __forceinline__ float red8(float v) {
  v += dpp_mov<0xB1>(v);
  v += dpp_mov<0x4E>(v);
  v += dpp_mov<0x141>(v);
  return v;
}
__device__ __forceinline__ float red64(float v) {
  v = red8(v);
  v += dpp_mov<0x128>(v);
  v += __shfl_xor(v, 16); v += __shfl_xor(v, 32); return v;
}
__device__ __forceinline__ void unpack8(uint4 u, float* f) {
  f[0] = __uint_as_float(u.x << 16); f[1] = __uint_as_float(u.x & 0xffff0000u);
  f[2] = __uint_as_float(u.y << 16); f[3] = __uint_as_float(u.y & 0xffff0000u);
  f[4] = __uint_as_float(u.z << 16); f[5] = __uint_as_float(u.z & 0xffff0000u);
  f[6] = __uint_as_float(u.w << 16); f[7] = __uint_as_float(u.w & 0xffff0000u);
}
__device__ __forceinline__ uint4 pack8(const float* f) {
  uint4 u;
  u.x = cvt_pk_bf16(f[0], f[1]);
  u.y = cvt_pk_bf16(f[2], f[3]);
  u.z = cvt_pk_bf16(f[4], f[5]);
  u.w = cvt_pk_bf16(f[6], f[7]);
  return u;
}

template <bool SCALE>
__device__ void transpose_tile(const float* __restrict__ src, bf16r* __restrict__ dst, int K, int N, int k0, int n0,
                               unsigned char* smem, const float* __restrict__ kscale) {
  float* tile = (float*)smem;
  const int tid = opaque(threadIdx.x);
  __syncthreads();
#pragma unroll
  for (int i = 0; i < 2; ++i) {
    const int kk = i * 32 + (tid >> 4), n4 = (tid & 15) * 4;
    float4 v = (n0 + n4 < N) ? *(const float4*)(src + (size_t)(k0 + kk) * N + n0 + n4) : float4{0.f, 0.f, 0.f, 0.f};
    if (SCALE) { const float ks = kscale[k0 + kk]; v.x *= ks; v.y *= ks; v.z *= ks; v.w *= ks; }
    tile[kk * 65 + n4 + 0] = v.x; tile[kk * 65 + n4 + 1] = v.y; tile[kk * 65 + n4 + 2] = v.z; tile[kk * 65 + n4 + 3] = v.w;
  }
  __syncthreads();
  int n = tid >> 3, ks = tid & 7;
  float f[8];
#pragma unroll
  for (int j = 0; j < 8; ++j) f[j] = tile[(ks * 8 + j) * 65 + n];
  *(uint4*)(dst + (size_t)(n0 + n) * K + k0 + ks * 8) = pack8(f);
}

template <int MODE>
__device__ void gemm_tile(const Params& p, const float* __restrict__ xin, int mt, int nt, unsigned char* smem) {
  constexpr int K = (MODE == 1) ? 1024 : 1536;
  bf16r* As = (bf16r*)smem;
  bf16r* Bs = As + 256 * LS;
  const bf16r* proj = (const bf16r*)(wsp(p) + OFF_PROJ);
  const bf16r* hbf = (const bf16r*)(wsp(p) + OFF_HBF);
  const bf16r* Bm = (MODE == 1) ? (const bf16r*)(wsp(p) + OFF_WIN) : (const bf16r*)(wsp(p) + OFF_WOUT);
  const int tid = opaque(threadIdx.x), lane = tid & 63, wid = tid >> 6;
  const int wr = wid >> 1, wc = wid & 1, fr = lane & 15, fq = lane >> 4;
  const int m0 = mt * 256, n0 = nt * 128;
  f32x4 acc[4][4];
#pragma unroll
  for (int i = 0; i < 4; ++i)
#pragma unroll
    for (int j = 0; j < 4; ++j) acc[i][j] = f32x4{0.f, 0.f, 0.f, 0.f};
  uint4 ra0, ra1, ra2, ra3, rb0, rb1;
  const int lrow = tid >> 3, lkc = tid & 7;
  const bf16r* aptr;
  if (MODE == 1) aptr = hbf + (size_t)(m0 + lrow) * 1024 + lkc * 8;
  else aptr = proj + (size_t)(m0 + lrow) * PD + lkc * 8;
  constexpr size_t ASTR = (MODE == 1) ? (size_t)64 * 1024 : (size_t)64 * PD;
  const bf16r* bptr = Bm + (size_t)(n0 + lrow) * K + lkc * 8;
#define GLOAD(k0_)                                                                              \
  {                                                                                             \
    int kk_ = (k0_);                                                                            \
    if (MODE == 2) { int blk_ = kk_ >> 9; kk_ = (blk_ == 0 ? 1536 : (blk_ == 1 ? 3712 : 5760)) + (kk_ & 511); } \
    ra0 = *(const uint4*)(aptr + kk_);                                                          \
    ra1 = *(const uint4*)(aptr + ASTR + kk_);                                                   \
    ra2 = *(const uint4*)(aptr + 2 * ASTR + kk_);                                               \
    ra3 = *(const uint4*)(aptr + 3 * ASTR + kk_);                                               \
    rb0 = *(const uint4*)(bptr + (k0_));                                                        \
    rb1 = *(const uint4*)(bptr + (size_t)64 * K + (k0_));                                       \
  }
  GLOAD(0);
  constexpr int NK = K / 64;
#pragma unroll 1
  for (int kt = 0; kt < NK; ++kt) {
    __syncthreads();
    *(uint4*)(As + lrow * LS + lkc * 8) = ra0;
    *(uint4*)(As + (lrow + 64) * LS + lkc * 8) = ra1;
    *(uint4*)(As + (lrow + 128) * LS + lkc * 8) = ra2;
    *(uint4*)(As + (lrow + 192) * LS + lkc * 8) = ra3;
    *(uint4*)(Bs + lrow * LS + lkc * 8) = rb0;
    *(uint4*)(Bs + (lrow + 64) * LS + lkc * 8) = rb1;
    __syncthreads();
    if (kt + 1 < NK) GLOAD((kt + 1) * 64);
#pragma unroll
    for (int ks = 0; ks < 2; ++ks) {
      bf16x8 bfr[4];
#pragma unroll
      for (int ni = 0; ni < 4; ++ni)
        bfr[ni] = *(const bf16x8*)(Bs + (wc * 64 + ni * 16 + fr) * LS + ks * 32 + fq * 8);
#pragma unroll
      for (int mi = 0; mi < 4; ++mi) {
        bf16x8 afr = *(const bf16x8*)(As + (wr * 64 + mi * 16 + fr) * LS + ks * 32 + fq * 8);
#pragma unroll
        for (int ni = 0; ni < 4; ++ni)
          acc[mi][ni] = __builtin_amdgcn_mfma_f32_16x16x32_bf16(afr, bfr[ni], acc[mi][ni], 0, 0, 0);
      }
    }
  }
#undef GLOAD
  if (MODE == 1) {
    bf16r* projw = (bf16r*)(wsp(p) + OFF_PROJ);
    float* gsc = (float*)(wsp(p) + OFF_GSC);
    bf16r* halo = (bf16r*)(wsp(p) + OFF_HALO);
#pragma unroll
    for (int mi = 0; mi < 4; ++mi)
#pragma unroll
      for (int ni = 0; ni < 4; ++ni) {
        int col = n0 + wc * 64 + ni * 16 + fr;
        if (col < NCOL) {
#pragma unroll
          for (int j = 0; j < 4; ++j) {
            int row = m0 + wr * 64 + mi * 16 + fq * 4 + j;
            float v = acc[mi][ni][j];
            bf16r b = f2bf(v);
            projw[(size_t)row * PD + col] = b;
            if (col >= 1536 && col < 1552) gsc[row * 16 + col - 1536] = v;
            if ((row & 63) == 63 && col >= RWKV_B && col < HGRN_B) halo[(row >> 6) * 2176 + col - RWKV_B] = b;
          }
        }
      }
  } else {
#pragma unroll
    for (int mi = 0; mi < 4; ++mi)
#pragma unroll
      for (int ni = 0; ni < 4; ++ni) {
        int col = n0 + wc * 64 + ni * 16 + fr;
#pragma unroll
        for (int j = 0; j < 4; ++j) {
          int row = m0 + wr * 64 + mi * 16 + fq * 4 + j;
          size_t o = (size_t)row * DM + col;
          p.out[o] = xin[o] + acc[mi][ni][j];
        }
      }
  }
}

namespace pg8 {
#define PG8_LAS __attribute__((address_space(3)))
constexpr int BM = 256, BK = 64, HALF = 128, HTB = HALF * BK * 2, STAGE_BYTES = 8 * HTB, NXCD = 8, WGM = 8;
__device__ __forceinline__ int lds_byte(int r, int c) { const int st = (r >> 4) * 2 + (c >> 5), rr = r & 15, cc = c & 31, ob = rr * 64 + cc * 2; return st * 1024 + (ob ^ (((ob >> 9) & 1) << 5)); }
__device__ __forceinline__ void stage_rc(int b, int& R, int& C) { const int st = b / 1024, sb = b % 1024, swz = sb ^ (((sb >> 9) & 1) << 5); R = (st >> 1) * 16 + swz / 64; C = (st & 1) * 32 + (swz % 64) / 2; }
__device__ __forceinline__ int perm32(int rho) { const int n = rho >> 4, i = rho & 15; return 8 * (i >> 2) + 4 * n + (i & 3); }
struct Unit { int pm, pn; };
struct StaticOrder {
  int nM, nN, nwg, G, c;
  __device__ void init(int M, int N, int G_, int c_) { nM = M / BM; nN = N / BM; nwg = nM * nN; G = G_; c = c_; }
  __device__ bool next(int i, Unit& u) const {
    const long L = (long)i * G + c; if (L >= nwg) return false;
    int wgid = (int)L; { const int q = nwg / NXCD, r = nwg % NXCD, xcd = wgid % NXCD, off = wgid / NXCD; wgid = (xcd < r ? xcd * (q + 1) : r * (q + 1) + (xcd - r) * q) + off; }
    const int nig = WGM * nN, gid = wgid / nig, fm = gid * WGM, gsz = (nM - fm) < WGM ? (nM - fm) : WGM;
    u.pm = fm + ((wgid % nig) % gsz); u.pn = (wgid % nig) / gsz; return true;
  }
};
template <int MODE> __device__ __forceinline__ size_t a_koff(int t) {
  if (MODE == 1) return (size_t)t * (BK * 2);
  const int blk = t >> 3;
  const int cb = (blk == 0 ? 1536 : (blk == 1 ? 3712 : 5760));
  return (size_t)cb * 2 + (size_t)(t & 7) * (BK * 2);
}
template <int MODE, class Epi>
__device__ __forceinline__ void gemm_phase(PG8_LAS unsigned char* lds, const unsigned short* A, const unsigned short* Bt, int M, int N, const StaticOrder& S, const Epi& E) {
  constexpr int K = (MODE == 1) ? 1024 : 1536;
  constexpr int LDA = (MODE == 1) ? 1024 : PD;
  const int tid = opaque(threadIdx.x), wid = __builtin_amdgcn_readfirstlane(tid >> 6), lane = tid & 63, wr = wid >> 2, wc = wid & 3, fr = lane & 15, fq = lane >> 4;
  constexpr int nt = K / BK;
  unsigned voffA[2], voffB[2];
#pragma unroll
  for (int i = 0; i < 2; ++i) { int R, C; stage_rc(tid * 16 + i * 8192, R, C); const int Rb = Epi::PERM ? ((R & ~31) + perm32(R & 31)) : R;
    voffA[i] = (unsigned)(R * LDA + C) * 2u; voffB[i] = (unsigned)(Rb * K + C) * 2u; }
  const size_t kstep = (size_t)(BK * 2);
  const size_t hstepA = (size_t)HALF * LDA * 2, hstepB = (size_t)HALF * K * 2;
  const size_t tstepA = 2 * hstepA, tstepB = 2 * hstepB;
  const unsigned ldsw = (unsigned)wid * 1024u;
  const int aoff = lds_byte(wr * 64 + fr, fq * 8), boff = lds_byte(wc * 32 + fr, fq * 8);
#define PG8_SA(b, h) (((b) * 2 + (h)) * HTB)
#define PG8_SB(b, h) ((4 + (b) * 2 + (h)) * HTB)
#define PG8_STAGE(bufoff, gbase, voff) do { _Pragma("unroll") for (int _i = 0; _i < 2; ++_i) \
    __builtin_amdgcn_global_load_lds((const unsigned*)((const char*)(gbase) + (voff)[_i]), (PG8_LAS unsigned*)(lds + (bufoff) + ldsw + _i * 8192), 16, 0, 0); } while (0)
#define PG8_LDA(dst, b, h) do { _Pragma("unroll") for (int m = 0; m < 4; ++m) _Pragma("unroll") for (int k = 0; k < 2; ++k) dst[m][k] = *(const PG8_LAS bf16x8*)(lds + PG8_SA(b, h) + aoff + m * 2048 + k * 1024); } while (0)
#define PG8_LDB(dst, b, h) do { _Pragma("unroll") for (int n = 0; n < 2; ++n) _Pragma("unroll") for (int k = 0; k < 2; ++k) dst[n][k] = *(const PG8_LAS bf16x8*)(lds + PG8_SB(b, h) + boff + n * 2048 + k * 1024); } while (0)
#define PG8_MMA(ai, bj, At, Bt_) do { __builtin_amdgcn_s_setprio(1); _Pragma("unroll") for (int m = 0; m < 4; ++m) _Pragma("unroll") for (int n = 0; n < 2; ++n) _Pragma("unroll") for (int k = 0; k < 2; ++k) \
    acc[ai][bj][m][n] = __builtin_amdgcn_mfma_f32_16x16x32_bf16(Bt_[n][k], At[m][k], acc[ai][bj][m][n], 0, 0, 0); __builtin_amdgcn_s_setprio(0); } while (0)
#define PG8_WAIT_V(n) asm volatile("s_waitcnt vmcnt(" #n ")" ::: "memory")
#define PG8_WAIT_L(n) asm volatile("s_waitcnt lgkmcnt(" #n ")" ::: "memory")
#define PG8_BAR __builtin_amdgcn_s_barrier()
#define PG8_SCHED __builtin_amdgcn_sched_barrier(0)
  Unit cur, nxt; int ui = 0;
  if (!S.next(0, cur)) return;
  f32x4 acc[2][2][4][2];
#pragma unroll
  for (int a = 0; a < 2; ++a)
#pragma unroll
    for (int b = 0; b < 2; ++b)
#pragma unroll
      for (int m = 0; m < 4; ++m)
#pragma unroll
        for (int n = 0; n < 2; ++n) acc[a][b][m][n] = (f32x4){0.f, 0.f, 0.f, 0.f};
  bf16x8 At[4][2], B0[2][2], B1[2][2];
  const char* cA = (const char*)A + (size_t)cur.pm * tstepA; const char* cB = (const char*)Bt + (size_t)cur.pn * tstepB;
  PG8_STAGE(PG8_SB(0, 0), cB, voffB); PG8_STAGE(PG8_SA(0, 0), cA + a_koff<MODE>(0), voffA); PG8_STAGE(PG8_SB(0, 1), cB + hstepB, voffB); PG8_STAGE(PG8_SA(0, 1), cA + a_koff<MODE>(0) + hstepA, voffA);
  if (wr == 1) PG8_BAR;
  PG8_WAIT_V(4); PG8_BAR;
  PG8_STAGE(PG8_SB(1, 0), cB + kstep, voffB); PG8_STAGE(PG8_SA(1, 0), cA + a_koff<MODE>(1), voffA); PG8_STAGE(PG8_SB(1, 1), cB + hstepB + kstep, voffB);
  PG8_WAIT_V(6); PG8_BAR;
  for (;;) {
    const bool has_next = S.next(ui + 1, nxt);
    const char* nA = has_next ? (const char*)A + (size_t)nxt.pm * tstepA : cA; const char* nB = has_next ? (const char*)Bt + (size_t)nxt.pn * tstepB : cB;
#pragma unroll 1
    for (int t = 0; t < nt; t += 2) {
      const bool last = (t == nt - 2);
      const char* a1 = cA + a_koff<MODE>(t + 1);
      const char* a2 = last ? nA + a_koff<MODE>(0) : cA + a_koff<MODE>(t + 2);
      const char* a3 = last ? nA + a_koff<MODE>(1) : cA + a_koff<MODE>(t + 3);
      const char* b2 = last ? nB : cB + (size_t)(t + 2) * kstep;
      const char* b3 = b2 + kstep;
      PG8_LDB(B0, 0, 0); PG8_SCHED; PG8_LDA(At, 0, 0); PG8_STAGE(PG8_SA(1, 1), a1 + hstepA, voffA);
      PG8_WAIT_L(8); PG8_BAR; PG8_WAIT_L(0); PG8_MMA(0, 0, At, B0); PG8_BAR; PG8_SCHED;
      PG8_LDB(B1, 0, 1); PG8_STAGE(PG8_SB(0, 0), b2, voffB);
      PG8_BAR; PG8_WAIT_L(0); PG8_MMA(0, 1, At, B1); PG8_BAR;
      PG8_LDA(At, 0, 1); PG8_STAGE(PG8_SA(0, 0), a2, voffA);
      PG8_BAR; PG8_WAIT_L(0); PG8_MMA(1, 0, At, B0); PG8_BAR; PG8_SCHED;
      PG8_STAGE(PG8_SB(0, 1), b2 + hstepB, voffB);
      PG8_WAIT_V(6); PG8_BAR; PG8_MMA(1, 1, At, B1); PG8_BAR;
      PG8_LDB(B0, 1, 0); PG8_SCHED; PG8_LDA(At, 1, 0); PG8_STAGE(PG8_SA(0, 1), a2 + hstepA, voffA);
      PG8_WAIT_L(8); PG8_BAR; PG8_WAIT_L(0); PG8_MMA(0, 0, At, B0); PG8_BAR; PG8_SCHED;
      PG8_LDB(B1, 1, 1); PG8_STAGE(PG8_SB(1, 0), b3, voffB);
      PG8_BAR; PG8_WAIT_L(0); PG8_MMA(0, 1, At, B1); PG8_BAR;
      PG8_LDA(At, 1, 1); PG8_STAGE(PG8_SA(1, 0), a3, voffA);
      PG8_BAR; PG8_WAIT_L(0); PG8_MMA(1, 0, At, B0); PG8_BAR; PG8_SCHED;
      PG8_STAGE(PG8_SB(1, 1), b3 + hstepB, voffB);
      PG8_WAIT_V(6); PG8_BAR; PG8_MMA(1, 1, At, B1); PG8_BAR;
    }
    E(acc, cur, wr, wc, fr, fq);
    if (!has_next) break;
#pragma unroll
    for (int a = 0; a < 2; ++a)
#pragma unroll
      for (int b = 0; b < 2; ++b)
#pragma unroll
        for (int m = 0; m < 4; ++m)
#pragma unroll
          for (int n = 0; n < 2; ++n) acc[a][b][m][n] = (f32x4){0.f, 0.f, 0.f, 0.f};
    cur = nxt; cA = nA; cB = nB; ++ui;
  }
  PG8_WAIT_V(0);
  if (wr == 0) PG8_BAR;
  PG8_BAR;
#undef PG8_SA
#undef PG8_SB
#undef PG8_STAGE
#undef PG8_LDA
#undef PG8_LDB
#undef PG8_MMA
#undef PG8_WAIT_V
#undef PG8_WAIT_L
#undef PG8_BAR
#undef PG8_SCHED
}
struct EpiProj {
  static constexpr bool PERM = true;
  unsigned char* ws;
  __device__ __forceinline__ void operator()(const f32x4 (&acc)[2][2][4][2], const Unit& u, int wr, int wc, int fr, int fq) const {
    bf16r* projw = (bf16r*)(ws + OFF_PROJ);
    float* gsc = (float*)(ws + OFF_GSC);
    bf16r* halo = (bf16r*)(ws + OFF_HALO);
#pragma unroll
    for (int ai = 0; ai < 2; ++ai)
#pragma unroll
      for (int m = 0; m < 4; ++m) {
        const int row = u.pm * BM + ai * HALF + wr * 64 + m * 16 + fr;
        const float rsr = ((const float*)(ws + OFF_RS))[row];
#pragma unroll
        for (int bj = 0; bj < 2; ++bj) {
          const int c0 = u.pn * BM + bj * HALF + wc * 32 + 8 * fq;
          if (c0 < NCOL) {
            const f32x4 v0 = acc[ai][bj][m][0] * rsr, v1 = acc[ai][bj][m][1] * rsr;
            if (c0 >= 1536 && c0 < 1552) {
              *(f32x4*)(gsc + row * 16 + (c0 - 1536)) = v0;
              *(f32x4*)(gsc + row * 16 + (c0 - 1536) + 4) = v1;
            } else {
              const int cs = (c0 < 1536) ? c0 : c0 - 16;
              uint4 pk;
              pk.x = cvt_pk_bf16(v0[0], v0[1]); pk.y = cvt_pk_bf16(v0[2], v0[3]);
              pk.z = cvt_pk_bf16(v1[0], v1[1]); pk.w = cvt_pk_bf16(v1[2], v1[3]);
              *(uint4*)(projw + (size_t)row * PD + cs) = pk;
              if ((row & 63) == 63 && cs >= RWKV_B && cs < HGRN_B) *(uint4*)(halo + (size_t)(row >> 6) * 2176 + (cs - RWKV_B)) = pk;
              if ((row & 63) >= 61 && cs < 1536) *(uint4*)((bf16r*)(ws + OFF_HALO2) + ((size_t)(row >> 6) * 3 + ((row & 63) - 61)) * 1536 + cs) = pk;
            }
          }
        }
      }
  }
};
struct EpiResid {
  static constexpr bool PERM = false;
  const float* xin; float* out; unsigned char* ws; bool next_in;
  __device__ __forceinline__ void operator()(const f32x4 (&acc)[2][2][4][2], const Unit& u, int wr, int wc, int fr, int fq) const {
    bf16r* hbf = (bf16r*)(ws + OFF_HBF);
    float* ssp = (float*)(ws + OFF_SSP) + (size_t)(u.pn * 4 + wc) * T;
#pragma unroll
    for (int ai = 0; ai < 2; ++ai)
#pragma unroll
      for (int m = 0; m < 4; ++m) {
        const int row = u.pm * BM + ai * HALF + wr * 64 + m * 16 + fr;
        float ss = 0.f;
#pragma unroll
        for (int bj = 0; bj < 2; ++bj)
#pragma unroll
          for (int n = 0; n < 2; ++n) {
            const int c0 = u.pn * BM + bj * HALF + wc * 32 + 16 * n + 4 * fq;
            const size_t o = (size_t)row * DM + c0;
            const f32x4 x = *(const f32x4*)(xin + o);
            const f32x4 y = x + acc[ai][bj][m][n];
            *(f32x4*)(out + o) = y;
            if (next_in) {
              ss += y[0] * y[0] + y[1] * y[1] + y[2] * y[2] + y[3] * y[3];
              *(uint2*)(hbf + o) = uint2{cvt_pk_bf16(y[0], y[1]), cvt_pk_bf16(y[2], y[3])};
            }
          }
        if (next_in) {
          ss += __shfl_xor(ss, 16);
          ss += __shfl_xor(ss, 32);
          if (fq == 0) ssp[row] = ss;
        }
      }
  }
};
}

__device__ void rows_bf16_rs(const float* __restrict__ xin, bf16r* __restrict__ dst, float* __restrict__ rsout) {
  const int tid_ = opaque(threadIdx.x);
  const int lane = tid_ & 63;
  const int gw = blockIdx.x * (NTHR / 64) + (tid_ >> 6);
  const int nw = gridDim.x * (NTHR / 64);
  for (int row = gw; row < T; row += nw) {
    const float4* xr = (const float4*)(xin + (size_t)row * DM);
    float4 v[4];
    float ss = 0.f;
#pragma unroll
    for (int i = 0; i < 2; ++i) {
      v[2 * i] = xr[128 * i + 2 * lane];
      v[2 * i + 1] = xr[128 * i + 2 * lane + 1];
    }
#pragma unroll
    for (int i = 0; i < 4; ++i) ss += v[i].x * v[i].x + v[i].y * v[i].y + v[i].z * v[i].z + v[i].w * v[i].w;
    ss = red64(ss);
    if (lane == 0) rsout[row] = rsqrtf(ss * (1.f / DM) + 1e-6f);
#pragma unroll
    for (int i = 0; i < 2; ++i) {
      uint4 o;
      o.x = cvt_pk_bf16(v[2 * i].x, v[2 * i].y);
      o.y = cvt_pk_bf16(v[2 * i].z, v[2 * i].w);
      o.z = cvt_pk_bf16(v[2 * i + 1].x, v[2 * i + 1].y);
      o.w = cvt_pk_bf16(v[2 * i + 1].z, v[2 * i + 1].w);
      *(uint4*)(dst + (size_t)row * DM + 512 * i + 8 * lane) = o;
    }
  }
}
__device__ void reduce_rs(const float* __restrict__ ssp, float* __restrict__ rsout) {
  const int tid_ = opaque(threadIdx.x);
  for (int row = blockIdx.x * NTHR + tid_; row < T; row += gridDim.x * NTHR) {
    float ss = 0.f;
#pragma unroll
    for (int i = 0; i < 16; ++i) ss += ssp[(size_t)i * T + row];
    rsout[row] = rsqrtf(ss * (1.f / DM) + 1e-6f);
  }
}

__device__ __forceinline__ void shifted8(const bf16r* pc, const bf16r* pp, const float* mu, bool hasprev, int col, float* o8) {
  float cur[8], prv[8];
  unpack8(*(const uint4*)(pc + col), cur);
  uint4 z = hasprev ? *(const uint4*)(pp + col) : uint4{0u, 0u, 0u, 0u};
  unpack8(z, prv);
#pragma unroll
  for (int j = 0; j < 8; ++j) o8[j] = cur[j] + mu[col + j] * (prv[j] - cur[j]);
}

__device__ void mixer_naive(const Params& p, int l, int br, int h, unsigned char* smem) {
  float* sW = (float*)smem;
  float* sA = sW + 4096;
  float* sB = sA + 4096;
  float* sK = sB + 4096;
  float* sQ = sK + 4096;
  float* sV = sQ + 4096;
  float* sO = sV + 4096;
  float* sX = sO + 4096;
  bf16r* proj = (bf16r*)(wsp(p) + OFF_PROJ);
  const float* gsc = (const float*)(wsp(p) + OFF_GSC);
  const bf16r* halo = (const bf16r*)(wsp(p) + OFF_HALO);
  const float* lb = (const float*)(wsp(p) + OFF_LB) + l * 512;
  const int tid = opaque(threadIdx.x), lane = tid & 63, wid = tid >> 6;
  const int tt = tid >> 3, js = tid & 7, j0 = js * 8;
  const int rv = wid * 8 + (lane >> 3);
  const int kq = (lane & 7) * 8;
  float s[8];
#pragma unroll
  for (int i = 0; i < 8; ++i) s[i] = 0.f;

#pragma unroll 1
  for (int c = 0; c < T / 64; ++c) {
    const int t = c * 64 + tt;
    __syncthreads();
    if (br == 0) {
      float cq[8], ck[8], cv[8];
#pragma unroll
      for (int j = 0; j < 8; ++j) { cq[j] = 0.f; ck[j] = 0.f; cv[j] = 0.f; }
      const float* cw = p.conv_w + (size_t)l * 4 * 1536;
#pragma unroll
      for (int i = 0; i < 4; ++i) {
        int ts = t - 3 + i;
        if (ts >= 0) {
          float fq_[8], fk_[8], fv_[8];
          const bf16r* pr = proj + (size_t)ts * PD + h * 64 + j0;
          unpack8(*(const uint4*)(pr), fq_);
          unpack8(*(const uint4*)(pr + 512), fk_);
          unpack8(*(const uint4*)(pr + 1024), fv_);
#pragma unroll
          for (int j = 0; j < 8; ++j) {
            cq[j] += cw[i * 1536 + h * 64 + j0 + j] * fq_[j];
            ck[j] += cw[i * 1536 + 512 + h * 64 + j0 + j] * fk_[j];
            cv[j] += cw[i * 1536 + 1024 + h * 64 + j0 + j] * fv_[j];
          }
        }
      }
      float sq = 0.f, sk = 0.f;
#pragma unroll
      for (int j = 0; j < 8; ++j) {
        cq[j] = siluf_(cq[j]); ck[j] = siluf_(ck[j]); cv[j] = siluf_(cv[j]);
        sq += cq[j] * cq[j]; sk += ck[j] * ck[j];
      }
      sq = red8(sq); sk = red8(sk);
      float nq = rsqrtf(sq + 1e-6f) * 0.125f, nk = rsqrtf(sk + 1e-6f);
      float beta = sigmoidf_(gsc[t * 16 + h]);
      float g = -__expf(p.a_log[l * 8 + h]) * softplusf_(gsc[t * 16 + 8 + h] + p.dt_bias[l * 8 + h]);
      float eg = __expf(g);
#pragma unroll
      for (int j = 0; j < 8; ++j) {
        float kn = ck[j] * nk;
        int o = tt * 64 + j0 + j;
        sQ[o] = cq[j] * nq; sA[o] = kn; sK[o] = beta * kn; sB[o] = -eg * beta * kn; sW[o] = eg; sV[o] = cv[j];
      }
    } else if (br == 1) {
      const float* mu = p.mu + (size_t)l * 2176;
      const bf16r* pc = proj + (size_t)t * PD + RWKV_B;
      const bf16r* pp = (tt == 0) ? (halo + (size_t)(c - 1) * 2176) : (pc - PD);
      const bool hasprev = (t > 0);
      {
        float wd[8], ad[8];
        shifted8(pc, pp, mu, hasprev, 1536 + j0, wd);
        shifted8(pc, pp, mu, hasprev, 1600 + j0, ad);
#pragma unroll
        for (int j = 0; j < 8; ++j) { sO[tt * 64 + j0 + j] = tanhf(wd[j]); sX[tt * 64 + j0 + j] = ad[j]; }
      }
      __syncthreads();
      float aw[8], aa[8];
      const int ch0 = h * 64 + j0;
#pragma unroll
      for (int j = 0; j < 8; ++j) { aw[j] = p.w0[l * 512 + ch0 + j]; aa[j] = p.a0[l * 512 + ch0 + j]; }
      const float* wu = p.w_up + (size_t)l * 64 * 512 + ch0;
      const float* au = p.a_up + (size_t)l * 64 * 512 + ch0;
#pragma unroll 2
      for (int i = 0; i < 64; ++i) {
        float xw = sO[tt * 64 + i], xa = sX[tt * 64 + i];
        float4 w1 = *(const float4*)(wu + i * 512), w2 = *(const float4*)(wu + i * 512 + 4);
        float4 a1 = *(const float4*)(au + i * 512), a2 = *(const float4*)(au + i * 512 + 4);
        aw[0] += xw * w1.x; aw[1] += xw * w1.y; aw[2] += xw * w1.z; aw[3] += xw * w1.w;
        aw[4] += xw * w2.x; aw[5] += xw * w2.y; aw[6] += xw * w2.z; aw[7] += xw * w2.w;
        aa[0] += xa * a1.x; aa[1] += xa * a1.y; aa[2] += xa * a1.z; aa[3] += xa * a1.w;
        aa[4] += xa * a2.x; aa[5] += xa * a2.y; aa[6] += xa * a2.z; aa[7] += xa * a2.w;
      }
      float r8[8], k8[8], v8[8];
      shifted8(pc, pp, mu, hasprev, ch0, r8); shifted8(pc, pp, mu, hasprev, 512 + ch0, k8); shifted8(pc, pp, mu, hasprev, 1024 + ch0, v8);
      float kk[8], ssk = 0.f;
#pragma unroll
      for (int j = 0; j < 8; ++j) { kk[j] = k8[j] * p.k_k[l * 512 + ch0 + j]; ssk += kk[j] * kk[j]; }
      ssk = red8(ssk);
      float nk = rsqrtf(ssk + 1e-6f);
      __syncthreads();
#pragma unroll
      for (int j = 0; j < 8; ++j) {
        float w_raw = -softplusf_(-aw[j]) - 0.5f;
        float dec = __expf(-__expf(w_raw));
        float ic = sigmoidf_(aa[j]);
        float kn = kk[j] * nk;
        int o = tt * 64 + j0 + j;
        sW[o] = dec; sA[o] = -kn; sB[o] = kn * ic;
        sK[o] = k8[j] * (1.f + (ic - 1.f) * p.k_a[l * 512 + ch0 + j]);
        sV[o] = v8[j]; sQ[o] = r8[j];
      }
    } else {
      const bf16r* pc = proj + (size_t)t * PD + HGRN_B + h * 64 + j0;
      float q8[8], f8[8], i8[8];
      unpack8(*(const uint4*)(pc), q8);
      unpack8(*(const uint4*)(pc + 512), f8);
      unpack8(*(const uint4*)(pc + 1024), i8);
#pragma unroll
      for (int j = 0; j < 8; ++j) {
        float lbv = lb[h * 64 + j0 + j];
        float sg = sigmoidf_(f8[j]);
        int o = tt * 64 + j0 + j;
        sW[o] = lbv + (1.f - lbv) * sg;
        sA[o] = 0.f; sB[o] = 0.f;
        sK[o] = (1.f - lbv) * (1.f - sg);
        sQ[o] = siluf_(q8[j]); sV[o] = i8[j];
      }
    }
    __syncthreads();
#pragma unroll 2
    for (int st = 0; st < 64; ++st) {
      const float4* w4 = (const float4*)(sW + st * 64 + kq);
      const float4* a4 = (const float4*)(sA + st * 64 + kq);
      const float4* b4 = (const float4*)(sB + st * 64 + kq);
      const float4* k4 = (const float4*)(sK + st * 64 + kq);
      const float4* q4 = (const float4*)(sQ + st * 64 + kq);
      float4 wa = w4[0], wb = w4[1], aa_ = a4[0], ab = a4[1], ba = b4[0], bb = b4[1];
      float4 ka = k4[0], kb = k4[1], qa = q4[0], qb = q4[1];
      float vv = sV[st * 64 + rv];
      float d = s[0] * aa_.x + s[1] * aa_.y + s[2] * aa_.z + s[3] * aa_.w + s[4] * ab.x + s[5] * ab.y + s[6] * ab.z + s[7] * ab.w;
      d = red8(d);
      s[0] = s[0] * wa.x + d * ba.x + vv * ka.x;
      s[1] = s[1] * wa.y + d * ba.y + vv * ka.y;
      s[2] = s[2] * wa.z + d * ba.z + vv * ka.z;
      s[3] = s[3] * wa.w + d * ba.w + vv * ka.w;
      s[4] = s[4] * wb.x + d * bb.x + vv * kb.x;
      s[5] = s[5] * wb.y + d * bb.y + vv * kb.y;
      s[6] = s[6] * wb.z + d * bb.z + vv * kb.z;
      s[7] = s[7] * wb.w + d * bb.w + vv * kb.w;
      float od = s[0] * qa.x + s[1] * qa.y + s[2] * qa.z + s[3] * qa.w + s[4] * qb.x + s[5] * qb.y + s[6] * qb.z + s[7] * qb.w;
      od = red8(od);
      if ((lane & 7) == 0) sO[st * 64 + rv] = od;
    }
    __syncthreads();
    float o8[8];
#pragma unroll
    for (int j = 0; j < 8; ++j) o8[j] = sO[tt * 64 + j0 + j];
    if (br == 0) {
      float ss = 0.f;
#pragma unroll
      for (int j = 0; j < 8; ++j) ss += o8[j] * o8[j];
      ss = red8(ss);
      float rs = rsqrtf(ss * (1.f / 64.f) + 1e-6f);
      bf16r* gp = proj + (size_t)t * PD + GDN_GATE + h * 64 + j0;
      float g8[8], y8[8];
      unpack8(*(const uint4*)gp, g8);
#pragma unroll
      for (int j = 0; j < 8; ++j) y8[j] = o8[j] * rs * p.gdn_norm_w[l * 64 + j0 + j] * siluf_(g8[j]);
      *(uint4*)gp = pack8(y8);
    } else if (br == 1) {
      float sm = 0.f;
#pragma unroll
      for (int j = 0; j < 8; ++j) sm += o8[j];
      sm = red8(sm);
      float mean = sm * (1.f / 64.f);
      float sv = 0.f;
#pragma unroll
      for (int j = 0; j < 8; ++j) { float d = o8[j] - mean; sv += d * d; }
      sv = red8(sv);
      float rs = rsqrtf(sv * (1.f / 64.f) + 64e-5f);
      float bs = 0.f;
      const int ch0 = h * 64 + j0;
#pragma unroll
      for (int j = 0; j < 8; ++j) bs += sQ[tt * 64 + j0 + j] * sK[tt * 64 + j0 + j] * p.r_k[l * 512 + ch0 + j];
      bs = red8(bs);
      const float* mu = p.mu + (size_t)l * 2176;
      bf16r* gp = proj + (size_t)t * PD + RWKV_B + 1664 + ch0;
      const bf16r* gpp = (tt == 0) ? (halo + (size_t)(c - 1) * 2176 + 1664 + ch0) : (gp - PD);
      float cur[8], prv[8], y8[8];
      unpack8(*(const uint4*)gp, cur);
      if (t > 0) unpack8(*(const uint4*)gpp, prv);
      else {
#pragma unroll
        for (int j = 0; j < 8; ++j) prv[j] = 0.f;
      }
#pragma unroll
      for (int j = 0; j < 8; ++j) {
        float gt = cur[j] + mu[1664 + ch0 + j] * (prv[j] - cur[j]);
        float on = (o8[j] - mean) * rs * p.ln_w[l * 512 + ch0 + j] + p.ln_b[l * 512 + ch0 + j];
        on += bs * sV[tt * 64 + j0 + j];
        y8[j] = on * siluf_(gt);
      }
      __syncthreads();
      *(uint4*)gp = pack8(y8);
    } else {
      bf16r* op = proj + (size_t)t * PD + HGRN_B + h * 64 + j0;
      *(uint4*)op = pack8(o8);
    }
  }
}

__device__ void hgrn_norm_phase(const Params& p, int l) {
  bf16r* proj = (bf16r*)(wsp(p) + OFF_PROJ);
  const int tid_ = opaque(threadIdx.x);
  const int lane = tid_ & 63;
  const int gw = blockIdx.x * (NTHR / 64) + (tid_ >> 6);
  const int nw = gridDim.x * (NTHR / 64);
  for (int t = gw; t < T; t += nw) {
    float o8[8], g8[8], y8[8];
    unpack8(*(const uint4*)(proj + (size_t)t * PD + HGRN_B + lane * 8), o8);
    bf16r* gp = proj + (size_t)t * PD + HGRN_B + 1536 + lane * 8;
    unpack8(*(const uint4*)gp, g8);
    float ss = 0.f;
#pragma unroll
    for (int j = 0; j < 8; ++j) ss += o8[j] * o8[j];
    ss = red64(ss);
    float rs = rsqrtf(ss * (1.f / 512.f) + 1e-6f);
#pragma unroll
    for (int j = 0; j < 8; ++j) y8[j] = o8[j] * rs * p.hgrn_norm_w[l * 512 + lane * 8 + j] * siluf_(g8[j]);
    *(uint4*)gp = pack8(y8);
  }
}


__device__ __forceinline__ void mm64(const bf16r* A, const bf16r* Bt, int lane, int wid, f32x4& c0, f32x4& c1) {
  const int fr = lane & 15, fq = lane >> 4, rt = wid >> 1, ct = (wid & 1) * 2;
#pragma unroll
  for (int s2 = 0; s2 < 2; ++s2) {
    bf16x8 a = *(const bf16x8*)(A + (rt * 16 + fr) * LS + s2 * 32 + fq * 8);
    bf16x8 b0 = *(const bf16x8*)(Bt + (ct * 16 + fr) * LS + s2 * 32 + fq * 8);
    bf16x8 b1 = *(const bf16x8*)(Bt + ((ct + 1) * 16 + fr) * LS + s2 * 32 + fq * 8);
    c0 = __builtin_amdgcn_mfma_f32_16x16x32_bf16(a, b0, c0, 0, 0, 0);
    c1 = __builtin_amdgcn_mfma_f32_16x16x32_bf16(a, b1, c1, 0, 0, 0);
  }
}

typedef short s16x4 __attribute__((ext_vector_type(4)));
__device__ __forceinline__ bf16x8 frag_tr(const bf16r* img, int ntile, int s2, int lane) {
  const int g = lane >> 4, q = (lane & 15) >> 2, pp = lane & 3;
  const bf16r* a0 = img + (32 * s2 + 8 * g + q) * LS + 16 * ntile + 4 * pp;
  s16x4 lo = __builtin_amdgcn_ds_read_tr16_b64_v4i16((__attribute__((address_space(3))) s16x4*)a0);
  s16x4 hi = __builtin_amdgcn_ds_read_tr16_b64_v4i16((__attribute__((address_space(3))) s16x4*)(a0 + 4 * LS));
  return bf16x8{lo[0], lo[1], lo[2], lo[3], hi[0], hi[1], hi[2], hi[3]};
}
template <bool ATR, bool BTR>
__device__ __forceinline__ void mm64t(const bf16r* A, const bf16r* B, int lane, int wid, f32x4& c0, f32x4& c1) {
  const int fr = lane & 15, fq = lane >> 4, rt = wid >> 1, ct = (wid & 1) * 2;
#pragma unroll
  for (int s2 = 0; s2 < 2; ++s2) {
    bf16x8 a, b0, b1;
    if (ATR) a = frag_tr(A, rt, s2, lane);
    else a = *(const bf16x8*)(A + (rt * 16 + fr) * LS + s2 * 32 + fq * 8);
    if (BTR) { b0 = frag_tr(B, ct, s2, lane); b1 = frag_tr(B, ct + 1, s2, lane); }
    else {
      b0 = *(const bf16x8*)(B + (ct * 16 + fr) * LS + s2 * 32 + fq * 8);
      b1 = *(const bf16x8*)(B + ((ct + 1) * 16 + fr) * LS + s2 * 32 + fq * 8);
    }
    c0 = __builtin_amdgcn_mfma_f32_16x16x32_bf16(a, b0, c0, 0, 0, 0);
    c1 = __builtin_amdgcn_mfma_f32_16x16x32_bf16(a, b1, c1, 0, 0, 0);
  }
}

__device__ __forceinline__ void cumsum_tokens(float* v, float* tot, float* sTot, int lane, int wid, int j0) {
#pragma unroll
  for (int d = 8; d < 64; d <<= 1) {
#pragma unroll
    for (int j = 0; j < 8; ++j) {
      float x = __shfl_up(v[j], d);
      if (lane >= d) v[j] += x;
    }
  }
  if ((lane >> 3) == 7) {
#pragma unroll
    for (int j = 0; j < 8; ++j) sTot[wid * 64 + j0 + j] = v[j];
  }
  __syncthreads();
#pragma unroll
  for (int j = 0; j < 8; ++j) tot[j] = 0.f;
#pragma unroll
  for (int w = 0; w < 8; ++w) {
#pragma unroll
    for (int j = 0; j < 8; ++j) {
      float x = sTot[w * 64 + j0 + j];
      if (w < wid) v[j] += x;
      tot[j] += x;
    }
  }
}

__device__ __forceinline__ void store_nacc(bf16r* nb, int lane, int wid, const f32x4& c0, const f32x4& c1) {
  const int rt = wid >> 1, ct = (wid & 1) * 2;
  *(uint2*)(nb + ((ct * 4 + rt) * 64 + lane) * 4) = uint2{cvt_pk_bf16(c0[0], c0[1]), cvt_pk_bf16(c0[2], c0[3])};
  *(uint2*)(nb + (((ct + 1) * 4 + rt) * 64 + lane) * 4) = uint2{cvt_pk_bf16(c1[0], c1[1]), cvt_pk_bf16(c1[2], c1[3])};
}

__device__ __forceinline__ void touch_prep(const Params& p, int c, int hh, int tid, unsigned& ta, unsigned& tb) {
  const bf16r* proj = (const bf16r*)(wsp(p) + OFF_PROJ) + (size_t)c * 64 * PD;
  const int br = hh >> 3, h = hh & 7;
  const int nper = (br == 1) ? 6 : 3;
  if (tid < 64 * nper) {
    const int row = (br == 1) ? tid / 6 : tid / 3, si = tid - row * nper;
    int col;
    if (br == 0) col = si * 512 + h * 64;
    else if (br == 2) col = HGRN_B + si * 512 + h * 64;
    else col = RWKV_B + (si < 3 ? si * 512 + h * 64 : (si == 3 ? 1664 + h * 64 : (si == 4 ? 1536 : 1600)));
    const unsigned* a = (const unsigned*)(proj + (size_t)row * PD + col);
    ta = a[0];
    tb = a[31];
  }
}

__device__ __forceinline__ void hgrn_load(const Params& p, int l, int t, int h, int j0, float* q, float* lg, float* k, float* v) {
  const bf16r* proj = (const bf16r*)(wsp(p) + OFF_PROJ);
  const float* lb = (const float*)(wsp(p) + OFF_LB) + l * 512;
  const bf16r* pc = proj + (size_t)t * PD + HGRN_B + h * 64 + j0;
  float q8[8], f8[8];
  unpack8(*(const uint4*)(pc), q8);
  unpack8(*(const uint4*)(pc + 512), f8);
  unpack8(*(const uint4*)(pc + 1024), v);
#pragma unroll
  for (int j = 0; j < 8; ++j) {
    float lbv = lb[h * 64 + j0 + j];
    float f = f8[j];
    float sg = sigmoidf_(f);
    float g = lbv + (1.f - lbv) * sg;
    lg[j] = __logf(fmaxf(g, 1e-37f));
    k[j] = (1.f - lbv) * (1.f - sg);
    q[j] = siluf_(q8[j]);
  }
}

__device__ void hgrn_prep(const Params& p, int l, int c, int cl, int h, unsigned char* smem, int nc, int nhh) {
  unsigned ta = 0u, tb = 0u;
  bf16r* sKT = (bf16r*)smem;
  bf16r* sVT = sKT + 64 * LS;
  bf16r* sQt = sVT + 64 * LS;
  bf16r* sKt = sQt + 64 * LS;
  bf16r* sAtt = sKt + 4 * 64 * LS;
  float* sTot = (float*)(sAtt + 64 * LS);
  bf16r* sO0 = sQt;
  const int tid = opaque(threadIdx.x), lane = tid & 63, wid = tid >> 6;
  const int tt = tid >> 3, j0 = (tid & 7) * 8;
  const int fr = lane & 15, fq = lane >> 4, rt = wid >> 1, ct = (wid & 1) * 2;
  const int t = c * 64 + tt;
  float q[8], b[8], k[8], v[8], tot[8];
  hgrn_load(p, l, t, h, j0, q, b, k, v);
  __syncthreads();
  cumsum_tokens(b, tot, sTot, lane, wid, j0);
  float P[4][8];
#pragma unroll
  for (int j = 0; j < 8; ++j) {
    float a0 = sTot[0 * 64 + j0 + j] + sTot[1 * 64 + j0 + j];
    float a1 = sTot[2 * 64 + j0 + j] + sTot[3 * 64 + j0 + j];
    float a2 = sTot[4 * 64 + j0 + j] + sTot[5 * 64 + j0 + j];
    P[0][j] = 0.f; P[1][j] = a0; P[2][j] = a0 + a1; P[3][j] = a0 + a1 + a2;
  }
  const int I = tt >> 4;
  bf16r* pr = (bf16r*)(wsp(p) + OFF_PROJ) + (size_t)t * PD + HGRN_B + h * 64 + j0;
  {
    float qd[8], qt[8], kh[8];
#pragma unroll
    for (int j = 0; j < 8; ++j) {
      float pi = (I == 0) ? P[0][j] : (I == 1 ? P[1][j] : (I == 2 ? P[2][j] : P[3][j]));
      qd[j] = q[j] * __expf(b[j]);
      qt[j] = q[j] * __expf(b[j] - pi);
      kh[j] = k[j] * __expf(tot[j] - b[j]);
    }
    *(uint4*)(sKT + tt * LS + j0) = pack8(kh);
    *(uint4*)(sVT + tt * LS + j0) = pack8(v);
    *(uint4*)(pr) = pack8(qd);
    *(uint4*)(sQt + tt * LS + j0) = pack8(qt);
#pragma unroll
    for (int ii = 0; ii < 4; ++ii) {
      if (ii >= I) {
        float kt[8];
#pragma unroll
        for (int j = 0; j < 8; ++j) kt[j] = k[j] * __expf(fminf(P[ii][j] - b[j], 80.f));
        *(uint4*)(sKt + ii * 64 * LS + tt * LS + j0) = pack8(kt);
      }
    }
    if (tt == 63) {
      float* gam = (float*)(wsp(p) + OFF_GAM) + ((size_t)h * CH + cl) * 64;
#pragma unroll
      for (int j = 0; j < 8; ++j) gam[j0 + j] = __expf(tot[j]);
    }
  }
  __syncthreads();
  {
    f32x4 a0 = {0.f, 0.f, 0.f, 0.f}, a1 = {0.f, 0.f, 0.f, 0.f};
    if (ct <= rt) mm64(sQt, sKt + rt * 64 * LS, lane, wid, a0, a1);
#pragma unroll
    for (int j = 0; j < 4; ++j) {
      int row = rt * 16 + fq * 4 + j;
      int col0 = ct * 16 + fr, col1 = col0 + 16;
      float x0 = (col0 <= row && ct <= rt) ? a0[j] : 0.f;
      float x1 = (col1 <= row && ct + 1 <= rt) ? a1[j] : 0.f;
      sAtt[row * LS + col0] = f2bf(x0);
      sAtt[row * LS + col1] = f2bf(x1);
    }
    f32x4 n0 = {0.f, 0.f, 0.f, 0.f}, n1 = {0.f, 0.f, 0.f, 0.f};
    mm64t<true, true>(sKT, sVT, lane, wid, n0, n1);
    bf16r* nb = (bf16r*)(wsp(p) + OFF_NBUF) + ((size_t)(16 + h) * CH + cl) * 4096;
    store_nacc(nb, lane, wid, n0, n1);
  }
  __syncthreads();
  if (nhh >= 0) touch_prep(p, nc, nhh, tid, ta, tb);
  {
    f32x4 o0 = {0.f, 0.f, 0.f, 0.f}, o1 = {0.f, 0.f, 0.f, 0.f};
    mm64t<false, true>(sAtt, sVT, lane, wid, o0, o1);
#pragma unroll
    for (int j = 0; j < 4; ++j) {
      int row = rt * 16 + fq * 4 + j;
      sO0[row * LS + ct * 16 + fr] = f2bf(o0[j]);
      sO0[row * LS + (ct + 1) * 16 + fr] = f2bf(o1[j]);
    }
  }
  __syncthreads();
  *(uint4*)(pr + 1024) = *(const uint4*)(sO0 + tt * LS + j0);
  asm volatile("" ::"v"(ta), "v"(tb));
}

__device__ void hgrn_output(const Params& p, int l, int c, int cl, int h, unsigned char* smem) {
  bf16r* sP = (bf16r*)smem;
  bf16r* sHT = sP + 64 * LS;
  float* sO = (float*)(sHT + 64 * LS);
  const int tid = opaque(threadIdx.x), lane = tid & 63, wid = tid >> 6;
  const int tt = tid >> 3, j0 = (tid & 7) * 8;
  const int fr = lane & 15, fq = lane >> 4, rt = wid >> 1, ct = (wid & 1) * 2;
  const int t = c * 64 + tt;
  bf16r* pr = (bf16r*)(wsp(p) + OFF_PROJ) + (size_t)t * PD + HGRN_B + h * 64 + j0;
  const uint4 p_raw = *(const uint4*)(pr);
  const uint4 o0_raw = *(const uint4*)(pr + 1024);
  const uint4 ht_raw = *(const uint4*)((const bf16r*)(wsp(p) + OFF_HTBUF) + ((size_t)(16 + h) * CH + cl) * 4096 + tt * 64 + j0);
  __syncthreads();
  *(uint4*)(sP + tt * LS + j0) = p_raw;
  *(uint4*)(sHT + tt * LS + j0) = ht_raw;
  __syncthreads();
  {
    f32x4 c0 = {0.f, 0.f, 0.f, 0.f}, c1 = {0.f, 0.f, 0.f, 0.f};
    mm64(sP, sHT, lane, wid, c0, c1);
#pragma unroll
    for (int j = 0; j < 4; ++j) {
      int row = rt * 16 + fq * 4 + j;
      sO[row * FS + ct * 16 + fr] = c0[j];
      sO[row * FS + (ct + 1) * 16 + fr] = c1[j];
    }
  }
  __syncthreads();
  {
    float o8[8], a8[8];
    unpack8(o0_raw, a8);
#pragma unroll
    for (int j = 0; j < 8; ++j) o8[j] = sO[tt * FS + j0 + j] + a8[j];
    *(uint4*)(pr) = pack8(o8);
  }
}

template <int CTRL> __device__ __forceinline__ float quad_bcast(float v) {
  return __int_as_float(__builtin_amdgcn_update_dpp(__float_as_int(v), __float_as_int(v), CTRL, 0xf, 0xf, false));
}
constexpr int SAS = 68;
template <int J0, int PF>
__device__ __forceinline__ void tri_solve_part(const float* abase, f32x2_t (&x2)[8], f32x4 (&ab)[PF + 1][4]) {
#pragma unroll
  for (int jj = 0; jj < 16; ++jj) {
    const int j = J0 + jj;
    if (j + PF < 64) {
#pragma unroll
      for (int m4 = ((j + PF) >> 4); m4 < 4; ++m4) ab[(j + PF) % (PF + 1)][m4] = *(const f32x4*)(abase + (j + PF) * SAS + m4 * 4);
    }
    __builtin_amdgcn_sched_barrier(0);
    float xj;
    const float xs = (((j >> 2) & 1) == 0) ? x2[j >> 3][0] : x2[j >> 3][1];
    if ((j & 3) == 0) xj = quad_bcast<0x00>(xs);
    else if ((j & 3) == 1) xj = quad_bcast<0x55>(xs);
    else if ((j & 3) == 2) xj = quad_bcast<0xAA>(xs);
    else xj = quad_bcast<0xFF>(xs);
    const f32x2_t xj2 = {xj, xj};
#pragma unroll
    for (int m4 = (j >> 4); m4 < 4; ++m4) {
      const f32x4 a = ab[j % (PF + 1)][m4];
      if (m4 * 4 + 1 >= (j >> 2)) x2[m4 * 2 + 0] = x2[m4 * 2 + 0] - f32x2_t{a[0], a[1]} * xj2;
      if (m4 * 4 + 3 >= (j >> 2)) x2[m4 * 2 + 1] = x2[m4 * 2 + 1] - f32x2_t{a[2], a[3]} * xj2;
    }
  }
}
__device__ __forceinline__ void tri_solve(const float* sAT, int r, float* x) {
  constexpr int PF = 3;
  f32x2_t x2[8];
#pragma unroll
  for (int k = 0; k < 8; ++k) x2[k] = f32x2_t{x[2 * k], x[2 * k + 1]};
  f32x4 ab[PF + 1][4];
  const float* abase = sAT + r * 16;
#pragma unroll
  for (int j = 0; j < PF; ++j) {
#pragma unroll
    for (int m4 = (j >> 4); m4 < 4; ++m4) ab[j % (PF + 1)][m4] = *(const f32x4*)(abase + j * SAS + m4 * 4);
  }
  __builtin_amdgcn_sched_barrier(0);
  tri_solve_part<0, PF>(abase, x2, ab);
  tri_solve_part<16, PF>(abase, x2, ab);
  tri_solve_part<32, PF>(abase, x2, ab);
  tri_solve_part<48, PF>(abase, x2, ab);
#pragma unroll
  for (int k = 0; k < 8; ++k) { x[2 * k] = x2[k][0]; x[2 * k + 1] = x2[k][1]; }
}

__device__ __forceinline__ void gdn_load(const Params& p, int l, int t, int h, int j0, float* cq, float* ck, float* cv,
                                         float& beta, float& g) {
  const bf16r* proj = (const bf16r*)(wsp(p) + OFF_PROJ);
  const float* gsc = (const float*)(wsp(p) + OFF_GSC);
#pragma unroll
  for (int j = 0; j < 8; ++j) { cq[j] = 0.f; ck[j] = 0.f; cv[j] = 0.f; }
  const float* cw = p.conv_w + (size_t)l * 4 * 1536 + h * 64 + j0;
#pragma unroll
  for (int i = 0; i < 4; ++i) {
    int ts = t - 3 + i;
    if (ts >= 0) {
      float fq_[8], fk_[8], fv_[8];
      const int cs = t & ~63;
      const bf16r* pr = (ts >= cs) ? (proj + (size_t)ts * PD + h * 64 + j0)
                                   : ((const bf16r*)(wsp(p) + OFF_HALO2) + ((size_t)((cs >> 6) - 1) * 3 + (ts - cs + 3)) * 1536 + h * 64 + j0);
      unpack8(*(const uint4*)(pr), fq_);
      unpack8(*(const uint4*)(pr + 512), fk_);
      unpack8(*(const uint4*)(pr + 1024), fv_);
#pragma unroll
      for (int j = 0; j < 8; ++j) {
        cq[j] += cw[i * 1536 + j] * fq_[j];
        ck[j] += cw[i * 1536 + 512 + j] * fk_[j];
        cv[j] += cw[i * 1536 + 1024 + j] * fv_[j];
      }
    }
  }
  float sq = 0.f, sk = 0.f;
#pragma unroll
  for (int j = 0; j < 8; ++j) {
    cq[j] = siluf_(cq[j]); ck[j] = siluf_(ck[j]); cv[j] = siluf_(cv[j]);
    sq += cq[j] * cq[j]; sk += ck[j] * ck[j];
  }
  sq = red8(sq); sk = red8(sk);
  float nq = rsqrtf(sq + 1e-6f) * 0.125f, nk = rsqrtf(sk + 1e-6f);
#pragma unroll
  for (int j = 0; j < 8; ++j) { cq[j] *= nq; ck[j] *= nk; }
  beta = sigmoidf_(gsc[t * 16 + h]);
  g = -__expf(p.a_log[l * 8 + h]) * softplusf_(gsc[t * 16 + 8 + h] + p.dt_bias[l * 8 + h]);
}

__device__ __forceinline__ void cumsum_scalar(float g, float* sG, int tt, int js, float& gc, float& gtot) {
  if (js == 0) sG[tt] = g;
  __syncthreads();
  if (threadIdx.x < 64) {
    float v = sG[threadIdx.x];
#pragma unroll
    for (int d = 1; d < 64; d <<= 1) {
      float x = __shfl_up(v, d);
      if ((int)threadIdx.x >= d) v += x;
    }
    sG[64 + threadIdx.x] = v;
  }
  __syncthreads();
  gc = sG[64 + tt];
  gtot = sG[64 + 63];
}

__device__ void gdn_prep(const Params& p, int l, int c, int cl, int h, unsigned char* smem, int nc, int nhh) {
  unsigned ta = 0u, tb = 0u;
  bf16r* sK = (bf16r*)smem;
  bf16r* sKdT = sK + 64 * LS;
  bf16r* sXT = sKdT + 64 * LS;
  bf16r* sQ = sXT + 128 * LS;
  bf16r* sAtt = sQ + 64 * LS;
  float* sAT = (float*)(sAtt + 64 * LS);
  float* sR = sAT + 64 * SAS;
  float* sQdF = sR + 64 * 136;
  float* sG = sQdF + 64 * FS;
  float* sGc = sG + 64;
  float* sBeta = sGc + 64;
  bf16r* sM = sQ;
  bf16r* sP = (bf16r*)sR;
  bf16r* sO0 = sP + 64 * LS;
  const int tid = opaque(threadIdx.x), lane = tid & 63, wid = tid >> 6;
  const int tt = tid >> 3, js = tid & 7, j0 = js * 8;
  const int fr = lane & 15, fq = lane >> 4, rt = wid >> 1, ct = (wid & 1) * 2;
  const int t = c * 64 + tt;
  float q[8], k[8], v[8], beta, g, gc, gtot;
  gdn_load(p, l, t, h, j0, q, k, v, beta, g);
  __syncthreads();
  cumsum_scalar(g, sG, tt, js, gc, gtot);
  {
    if (js == 0) { sGc[tt] = gc; sBeta[tt] = beta; }
    *(uint4*)(sK + tt * LS + j0) = pack8(k);
    *(uint4*)(sQ + tt * LS + j0) = pack8(q);
    const float egc = __expf(gc), ekd = __expf(gtot - gc);
    float kd[8];
#pragma unroll
    for (int j = 0; j < 8; ++j) {
      kd[j] = k[j] * ekd;
      sR[tt * 136 + j0 + j] = beta * v[j];
      sR[tt * 136 + 64 + j0 + j] = beta * k[j] * egc;
      sQdF[tt * FS + j0 + j] = q[j] * egc;
    }
    *(uint4*)(sKdT + tt * LS + j0) = pack8(kd);
  }
  __syncthreads();
  {
    f32x4 a0 = {0.f, 0.f, 0.f, 0.f}, a1 = {0.f, 0.f, 0.f, 0.f};
    f32x4 b0 = {0.f, 0.f, 0.f, 0.f}, b1 = {0.f, 0.f, 0.f, 0.f};
    mm64(sK, sK, lane, wid, a0, a1);
    mm64(sQ, sK, lane, wid, b0, b1);
#pragma unroll
    for (int j = 0; j < 4; ++j) {
      int row = rt * 16 + fq * 4 + j;
      float br_ = sBeta[row], gr = sGc[row];
      int c0i = ct * 16 + fr, c1i = c0i + 16;
      float e0 = __expf(fminf(gr - sGc[c0i], 0.f)), e1 = __expf(fminf(gr - sGc[c1i], 0.f));
      sAT[c0i * SAS + (row & 3) * 16 + (row >> 2)] = (c0i < row) ? br_ * a0[j] * e0 : 0.f;
      sAT[c1i * SAS + (row & 3) * 16 + (row >> 2)] = (c1i < row) ? br_ * a1[j] * e1 : 0.f;
      sAtt[row * LS + c0i] = f2bf((c0i <= row) ? b0[j] * e0 : 0.f);
      sAtt[row * LS + c1i] = f2bf((c1i <= row) ? b1[j] * e1 : 0.f);
    }
  }
  __syncthreads();
  if (nhh >= 0) touch_prep(p, nc, nhh, tid, ta, tb);
  {
    const int col = tid >> 2, r = tid & 3;
    float x[16];
#pragma unroll
    for (int m = 0; m < 16; ++m) x[m] = sR[(4 * m + r) * 136 + col];
    tri_solve(sAT, r, x);
#pragma unroll
    for (int m = 0; m < 16; ++m) sXT[col * LS + 4 * m + r] = f2bf(x[m]);
  }
  __syncthreads();
  {
    f32x4 n0 = {0.f, 0.f, 0.f, 0.f}, n1 = {0.f, 0.f, 0.f, 0.f}, w0 = {0.f, 0.f, 0.f, 0.f}, w1 = {0.f, 0.f, 0.f, 0.f};
    f32x4 p0 = {0.f, 0.f, 0.f, 0.f}, p1 = {0.f, 0.f, 0.f, 0.f}, o0 = {0.f, 0.f, 0.f, 0.f}, o1 = {0.f, 0.f, 0.f, 0.f};
    mm64t<true, false>(sKdT, sXT, lane, wid, n0, n1);
    mm64t<true, false>(sKdT, sXT + 64 * LS, lane, wid, w0, w1);
    mm64(sAtt, sXT + 64 * LS, lane, wid, p0, p1);
    mm64(sAtt, sXT, lane, wid, o0, o1);
    bf16r* nb = (bf16r*)(wsp(p) + OFF_NBUF) + ((size_t)h * CH + cl) * 4096;
    store_nacc(nb, lane, wid, n0, n1);
    const float eg = __expf(gtot);
#pragma unroll
    for (int j = 0; j < 4; ++j) {
      int row = rt * 16 + fq * 4 + j;
      int c0i = ct * 16 + fr, c1i = c0i + 16;
      sM[row * LS + c0i] = f2bf((row == c0i ? eg : 0.f) - w0[j]);
      sM[row * LS + c1i] = f2bf((row == c1i ? eg : 0.f) - w1[j]);
      sP[row * LS + c0i] = f2bf(sQdF[row * FS + c0i] - p0[j]);
      sP[row * LS + c1i] = f2bf(sQdF[row * FS + c1i] - p1[j]);
      sO0[row * LS + c0i] = f2bf(o0[j]);
      sO0[row * LS + c1i] = f2bf(o1[j]);
    }
  }
  __syncthreads();
  {
    const int fi = tid >> 6, s2 = fi & 1, rtm = fi >> 1;
    const int row = rtm * 16 + fr;
    uint2 lo = *(const uint2*)(sM + row * LS + (2 * s2) * 16 + fq * 4);
    uint2 hi = *(const uint2*)(sM + row * LS + (2 * s2 + 1) * 16 + fq * 4);
    bf16r* mb = (bf16r*)(wsp(p) + OFF_MBUF) + ((size_t)h * CH + cl) * 4096;
    *(uint4*)(mb + (fi * 64 + lane) * 8) = uint4{lo.x, lo.y, hi.x, hi.y};
    bf16r* pr = (bf16r*)(wsp(p) + OFF_PROJ) + (size_t)t * PD + h * 64 + j0;
    *(uint4*)(pr) = *(const uint4*)(sP + tt * LS + j0);
    *(uint4*)(pr + 1024) = *(const uint4*)(sO0 + tt * LS + j0);
  }
  asm volatile("" ::"v"(ta), "v"(tb));
}

__device__ void gdn_output(const Params& p, int l, int c, int cl, int h, unsigned char* smem) {
  bf16r* sP = (bf16r*)smem;
  bf16r* sHT = sP + 64 * LS;
  float* sO = (float*)(sHT + 64 * LS);
  const int tid = opaque(threadIdx.x), lane = tid & 63, wid = tid >> 6;
  const int tt = tid >> 3, js = tid & 7, j0 = js * 8;
  const int fr = lane & 15, fq = lane >> 4, rt = wid >> 1, ct = (wid & 1) * 2;
  const int t = c * 64 + tt;
  bf16r* pr = (bf16r*)(wsp(p) + OFF_PROJ) + (size_t)t * PD + h * 64 + j0;
  const uint4 p_raw = *(const uint4*)(pr);
  const uint4 o0_raw = *(const uint4*)(pr + 1024);
  const uint4 ht_raw = *(const uint4*)((const bf16r*)(wsp(p) + OFF_HTBUF) + ((size_t)h * CH + cl) * 4096 + tt * 64 + j0);
  bf16r* gp = pr + GDN_GATE;
  const uint4 gate_raw = *(const uint4*)gp;
  __syncthreads();
  *(uint4*)(sP + tt * LS + j0) = p_raw;
  *(uint4*)(sHT + tt * LS + j0) = ht_raw;
  __syncthreads();
  {
    f32x4 c0 = {0.f, 0.f, 0.f, 0.f}, c1 = {0.f, 0.f, 0.f, 0.f};
    mm64(sP, sHT, lane, wid, c0, c1);
#pragma unroll
    for (int j = 0; j < 4; ++j) {
      int row = rt * 16 + fq * 4 + j;
      sO[row * FS + ct * 16 + fr] = c0[j];
      sO[row * FS + (ct + 1) * 16 + fr] = c1[j];
    }
  }
  __syncthreads();
  {
    float o8[8], a8[8], g8[8], y8[8], ss = 0.f;
    unpack8(o0_raw, a8);
    unpack8(gate_raw, g8);
#pragma unroll
    for (int j = 0; j < 8; ++j) { o8[j] = sO[tt * FS + j0 + j] + a8[j]; ss += o8[j] * o8[j]; }
    ss = red8(ss);
    float rs = rsqrtf(ss * (1.f / 64.f) + 1e-6f);
#pragma unroll
    for (int j = 0; j < 8; ++j) y8[j] = o8[j] * rs * p.gdn_norm_w[l * 64 + j0 + j] * siluf_(g8[j]);
    *(uint4*)gp = pack8(y8);
  }
}

__device__ __forceinline__ float tanh_fast(float x) { return 1.f - 2.f * __builtin_amdgcn_rcpf(1.f + __expf(2.f * x)); }
__device__ __forceinline__ void rwkv_load(const Params& p, int l, int c, int tt, int h, int j0, unsigned char* smem,
                                          float* r8, float* k8, float* v8, float* kk8, float* ic8, float* lw8) {
  bf16r* tA1 = (bf16r*)smem;
  bf16r* tA2 = tA1 + 64 * LS;
  bf16r* tB1 = tA2 + 64 * LS;
  bf16r* tB2 = tB1 + 64 * LS;
  float* res1 = (float*)(tB2 + 64 * LS);
  float* res2 = res1 + 4096;
  const bf16r* proj = (const bf16r*)(wsp(p) + OFF_PROJ);
  const bf16r* halo = (const bf16r*)(wsp(p) + OFF_HALO);
  const bf16r* lora = (const bf16r*)(wsp(p) + OFF_LORA);
  const int t = c * 64 + tt;
  const int tid = tt * 8 + (j0 >> 3), lane = tid & 63, wid = tid >> 6;
  const float* mu = p.mu + (size_t)l * 2176;
  const bf16r* pc = proj + (size_t)t * PD + RWKV_B;
  const bf16r* pp = (tt == 0) ? (halo + (size_t)(c - 1) * 2176) : (pc - PD);
  const bool hasprev = (t > 0);
  const int ch0 = h * 64 + j0;
  {
    float wd[8], ad[8];
    shifted8(pc, pp, mu, hasprev, 1536 + j0, wd);
    shifted8(pc, pp, mu, hasprev, 1600 + j0, ad);
#pragma unroll
    for (int j = 0; j < 8; ++j) wd[j] = tanh_fast(wd[j]);
    *(uint4*)(tA1 + tt * LS + j0) = pack8(wd);
    *(uint4*)(tA2 + tt * LS + j0) = pack8(ad);
    *(uint4*)(tB1 + tt * LS + j0) = *(const uint4*)(lora + (size_t)(h * 64 + tt) * 64 + j0);
    *(uint4*)(tB2 + tt * LS + j0) = *(const uint4*)(lora + (size_t)(512 + h * 64 + tt) * 64 + j0);
  }
  shifted8(pc, pp, mu, hasprev, ch0, r8);
  shifted8(pc, pp, mu, hasprev, 512 + ch0, k8);
  shifted8(pc, pp, mu, hasprev, 1024 + ch0, v8);
  __syncthreads();
  {
    f32x4 a0 = {0.f, 0.f, 0.f, 0.f}, a1 = {0.f, 0.f, 0.f, 0.f}, b0 = {0.f, 0.f, 0.f, 0.f}, b1 = {0.f, 0.f, 0.f, 0.f};
    mm64(tA1, tB1, lane, wid, a0, a1);
    mm64(tA2, tB2, lane, wid, b0, b1);
    const int fr = lane & 15, fq = lane >> 4, rt = wid >> 1, ct = (wid & 1) * 2;
#pragma unroll
    for (int j = 0; j < 4; ++j) {
      int row = rt * 16 + fq * 4 + j;
      res1[row * 64 + ct * 16 + fr] = a0[j];
      res1[row * 64 + (ct + 1) * 16 + fr] = a1[j];
      res2[row * 64 + ct * 16 + fr] = b0[j];
      res2[row * 64 + (ct + 1) * 16 + fr] = b1[j];
    }
  }
  __syncthreads();
  float aw[8], aa[8];
#pragma unroll
  for (int j = 0; j < 8; ++j) {
    aw[j] = p.w0[l * 512 + ch0 + j] + res1[tt * 64 + j0 + j];
    aa[j] = p.a0[l * 512 + ch0 + j] + res2[tt * 64 + j0 + j];
  }
  float ssk = 0.f;
#pragma unroll
  for (int j = 0; j < 8; ++j) { kk8[j] = k8[j] * p.k_k[l * 512 + ch0 + j]; ssk += kk8[j] * kk8[j]; }
  ssk = red8(ssk);
  const float nk = rsqrtf(ssk + 1e-6f);
#pragma unroll
  for (int j = 0; j < 8; ++j) {
    float w_raw = -softplusf_(-aw[j]) - 0.5f;
    lw8[j] = -__expf(w_raw);
    ic8[j] = sigmoidf_(aa[j]);
    kk8[j] *= nk;
    k8[j] = k8[j] * (1.f + (ic8[j] - 1.f) * p.k_a[l * 512 + ch0 + j]);
  }
}

__device__ void rwkv_prep(const Params& p, int l, int c, int cl, int h, unsigned char* smem, int nc, int nhh) {
  unsigned ta = 0u, tb = 0u;
  bf16r* sAt = (bf16r*)smem;
  bf16r* sRt = sAt + 64 * LS;
  bf16r* sBK = sRt + 64 * LS;
  bf16r* sVT = sBK + 128 * LS;
  bf16r* sBhT = sVT + 64 * LS;
  bf16r* sKhT = sBhT + 64 * LS;
  bf16r* sMak = sKhT + 64 * LS;
  bf16r* sMrb = sMak + 64 * LS;
  bf16r* sMrk = sMrb + 64 * LS;
  float* sAT = (float*)(sMrk + 64 * LS);
  float* sR = sAT + 64 * SAS;
  float* sTot = sR + 64 * FS;
  bf16r* sXT = sBK;
  bf16r* sM = sMak;
  bf16r* sP = (bf16r*)sAT;
  bf16r* sO0 = (bf16r*)sR;
  const int tid = opaque(threadIdx.x), lane = tid & 63, wid = tid >> 6;
  const int tt = tid >> 3, js = tid & 7, j0 = js * 8;
  const int fr = lane & 15, fq = lane >> 4, rt = wid >> 1, ct = (wid & 1) * 2;
  const int t = c * 64 + tt;
  float r8[8], k8[8], v8[8], kk8[8], ic8[8], lc[8], tot[8];
  __syncthreads();
  rwkv_load(p, l, c, tt, h, j0, smem, r8, k8, v8, kk8, ic8, lc);
  float lw[8];
#pragma unroll
  for (int j = 0; j < 8; ++j) lw[j] = lc[j];
  cumsum_tokens(lc, tot, sTot, lane, wid, j0);
  uint4 v_pk;
  {
    float at[8], rt_[8], bt[8], kt[8], bh[8], kh[8], bs = 0.f;
#pragma unroll
    for (int j = 0; j < 8; ++j) {
      float eil = __expf(-lc[j]), ekd = __expf(tot[j] - lc[j]);
      at[j] = -kk8[j] * __expf(lc[j] - lw[j]);
      rt_[j] = r8[j] * __expf(lc[j]);
      float b = kk8[j] * ic8[j];
      bt[j] = b * eil;
      kt[j] = k8[j] * eil;
      bs += r8[j] * k8[j] * p.r_k[l * 512 + h * 64 + j0 + j];
      bh[j] = b * ekd;
      kh[j] = k8[j] * ekd;
    }
    bs = red8(bs);
    if (js == 0) ((float*)(wsp(p) + OFF_BON))[t * 8 + h] = bs;
    v_pk = pack8(v8);
    *(uint4*)(sVT + tt * LS + j0) = v_pk;
    *(uint4*)(sBhT + tt * LS + j0) = pack8(bh);
    *(uint4*)(sKhT + tt * LS + j0) = pack8(kh);
    *(uint4*)(sAt + tt * LS + j0) = pack8(at);
    *(uint4*)(sRt + tt * LS + j0) = pack8(rt_);
    *(uint4*)(sBK + tt * LS + j0) = pack8(bt);
    *(uint4*)(sBK + (64 + tt) * LS + j0) = pack8(kt);
  }
  __syncthreads();
  {
    f32x4 a0 = {0.f, 0.f, 0.f, 0.f}, a1 = {0.f, 0.f, 0.f, 0.f}, b0 = {0.f, 0.f, 0.f, 0.f}, b1 = {0.f, 0.f, 0.f, 0.f};
    f32x4 e0 = {0.f, 0.f, 0.f, 0.f}, e1 = {0.f, 0.f, 0.f, 0.f}, f0 = {0.f, 0.f, 0.f, 0.f}, f1 = {0.f, 0.f, 0.f, 0.f};
    mm64(sAt, sBK, lane, wid, a0, a1);
    mm64(sAt, sBK + 64 * LS, lane, wid, b0, b1);
    mm64(sRt, sBK, lane, wid, e0, e1);
    mm64(sRt, sBK + 64 * LS, lane, wid, f0, f1);
#pragma unroll
    for (int j = 0; j < 4; ++j) {
      int row = rt * 16 + fq * 4 + j;
      int c0i = ct * 16 + fr, c1i = c0i + 16;
      sAT[c0i * SAS + (row & 3) * 16 + (row >> 2)] = (c0i < row) ? -a0[j] : 0.f;
      sAT[c1i * SAS + (row & 3) * 16 + (row >> 2)] = (c1i < row) ? -a1[j] : 0.f;
      sMak[row * LS + c0i] = f2bf((c0i < row) ? b0[j] : 0.f);
      sMak[row * LS + c1i] = f2bf((c1i < row) ? b1[j] : 0.f);
      sMrb[row * LS + c0i] = f2bf((c0i <= row) ? e0[j] : 0.f);
      sMrb[row * LS + c1i] = f2bf((c1i <= row) ? e1[j] : 0.f);
      sMrk[row * LS + c0i] = f2bf((c0i <= row) ? f0[j] : 0.f);
      sMrk[row * LS + c1i] = f2bf((c1i <= row) ? f1[j] : 0.f);
    }
  }
  __syncthreads();
  {
    f32x4 y0 = {0.f, 0.f, 0.f, 0.f}, y1 = {0.f, 0.f, 0.f, 0.f};
    mm64t<false, true>(sMak, sVT, lane, wid, y0, y1);
#pragma unroll
    for (int j = 0; j < 4; ++j) {
      int row = rt * 16 + fq * 4 + j;
      sR[row * FS + ct * 16 + fr] = y0[j];
      sR[row * FS + (ct + 1) * 16 + fr] = y1[j];
    }
  }
  __syncthreads();
  if (nhh >= 0) touch_prep(p, nc, nhh, tid, ta, tb);
  {
    const int col = tid >> 2, r = tid & 3;
    float x[16];
    if (col < 64) {
#pragma unroll
      for (int m = 0; m < 16; ++m) x[m] = sR[(4 * m + r) * FS + col];
    } else {
#pragma unroll
      for (int m = 0; m < 16; ++m) x[m] = bf2f(sAt[(4 * m + r) * LS + (col - 64)]);
    }
    tri_solve(sAT, r, x);
#pragma unroll
    for (int m = 0; m < 16; ++m) sXT[col * LS + 4 * m + r] = f2bf(x[m]);
  }
  __syncthreads();
  {
    f32x4 n0 = {0.f, 0.f, 0.f, 0.f}, n1 = {0.f, 0.f, 0.f, 0.f}, w0 = {0.f, 0.f, 0.f, 0.f}, w1 = {0.f, 0.f, 0.f, 0.f};
    f32x4 p0 = {0.f, 0.f, 0.f, 0.f}, p1 = {0.f, 0.f, 0.f, 0.f}, o0 = {0.f, 0.f, 0.f, 0.f}, o1 = {0.f, 0.f, 0.f, 0.f};
    mm64t<true, false>(sBhT, sXT, lane, wid, n0, n1);
    mm64t<true, true>(sKhT, sVT, lane, wid, n0, n1);
    mm64t<true, false>(sBhT, sXT + 64 * LS, lane, wid, w0, w1);
    mm64(sMrb, sXT + 64 * LS, lane, wid, p0, p1);
    mm64(sMrb, sXT, lane, wid, o0, o1);
    mm64t<false, true>(sMrk, sVT, lane, wid, o0, o1);
    bf16r* nb = (bf16r*)(wsp(p) + OFF_NBUF) + ((size_t)(8 + h) * CH + cl) * 4096;
    store_nacc(nb, lane, wid, n0, n1);
#pragma unroll
    for (int j = 0; j < 4; ++j) {
      int row = rt * 16 + fq * 4 + j;
      int c0i = ct * 16 + fr, c1i = c0i + 16;
      float gt = 0.f;
#pragma unroll
      for (int w = 0; w < 8; ++w) gt += sTot[w * 64 + row];
      float eg = __expf(gt);
      sM[row * LS + c0i] = f2bf((row == c0i ? eg : 0.f) + w0[j]);
      sM[row * LS + c1i] = f2bf((row == c1i ? eg : 0.f) + w1[j]);
      sP[row * LS + c0i] = f2bf(bf2f(sRt[row * LS + c0i]) + p0[j]);
      sP[row * LS + c1i] = f2bf(bf2f(sRt[row * LS + c1i]) + p1[j]);
      sO0[row * LS + c0i] = f2bf(o0[j]);
      sO0[row * LS + c1i] = f2bf(o1[j]);
    }
  }
  __syncthreads();
  {
    const int fi = tid >> 6, s2 = fi & 1, rtm = fi >> 1;
    const int row = rtm * 16 + fr;
    uint2 lo = *(const uint2*)(sM + row * LS + (2 * s2) * 16 + fq * 4);
    uint2 hi = *(const uint2*)(sM + row * LS + (2 * s2 + 1) * 16 + fq * 4);
    bf16r* mb = (bf16r*)(wsp(p) + OFF_MBUF) + ((size_t)(8 + h) * CH + cl) * 4096;
    *(uint4*)(mb + (fi * 64 + lane) * 8) = uint4{lo.x, lo.y, hi.x, hi.y};
    bf16r* pr = (bf16r*)(wsp(p) + OFF_PROJ) + (size_t)t * PD + RWKV_B + h * 64 + j0;
    *(uint4*)(pr) = *(const uint4*)(sP + tt * LS + j0);
    *(uint4*)(pr + 512) = *(const uint4*)(sO0 + tt * LS + j0);
    *(uint4*)(pr + 1024) = v_pk;
  }
  asm volatile("" ::"v"(ta), "v"(tb));
}

__device__ void rwkv_output(const Params& p, int l, int c, int cl, int h, unsigned char* smem) {
  bf16r* sP = (bf16r*)smem;
  bf16r* sHT = sP + 64 * LS;
  float* sO = (float*)(sHT + 64 * LS);
  const int tid = opaque(threadIdx.x), lane = tid & 63, wid = tid >> 6;
  const int tt = tid >> 3, js = tid & 7, j0 = js * 8;
  const int fr = lane & 15, fq = lane >> 4, rt = wid >> 1, ct = (wid & 1) * 2;
  const int t = c * 64 + tt;
  const int ch0 = h * 64 + j0;
  bf16r* pr = (bf16r*)(wsp(p) + OFF_PROJ) + (size_t)t * PD + RWKV_B + ch0;
  const uint4 p_raw = *(const uint4*)(pr);
  const uint4 o0_raw = *(const uint4*)(pr + 512);
  const uint4 v_raw = *(const uint4*)(pr + 1024);
  const uint4 ht_raw = *(const uint4*)((const bf16r*)(wsp(p) + OFF_HTBUF) + ((size_t)(8 + h) * CH + cl) * 4096 + tt * 64 + j0);
  bf16r* gp = pr + 1664;
  const uint4 gate_cur = *(const uint4*)gp;
  uint4 gate_prv = uint4{0u, 0u, 0u, 0u};
  if (t > 0) gate_prv = (tt == 0) ? *(const uint4*)((const bf16r*)(wsp(p) + OFF_HALO) + (size_t)(c - 1) * 2176 + 1664 + ch0) : *(const uint4*)(gp - PD);
  const float bs = ((const float*)(wsp(p) + OFF_BON))[t * 8 + h];
  __syncthreads();
  *(uint4*)(sP + tt * LS + j0) = p_raw;
  *(uint4*)(sHT + tt * LS + j0) = ht_raw;
  __syncthreads();
  {
    f32x4 c0 = {0.f, 0.f, 0.f, 0.f}, c1 = {0.f, 0.f, 0.f, 0.f};
    mm64(sP, sHT, lane, wid, c0, c1);
#pragma unroll
    for (int j = 0; j < 4; ++j) {
      int row = rt * 16 + fq * 4 + j;
      sO[row * FS + ct * 16 + fr] = c0[j];
      sO[row * FS + (ct + 1) * 16 + fr] = c1[j];
    }
  }
  __syncthreads();
  {
    float o8[8], a8[8], v8[8], cur[8], prv[8], y8[8], sm = 0.f;
    unpack8(o0_raw, a8);
    unpack8(v_raw, v8);
    unpack8(gate_cur, cur);
    unpack8(gate_prv, prv);
#pragma unroll
    for (int j = 0; j < 8; ++j) { o8[j] = sO[tt * FS + j0 + j] + a8[j]; sm += o8[j]; }
    sm = red8(sm);
    const float mean = sm * (1.f / 64.f);
    float sv = 0.f;
#pragma unroll
    for (int j = 0; j < 8; ++j) { float d = o8[j] - mean; sv += d * d; }
    sv = red8(sv);
    const float rs = rsqrtf(sv * (1.f / 64.f) + 64e-5f);
    const float* mu = p.mu + (size_t)l * 2176;
#pragma unroll
    for (int j = 0; j < 8; ++j) {
      float gt = cur[j] + mu[1664 + ch0 + j] * (prv[j] - cur[j]);
      float on = (o8[j] - mean) * rs * p.ln_w[l * 512 + ch0 + j] + p.ln_b[l * 512 + ch0 + j];
      on += bs * v8[j];
      y8[j] = on * siluf_(gt);
    }
    *(uint4*)gp = pack8(y8);
  }
}

__device__ void scan_phase(const Params& p, int seg, int head, int ns, int lane_) {
  const int lane = opaque(lane_);
  const int fr = lane & 15, fq = lane >> 4;
  const int br = head >> 3;
  f32x4 acc[4];
  float* hst = (float*)(wsp(p) + OFF_HSTATE) + ((size_t)head * 4 + ns) * 1024;
  if (seg == 0) {
#pragma unroll
    for (int rt = 0; rt < 4; ++rt) acc[rt] = f32x4{0.f, 0.f, 0.f, 0.f};
  } else {
#pragma unroll
    for (int rt = 0; rt < 4; ++rt) acc[rt] = *(const f32x4*)(hst + (rt * 64 + lane) * 4);
  }
  const bf16r* nbase = (const bf16r*)(wsp(p) + OFF_NBUF) + (size_t)head * CH * 4096 + (ns * 4 * 64 + lane) * 4;
  bf16r* htbase = (bf16r*)(wsp(p) + OFF_HTBUF) + (size_t)head * CH * 4096 + (ns * 16 + fr) * 64 + fq * 4;
  constexpr int PFD = 4;
  if (br == 2) {
    const float* gbase = (const float*)(wsp(p) + OFF_GAM) + (size_t)(head - 16) * CH * 64 + fq * 4;
    uint2 n[PFD][4];
    f32x4 g[PFD][4];
#pragma unroll
    for (int k = 0; k < PFD; ++k)
#pragma unroll
      for (int rt = 0; rt < 4; ++rt) {
        n[k][rt] = *(const uint2*)(nbase + (size_t)k * 4096 + rt * 256);
        g[k][rt] = *(const f32x4*)(gbase + k * 64 + rt * 16);
      }
#pragma unroll 1
    for (int cl = 0; cl < CH; cl += PFD) {
#pragma unroll
      for (int k = 0; k < PFD; ++k) {
        const int cc = cl + k;
        if (cc >= CH) break;
        uint2 hv[4];
#pragma unroll
        for (int rt = 0; rt < 4; ++rt) {
          hv[rt].x = cvt_pk_bf16(acc[rt][0], acc[rt][1]);
          hv[rt].y = cvt_pk_bf16(acc[rt][2], acc[rt][3]);
          const f32x4 nf = {__uint_as_float(n[k][rt].x << 16), __uint_as_float(n[k][rt].x & 0xffff0000u),
                            __uint_as_float(n[k][rt].y << 16), __uint_as_float(n[k][rt].y & 0xffff0000u)};
          acc[rt] = acc[rt] * g[k][rt] + nf;
        }
#pragma unroll
        for (int rt = 0; rt < 4; ++rt) *(uint2*)(htbase + (size_t)cc * 4096 + rt * 16) = hv[rt];
        const int cn = (cc + PFD < CH) ? cc + PFD : CH - 1;
#pragma unroll
        for (int rt = 0; rt < 4; ++rt) {
          n[k][rt] = *(const uint2*)(nbase + (size_t)cn * 4096 + rt * 256);
          g[k][rt] = *(const f32x4*)(gbase + cn * 64 + rt * 16);
        }
      }
    }
  } else {
    const bf16r* mbase = (const bf16r*)(wsp(p) + OFF_MBUF) + (size_t)head * CH * 4096 + lane * 8;
    uint2 n[PFD][4];
    bf16x8 m[PFD][8];
#pragma unroll
    for (int k = 0; k < PFD; ++k) {
#pragma unroll
      for (int rt = 0; rt < 4; ++rt) n[k][rt] = *(const uint2*)(nbase + (size_t)k * 4096 + rt * 256);
#pragma unroll
      for (int i = 0; i < 8; ++i) m[k][i] = *(const bf16x8*)(mbase + (size_t)k * 4096 + i * 512);
    }
#pragma unroll 1
    for (int cl = 0; cl < CH; cl += PFD) {
#pragma unroll
      for (int k = 0; k < PFD; ++k) {
        const int cc = cl + k;
        if (cc >= CH) break;
        uint4 b0u, b1u;
        b0u.x = cvt_pk_bf16(acc[0][0], acc[0][1]);
        b0u.y = cvt_pk_bf16(acc[0][2], acc[0][3]);
        b0u.z = cvt_pk_bf16(acc[1][0], acc[1][1]);
        b0u.w = cvt_pk_bf16(acc[1][2], acc[1][3]);
        b1u.x = cvt_pk_bf16(acc[2][0], acc[2][1]);
        b1u.y = cvt_pk_bf16(acc[2][2], acc[2][3]);
        b1u.z = cvt_pk_bf16(acc[3][0], acc[3][1]);
        b1u.w = cvt_pk_bf16(acc[3][2], acc[3][3]);
        bf16x8 b0 = *(bf16x8*)&b0u, b1 = *(bf16x8*)&b1u;
#pragma unroll
        for (int rt = 0; rt < 4; ++rt) {
          const f32x4 nf = {__uint_as_float(n[k][rt].x << 16), __uint_as_float(n[k][rt].x & 0xffff0000u),
                            __uint_as_float(n[k][rt].y << 16), __uint_as_float(n[k][rt].y & 0xffff0000u)};
          f32x4 a = __builtin_amdgcn_mfma_f32_16x16x32_bf16(m[k][rt * 2], b0, nf, 0, 0, 0);
          acc[rt] = __builtin_amdgcn_mfma_f32_16x16x32_bf16(m[k][rt * 2 + 1], b1, a, 0, 0, 0);
        }
        *(uint2*)(htbase + (size_t)cc * 4096 + 0) = uint2{b0u.x, b0u.y};
        *(uint2*)(htbase + (size_t)cc * 4096 + 16) = uint2{b0u.z, b0u.w};
        *(uint2*)(htbase + (size_t)cc * 4096 + 32) = uint2{b1u.x, b1u.y};
        *(uint2*)(htbase + (size_t)cc * 4096 + 48) = uint2{b1u.z, b1u.w};
        const int cn = (cc + PFD < CH) ? cc + PFD : CH - 1;
#pragma unroll
        for (int rt = 0; rt < 4; ++rt) n[k][rt] = *(const uint2*)(nbase + (size_t)cn * 4096 + rt * 256);
#pragma unroll
        for (int i = 0; i < 8; ++i) m[k][i] = *(const bf16x8*)(mbase + (size_t)cn * 4096 + i * 512);
      }
    }
  }
#pragma unroll
  for (int rt = 0; rt < 4; ++rt) *(f32x4*)(hst + (rt * 64 + lane) * 4) = acc[rt];
}

__device__ void final_norm_phase(const Params& p) {
  const int tid_ = opaque(threadIdx.x);
  const int lane = tid_ & 63;
  const int gw = blockIdx.x * (NTHR / 64) + (tid_ >> 6);
  const int nw = gridDim.x * (NTHR / 64);
  for (int row = gw; row < T; row += nw) {
    float4* xr = (float4*)(p.out + (size_t)row * DM);
    float4 v[4];
    float ss = 0.f;
#pragma unroll
    for (int i = 0; i < 4; ++i) {
      v[i] = xr[lane + 64 * i];
      ss += v[i].x * v[i].x + v[i].y * v[i].y + v[i].z * v[i].z + v[i].w * v[i].w;
    }
    ss = red64(ss);
    float rs = rsqrtf(ss * (1.f / DM) + 1e-6f);
#pragma unroll
    for (int i = 0; i < 4; ++i) {
      float4 ww = ((const float4*)p.final_norm_w)[lane + 64 * i];
      float4 o;
      o.x = v[i].x * rs * ww.x; o.y = v[i].y * rs * ww.y; o.z = v[i].z * rs * ww.z; o.w = v[i].w * rs * ww.w;
      xr[lane + 64 * i] = o;
    }
  }
}

#define XB_TMO      128
#define XB_XCNT(j)  (256  + 64 * (j))
#define XB_XSUB(j)  (1280 + 64 * (j))
#define XB_XGEN(j)  (2304 + 64 * (j))
#define XB_TOP      3328
#define XB_TOPGEN   3392
#define XCD_BAR_WORDS 3456
#define XB_SPIN_CAP (1u << 18)
#define LAS __attribute__((address_space(3)))
__device__ __forceinline__ unsigned xb_ld(unsigned* p)              { return __hip_atomic_load(p, __ATOMIC_RELAXED, __HIP_MEMORY_SCOPE_AGENT); }
__device__ __forceinline__ unsigned xb_add(unsigned* p, unsigned v) { return __hip_atomic_fetch_add(p, v, __ATOMIC_RELAXED, __HIP_MEMORY_SCOPE_AGENT); }
__device__ __forceinline__ unsigned xb_xcc_id() { return (unsigned)__builtin_amdgcn_s_getreg((3 << 11) | 20) & 0xFu; }
#define XB_SPIN(cond, bar) do { unsigned _sp = 0; while (cond) { __builtin_amdgcn_s_sleep(1); \
    if ((++_sp & 255u) == 0u) { if (xb_ld(&(bar)[XB_TMO])) break; if (_sp > XB_SPIN_CAP) { atomicAdd(&(bar)[XB_TMO], 1u); break; } } } } while (0)
struct XcdBarrier { unsigned* bar; unsigned x; volatile LAS unsigned* st; };
__device__ __forceinline__ XcdBarrier xcd_barrier_post(unsigned* bar, volatile LAS unsigned* st) {
  XcdBarrier b; b.bar = bar; b.x = xb_xcc_id(); b.st = st;
  if (threadIdx.x == 0) (void)xb_add(&bar[XB_XCNT(b.x)], 1u);
  return b;
}
__device__ __forceinline__ void xcd_barrier_complete(unsigned* bar, unsigned x, unsigned& nloc, unsigned& nx) {
  const unsigned G = gridDim.x * gridDim.y * gridDim.z;
  unsigned sum, cnt, mine, sp = 0u;
  for (;;) {
    sum = 0u; cnt = 0u; mine = 0u;
#pragma unroll
    for (unsigned j = 0; j < 16; ++j) { const unsigned c = xb_ld(&bar[XB_XCNT(j)]); sum += c; cnt += (c > 0u) ? 1u : 0u; mine = (j == x) ? c : mine; }
    if (sum == G) break;
    __builtin_amdgcn_s_sleep(1);
    if ((++sp & 255u) == 0u) { if (xb_ld(&bar[XB_TMO])) break; if (sp > XB_SPIN_CAP) { atomicAdd(&bar[XB_TMO], 1u); break; } }
  }
  nloc = mine > 0u ? mine : 1u; nx = cnt > 0u ? cnt : 1u;
}
__device__ __forceinline__ void xcd_barrier(const XcdBarrier& b) {
  asm volatile("s_waitcnt vmcnt(0)" ::: "memory");
  __syncthreads();
  if (threadIdx.x == 0) {
    size_t zb = 0;
    asm volatile("" : "+s"(zb));
    unsigned* bar = b.bar + zb;
    __builtin_amdgcn_s_waitcnt(0);
    unsigned nloc = b.st[0], nx = b.st[1];
    if (nloc == 0u) { xcd_barrier_complete(bar, b.x, nloc, nx); b.st[0] = nloc; b.st[1] = nx; }
    const unsigned old = xb_add(&bar[XB_XSUB(b.x)], 1u);
    const unsigned gen = old / nloc;
    if (old + 1u == (gen + 1u) * nloc) {
      __builtin_amdgcn_fence(__ATOMIC_RELEASE, "agent");
      asm volatile("s_waitcnt vmcnt(0)" ::: "memory");
      const unsigned og = xb_add(&bar[XB_TOP], 1u);
      const unsigned tg = og / nx;
      if (og + 1u == (tg + 1u) * nx) xb_add(&bar[XB_TOPGEN], 1u);
      else XB_SPIN(xb_ld(&bar[XB_TOPGEN]) == tg, bar);
      __builtin_amdgcn_fence(__ATOMIC_ACQUIRE, "agent");
      xb_add(&bar[XB_XGEN(b.x)], 1u);
      asm volatile("s_waitcnt vmcnt(0)" ::: "memory");
    } else {
      XB_SPIN(xb_ld(&bar[XB_XGEN(b.x)]) == gen, bar);
      __builtin_amdgcn_fence(__ATOMIC_ACQUIRE, "agent");
      asm volatile("s_waitcnt vmcnt(0)" ::: "memory");
    }
  }
  __syncthreads();
}

__global__ void __launch_bounds__(NTHR) mega(Params p) {
  cg::grid_group grid = cg::this_grid();
  __shared__ __attribute__((aligned(16))) unsigned char smem[SMEM_BYTES];
  const int nb = gridDim.x, bid = blockIdx.x;
  __shared__ uint4 xb_words;
  if (threadIdx.x == 0) xb_words = make_uint4(0u, 0u, 0u, 0u);
  __syncthreads();
  XcdBarrier xb = xcd_barrier_post((unsigned*)(wsp(p) + OFF_BAR), (volatile LAS unsigned*)&xb_words);
  if (bid == 0) {
    float* lb = (float*)(wsp(p) + OFF_LB);
    int i = threadIdx.x;
    float b0 = p.lbnd[i], b1 = p.lbnd[512 + i];
    float m = fmaxf(b0, b1);
    float e0 = __expf(b0 - m), e1 = __expf(b1 - m);
    lb[i] = 0.f;
    lb[512 + i] = e1 / (e0 + e1);
  }
  grid.sync();
  for (int l = 0; l < 2; ++l) {
    const float* xin = (l == 0) ? p.x : p.out;
    if (l == 0) rows_bf16_rs(xin, (bf16r*)(wsp(p) + OFF_HBF), (float*)(wsp(p) + OFF_RS));
    else reduce_rs((const float*)(wsp(p) + OFF_SSP), (float*)(wsp(p) + OFF_RS));
    for (int tile = bid; tile < 1600 + 384; tile += nb) {
      if (tile < 1600) {
        int kt = tile & 15, ntile = tile >> 4;
        transpose_tile<true>(p.w_in + (size_t)l * DM * NCOL, (bf16r*)(wsp(p) + OFF_WIN), DM, NCOL, kt * 64, ntile * 64, smem, p.norm_w + l * DM);
      } else {
        int tt = tile - 1600;
        int kt = tt % 24, ntile = tt / 24;
        transpose_tile<false>(p.w_out + (size_t)l * DMIX * DM, (bf16r*)(wsp(p) + OFF_WOUT), DMIX, DM, kt * 64, ntile * 64, smem, nullptr);
      }
    }
    {
      bf16r* lora = (bf16r*)(wsp(p) + OFF_LORA);
      for (int e = bid * NTHR + opaque(threadIdx.x); e < 2 * 512 * 8; e += nb * NTHR) {
        int which = e >> 12, ch = (e >> 3) & 511, is = e & 7;
        const float* src = (which ? p.a_up : p.w_up) + (size_t)l * 64 * 512 + ch;
        float f[8];
#pragma unroll
        for (int j = 0; j < 8; ++j) f[j] = src[(is * 8 + j) * 512];
        *(uint4*)(lora + ((size_t)which * 512 + ch) * 64 + is * 8) = pack8(f);
      }
    }
    xcd_barrier(xb);
    {
      pg8::StaticOrder so; so.init(T, PDP, nb, bid);
      pg8::EpiProj ep{wsp(p)};
      __syncthreads();
      pg8::gemm_phase<1>((PG8_LAS unsigned char*)smem, (const bf16r*)(wsp(p) + OFF_HBF), (const bf16r*)(wsp(p) + OFF_WIN), T, PDP, so, ep);
      __syncthreads();
    }
    xcd_barrier(xb);
    for (int seg = 0; seg < NSEG; ++seg) {
      for (int it = bid; it < 24 * CH; it += nb) {
        int hh = it / CH, cl = it % CH;
        if (seg > 0) {
          if (hh < 8) gdn_output(p, l, (seg - 1) * CH + cl, cl, hh, smem);
          else if (hh < 16) rwkv_output(p, l, (seg - 1) * CH + cl, cl, hh - 8, smem);
          else hgrn_output(p, l, (seg - 1) * CH + cl, cl, hh - 16, smem);
        }
        const int it2 = it + nb;
        const int nhh = (it2 < 24 * CH) ? it2 / CH : -1, nc = seg * CH + (it2 % CH);
        if (hh < 8) gdn_prep(p, l, seg * CH + cl, cl, hh, smem, nc, nhh);
        else if (hh < 16) rwkv_prep(p, l, seg * CH + cl, cl, hh - 8, smem, nc, nhh);
        else hgrn_prep(p, l, seg * CH + cl, cl, hh - 16, smem, nc, nhh);
      }
      xcd_barrier(xb);
      if (threadIdx.x < 64 && bid < 96) scan_phase(p, seg, bid >> 2, bid & 3, threadIdx.x);
      xcd_barrier(xb);
    }
    for (int it = bid; it < 24 * CH; it += nb) {
      int hh = it / CH, cl = it % CH;
      if (hh < 8) gdn_output(p, l, (NSEG - 1) * CH + cl, cl, hh, smem);
      else if (hh < 16) rwkv_output(p, l, (NSEG - 1) * CH + cl, cl, hh - 8, smem);
      else hgrn_output(p, l, (NSEG - 1) * CH + cl, cl, hh - 16, smem);
    }
    xcd_barrier(xb);
    hgrn_norm_phase(p, l);
    xcd_barrier(xb);
    {
      pg8::StaticOrder so; so.init(T, DM, nb, bid);
      pg8::EpiResid er{xin, p.out, wsp(p), l == 0};
      __syncthreads();
      pg8::gemm_phase<2>((PG8_LAS unsigned char*)smem, (const bf16r*)(wsp(p) + OFF_PROJ), (const bf16r*)(wsp(p) + OFF_WOUT), T, DM, so, er);
      __syncthreads();
    }
    xcd_barrier(xb);
  }
  final_norm_phase(p);
}

extern "C" void kernel_launch(void* const* d_in, const int* in_sizes, int n_in,
                              void* d_out, int out_size, void* d_ws, size_t ws_size,
                              hipStream_t stream) {
  static int grid_blocks = 0;
  if (!grid_blocks) {
    int dev = 0, cus = 0, per_cu = 0;
    (void)hipGetDevice(&dev);
    (void)hipDeviceGetAttribute(&cus, hipDeviceAttributeMultiprocessorCount, dev);
    (void)hipOccupancyMaxActiveBlocksPerMultiprocessor(&per_cu, mega, NTHR, 0);
    if (per_cu > 1) per_cu = 1;
    if (per_cu < 1) per_cu = 1;
    grid_blocks = cus * per_cu;
  }
  Params p{};
  p.x = (const float*)d_in[0]; p.norm_w = (const float*)d_in[1]; p.w_in = (const float*)d_in[2];
  p.conv_w = (const float*)d_in[3]; p.a_log = (const float*)d_in[4]; p.dt_bias = (const float*)d_in[5];
  p.gdn_norm_w = (const float*)d_in[6]; p.mu = (const float*)d_in[7]; p.w0 = (const float*)d_in[8];
  p.w_up = (const float*)d_in[9]; p.a0 = (const float*)d_in[10]; p.a_up = (const float*)d_in[11];
  p.k_k = (const float*)d_in[12]; p.k_a = (const float*)d_in[13]; p.r_k = (const float*)d_in[14];
  p.ln_w = (const float*)d_in[15]; p.ln_b = (const float*)d_in[16]; p.lbnd = (const float*)d_in[17];
  p.hgrn_norm_w = (const float*)d_in[18]; p.w_out = (const float*)d_in[19]; p.final_norm_w = (const float*)d_in[20];
  p.out = (float*)d_out; p.ws = (unsigned char*)d_ws;
  (void)hipMemsetAsync((unsigned char*)d_ws + OFF_BAR, 0, 16384, stream);
  void* args[] = {&p};
  hipError_t e = hipLaunchCooperativeKernel((void*)mega, dim3(grid_blocks), dim3(NTHR), args, 0, stream);
  if (e != hipSuccess) fprintf(stderr, "coop launch failed: %s\n", hipGetErrorString(e));
}
```

```cpp
#include <hip/hip_runtime.h>
#include <hip/hip_cooperative_groups.h>
#include <cstdio>
namespace cg = cooperative_groups;

typedef unsigned short bf16r;
using bf16x8 = __attribute__((ext_vector_type(8))) short;
using f32x4 = __attribute__((ext_vector_type(4))) float;

constexpr int T = 16384, DM = 1024, NCOL = 6288, PDP = 6400, DMIX = 1536;
constexpr int PD = 6272;
constexpr int GDN_GATE = 1536, RWKV_B = 2048, HGRN_B = 4224;
constexpr int NTHR = 512;
constexpr size_t OFF_PROJ = 0;
constexpr size_t OFF_WOUT = 206045184;
constexpr size_t OFF_GSC = OFF_WOUT + 3145728;
constexpr size_t OFF_HALO = OFF_GSC + 1048576;
constexpr size_t OFF_LB = OFF_HALO + 1179648;
constexpr size_t OFF_LORA = OFF_LB + 4096;
constexpr size_t OFF_BAR = OFF_LORA + 131072;
constexpr size_t OFF_SCR = OFF_BAR + 16384;
constexpr size_t OFF_HBF = OFF_SCR;
constexpr size_t OFF_WIN = OFF_SCR + 33554432;
constexpr int SMEM_BYTES = 131072;
constexpr int CH = 128, NSEG = 2;
constexpr size_t OFF_MBUF = OFF_SCR;
constexpr size_t OFF_GAM = OFF_MBUF + (size_t)16 * CH * 8192;
constexpr size_t OFF_NBUF = OFF_GAM + (size_t)8 * CH * 256;
constexpr size_t OFF_HTBUF = OFF_NBUF;
constexpr size_t OFF_HSTATE = OFF_NBUF + (size_t)24 * CH * 8192;
constexpr size_t OFF_HALO2 = OFF_SCR + 49807360;
constexpr size_t OFF_BON = OFF_HALO2 + 2359296;
constexpr size_t OFF_SSP = OFF_BON + 524288;
constexpr size_t OFF_RS = OFF_SSP + 1048576;
constexpr int LS = 72;
constexpr int FS = 68;

struct Params {
  const float* x; const float* norm_w; const float* w_in; const float* conv_w; const float* a_log;
  const float* dt_bias; const float* gdn_norm_w; const float* mu; const float* w0; const float* w_up;
  const float* a0; const float* a_up; const float* k_k; const float* k_a; const float* r_k;
  const float* ln_w; const float* ln_b; const float* lbnd; const float* hgrn_norm_w; const float* w_out;
  const float* final_norm_w;
  float* out; unsigned char* ws;
};

typedef float f32x2_t __attribute__((ext_vector_type(2)));
typedef __bf16 bf16x2_t __attribute__((ext_vector_type(2)));
__device__ __forceinline__ unsigned char* wsp(const Params& p) {
  size_t z = 0;
  asm volatile("" : "+s"(z));
  return p.ws + z;
}
__device__ __forceinline__ unsigned cvt_pk_bf16(float lo, float hi) {
  f32x2_t f = {lo, hi};
  bf16x2_t b = __builtin_convertvector(f, bf16x2_t);
  return __builtin_bit_cast(unsigned, b);
}
__device__ __forceinline__ bf16r f2bf(float f) { return (bf16r)(cvt_pk_bf16(f, f) & 0xffffu); }
__device__ __forceinline__ int opaque(int v) { asm volatile("" : "+v"(v)); return v; }
__device__ __forceinline__ float bf2f(bf16r h) { return __uint_as_float(((unsigned)h) << 16); }
__device__ __forceinline__ float sigmoidf_(float x) { return __builtin_amdgcn_rcpf(1.f + __expf(-x)); }
__device__ __forceinline__ float siluf_(float x) { return x * __builtin_amdgcn_rcpf(1.f + __expf(-x)); }
__device__ __forceinline__ float softplusf_(float x) { return x > 20.f ? x : __logf(1.f + __expf(x)); }
template <int CTRL> __device__ __forceinline__ float dpp_mov(float v) {
  return __int_as_float(__builtin_amdgcn_update_dpp(0, __float_as_int(v), CTRL, 0xf, 0xf, true));
}
__device__ __forceinline__ float red8(float v) {
  v += dpp_mov<0xB1>(v);
  v += dpp_mov<0x4E>(v);
  v += dpp_mov<0x141>(v);
  return v;
}
__device__ __forceinline__ float red64(float v) {
  v = red8(v);
  v += dpp_mov<0x128>(v);
  v += __shfl_xor(v, 16); v += __shfl_xor(v, 32); return v;
}
__device__ __forceinline__ void unpack8(uint4 u, float* f) {
  f[0] = __uint_as_float(u.x << 16); f[1] = __uint_as_float(u.x & 0xffff0000u);
  f[2] = __uint_as_float(u.y << 16); f[3] = __uint_as_float(u.y & 0xffff0000u);
  f[4] = __uint_as_float(u.z << 16); f[5] = __uint_as_float(u.z & 0xffff0000u);
  f[6] = __uint_as_float(u.w << 16); f[7] = __uint_as_float(u.w & 0xffff0000u);
}
__device__ __forceinline__ uint4 pack8(const float* f) {
  uint4 u;
  u.x = cvt_pk_bf16(f[0], f[1]);
  u.y = cvt_pk_bf16(f[2], f[3]);
  u.z = cvt_pk_bf16(f[4], f[5]);
  u.w = cvt_pk_bf16(f[6], f[7]);
  return u;
}

template <bool SCALE>
__device__ void transpose_tile(const float* __restrict__ src, bf16r* __restrict__ dst, int K, int N, int k0, int n0,
                               unsigned char* smem, const float* __restrict__ kscale) {
  float* tile = (float*)smem;
  const int tid = opaque(threadIdx.x);
  __syncthreads();
#pragma unroll
  for (int i = 0; i < 2; ++i) {
    const int kk = i * 32 + (tid >> 4), n4 = (tid & 15) * 4;
    float4 v = (n0 + n4 < N) ? *(const float4*)(src + (size_t)(k0 + kk) * N + n0 + n4) : float4{0.f, 0.f, 0.f, 0.f};
    if (SCALE) { const float ks = kscale[k0 + kk]; v.x *= ks; v.y *= ks; v.z *= ks; v.w *= ks; }
    tile[kk * 65 + n4 + 0] = v.x; tile[kk * 65 + n4 + 1] = v.y; tile[kk * 65 + n4 + 2] = v.z; tile[kk * 65 + n4 + 3] = v.w;
  }
  __syncthreads();
  int n = tid >> 3, ks = tid & 7;
  float f[8];
#pragma unroll
  for (int j = 0; j < 8; ++j) f[j] = tile[(ks * 8 + j) * 65 + n];
  *(uint4*)(dst + (size_t)(n0 + n) * K + k0 + ks * 8) = pack8(f);
}

template <int MODE>
__device__ void gemm_tile(const Params& p, const float* __restrict__ xin, int mt, int nt, unsigned char* smem) {
  constexpr int K = (MODE == 1) ? 1024 : 1536;
  bf16r* As = (bf16r*)smem;
  bf16r* Bs = As + 256 * LS;
  const bf16r* proj = (const bf16r*)(wsp(p) + OFF_PROJ);
  const bf16r* hbf = (const bf16r*)(wsp(p) + OFF_HBF);
  const bf16r* Bm = (MODE == 1) ? (const bf16r*)(wsp(p) + OFF_WIN) : (const bf16r*)(wsp(p) + OFF_WOUT);
  const int tid = opaque(threadIdx.x), lane = tid & 63, wid = tid >> 6;
  const int wr = wid >> 1, wc = wid & 1, fr = lane & 15, fq = lane >> 4;
  const int m0 = mt * 256, n0 = nt * 128;
  f32x4 acc[4][4];
#pragma unroll
  for (int i = 0; i < 4; ++i)
#pragma unroll
    for (int j = 0; j < 4; ++j) acc[i][j] = f32x4{0.f, 0.f, 0.f, 0.f};
  uint4 ra0, ra1, ra2, ra3, rb0, rb1;
  const int lrow = tid >> 3, lkc = tid & 7;
  const bf16r* aptr;
  if (MODE == 1) aptr = hbf + (size_t)(m0 + lrow) * 1024 + lkc * 8;
  else aptr = proj + (size_t)(m0 + lrow) * PD + lkc * 8;
  constexpr size_t ASTR = (MODE == 1) ? (size_t)64 * 1024 : (size_t)64 * PD;
  const bf16r* bptr = Bm + (size_t)(n0 + lrow) * K + lkc * 8;
#define GLOAD(k0_)                                                                              \
  {                                                                                             \
    int kk_ = (k0_);                                                                            \
    if (MODE == 2) { int blk_ = kk_ >> 9; kk_ = (blk_ == 0 ? 1536 : (blk_ == 1 ? 3712 : 5760)) + (kk_ & 511); } \
    ra0 = *(const uint4*)(aptr + kk_);                                                          \
    ra1 = *(const uint4*)(aptr + ASTR + kk_);                                                   \
    ra2 = *(const uint4*)(aptr + 2 * ASTR + kk_);                                               \
    ra3 = *(const uint4*)(aptr + 3 * ASTR + kk_);                                               \
    rb0 = *(const uint4*)(bptr + (k0_));                                                        \
    rb1 = *(const uint4*)(bptr + (size_t)64 * K + (k0_));                                       \
  }
  GLOAD(0);
  constexpr int NK = K / 64;
#pragma unroll 1
  for (int kt = 0; kt < NK; ++kt) {
    __syncthreads();
    *(uint4*)(As + lrow * LS + lkc * 8) = ra0;
    *(uint4*)(As + (lrow + 64) * LS + lkc * 8) = ra1;
    *(uint4*)(As + (lrow + 128) * LS + lkc * 8) = ra2;
    *(uint4*)(As + (lrow + 192) * LS + lkc * 8) = ra3;
    *(uint4*)(Bs + lrow * LS + lkc * 8) = rb0;
    *(uint4*)(Bs + (lrow + 64) * LS + lkc * 8) = rb1;
    __syncthreads();
    if (kt + 1 < NK) GLOAD((kt + 1) * 64);
#pragma unroll
    for (int ks = 0; ks < 2; ++ks) {
      bf16x8 bfr[4];
#pragma unroll
      for (int ni = 0; ni < 4; ++ni)
        bfr[ni] = *(const bf16x8*)(Bs + (wc * 64 + ni * 16 + fr) * LS + ks * 32 + fq * 8);
#pragma unroll
      for (int mi = 0; mi < 4; ++mi) {
        bf16x8 afr = *(const bf16x8*)(As + (wr * 64 + mi * 16 + fr) * LS + ks * 32 + fq * 8);
#pragma unroll
        for (int ni = 0; ni < 4; ++ni)
          acc[mi][ni] = __builtin_amdgcn_mfma_f32_16x16x32_bf16(afr, bfr[ni], acc[mi][ni], 0, 0, 0);
      }
    }
  }
#undef GLOAD
  if (MODE == 1) {
    bf16r* projw = (bf16r*)(wsp(p) + OFF_PROJ);
    float* gsc = (float*)(wsp(p) + OFF_GSC);
    bf16r* halo = (bf16r*)(wsp(p) + OFF_HALO);
#pragma unroll
    for (int mi = 0; mi < 4; ++mi)
#pragma unroll
      for (int ni = 0; ni < 4; ++ni) {
        int col = n0 + wc * 64 + ni * 16 + fr;
        if (col < NCOL) {
#pragma unroll
          for (int j = 0; j < 4; ++j) {
            int row = m0 + wr * 64 + mi * 16 + fq * 4 + j;
            float v = acc[mi][ni][j];
            bf16r b = f2bf(v);
            projw[(size_t)row * PD + col] = b;
            if (col >= 1536 && col < 1552) gsc[row * 16 + col - 1536] = v;
            if ((row & 63) == 63 && col >= RWKV_B && col < HGRN_B) halo[(row >> 6) * 2176 + col - RWKV_B] = b;
          }
        }
      }
  } else {
#pragma unroll
    for (int mi = 0; mi < 4; ++mi)
#pragma unroll
      for (int ni = 0; ni < 4; ++ni) {
        int col = n0 + wc * 64 + ni * 16 + fr;
#pragma unroll
        for (int j = 0; j < 4; ++j) {
          int row = m0 + wr * 64 + mi * 16 + fq * 4 + j;
          size_t o = (size_t)row * DM + col;
          p.out[o] = xin[o] + acc[mi][ni][j];
        }
      }
  }
}

namespace pg8 {
#define PG8_LAS __attribute__((address_space(3)))
constexpr int BM = 256, BK = 64, HALF = 128, HTB = HALF * BK * 2, STAGE_BYTES = 8 * HTB, NXCD = 8, WGM = 8;
__device__ __forceinline__ int lds_byte(int r, int c) { const int st = (r >> 4) * 2 + (c >> 5), rr = r & 15, cc = c & 31, ob = rr * 64 + cc * 2; return st * 1024 + (ob ^ (((ob >> 9) & 1) << 5)); }
__device__ __forceinline__ void stage_rc(int b, int& R, int& C) { const int st = b / 1024, sb = b % 1024, swz = sb ^ (((sb >> 9) & 1) << 5); R = (st >> 1) * 16 + swz / 64; C = (st & 1) * 32 + (swz % 64) / 2; }
__device__ __forceinline__ int perm32(int rho) { const int n = rho >> 4, i = rho & 15; return 8 * (i >> 2) + 4 * n + (i & 3); }
struct Unit { int pm, pn; };
struct StaticOrder {
  int nM, nN, nwg, G, c;
  __device__ void init(int M, int N, int G_, int c_) { nM = M / BM; nN = N / BM; nwg = nM * nN; G = G_; c = c_; }
  __device__ bool next(int i, Unit& u) const {
    const long L = (long)i * G + c; if (L >= nwg) return false;
    int wgid = (int)L; { const int q = nwg / NXCD, r = nwg % NXCD, xcd = wgid % NXCD, off = wgid / NXCD; wgid = (xcd < r ? xcd * (q + 1) : r * (q + 1) + (xcd - r) * q) + off; }
    const int nig = WGM * nN, gid = wgid / nig, fm = gid * WGM, gsz = (nM - fm) < WGM ? (nM - fm) : WGM;
    u.pm = fm + ((wgid % nig) % gsz); u.pn = (wgid % nig) / gsz; return true;
  }
};
template <int MODE> __device__ __forceinline__ size_t a_koff(int t) {
  if (MODE == 1) return (size_t)t * (BK * 2);
  const int blk = t >> 3;
  const int cb = (blk == 0 ? 1536 : (blk == 1 ? 3712 : 5760));
  return (size_t)cb * 2 + (size_t)(t & 7) * (BK * 2);
}
template <int MODE, class Epi>
__device__ __forceinline__ void gemm_phase(PG8_LAS unsigned char* lds, const unsigned short* A, const unsigned short* Bt, int M, int N, const StaticOrder& S, const Epi& E) {
  constexpr int K = (MODE == 1) ? 1024 : 1536;
  constexpr int LDA = (MODE == 1) ? 1024 : PD;
  const int tid = opaque(threadIdx.x), wid = __builtin_amdgcn_readfirstlane(tid >> 6), lane = tid & 63, wr = wid >> 2, wc = wid & 3, fr = lane & 15, fq = lane >> 4;
  constexpr int nt = K / BK;
  unsigned voffA[2], voffB[2];
#pragma unroll
  for (int i = 0; i < 2; ++i) { int R, C; stage_rc(tid * 16 + i * 8192, R, C); const int Rb = Epi::PERM ? ((R & ~31) + perm32(R & 31)) : R;
    voffA[i] = (unsigned)(R * LDA + C) * 2u; voffB[i] = (unsigned)(Rb * K + C) * 2u; }
  const size_t kstep = (size_t)(BK * 2);
  const size_t hstepA = (size_t)HALF * LDA * 2, hstepB = (size_t)HALF * K * 2;
  const size_t tstepA = 2 * hstepA, tstepB = 2 * hstepB;
  const unsigned ldsw = (unsigned)wid * 1024u;
  const int aoff = lds_byte(wr * 64 + fr, fq * 8), boff = lds_byte(wc * 32 + fr, fq * 8);
#define PG8_SA(b, h) (((b) * 2 + (h)) * HTB)
#define PG8_SB(b, h) ((4 + (b) * 2 + (h)) * HTB)
#define PG8_STAGE(bufoff, gbase, voff) do { _Pragma("unroll") for (int _i = 0; _i < 2; ++_i) \
    __builtin_amdgcn_global_load_lds((const unsigned*)((const char*)(gbase) + (voff)[_i]), (PG8_LAS unsigned*)(lds + (bufoff) + ldsw + _i * 8192), 16, 0, 0); } while (0)
#define PG8_LDA(dst, b, h) do { _Pragma("unroll") for (int m = 0; m < 4; ++m) _Pragma("unroll") for (int k = 0; k < 2; ++k) dst[m][k] = *(const PG8_LAS bf16x8*)(lds + PG8_SA(b, h) + aoff + m * 2048 + k * 1024); } while (0)
#define PG8_LDB(dst, b, h) do { _Pragma("unroll") for (int n = 0; n < 2; ++n) _Pragma("unroll") for (int k = 0; k < 2; ++k) dst[n][k] = *(const PG8_LAS bf16x8*)(lds + PG8_SB(b, h) + boff + n * 2048 + k * 1024); } while (0)
#define PG8_MMA(ai, bj, At, Bt_) do { __builtin_amdgcn_s_setprio(1); _Pragma("unroll") for (int m = 0; m < 4; ++m) _Pragma("unroll") for (int n = 0; n < 2; ++n) _Pragma("unroll") for (int k = 0; k < 2; ++k) \
    acc[ai][bj][m][n] = __builtin_amdgcn_mfma_f32_16x16x32_bf16(Bt_[n][k], At[m][k], acc[ai][bj][m][n], 0, 0, 0); __builtin_amdgcn_s_setprio(0); } while (0)
#define PG8_WAIT_V(n) asm volatile("s_waitcnt vmcnt(" #n ")" ::: "memory")
#define PG8_WAIT_L(n) asm volatile("s_waitcnt lgkmcnt(" #n ")" ::: "memory")
#define PG8_BAR __builtin_amdgcn_s_barrier()
#define PG8_SCHED __builtin_amdgcn_sched_barrier(0)
  Unit cur, nxt; int ui = 0;
  if (!S.next(0, cur)) return;
  f32x4 acc[2][2][4][2];
#pragma unroll
  for (int a = 0; a < 2; ++a)
#pragma unroll
    for (int b = 0; b < 2; ++b)
#pragma unroll
      for (int m = 0; m < 4; ++m)
#pragma unroll
        for (int n = 0; n < 2; ++n) acc[a][b][m][n] = (f32x4){0.f, 0.f, 0.f, 0.f};
  bf16x8 At[4][2], B0[2][2], B1[2][2];
  const char* cA = (const char*)A + (size_t)cur.pm * tstepA; const char* cB = (const char*)Bt + (size_t)cur.pn * tstepB;
  PG8_STAGE(PG8_SB(0, 0), cB, voffB); PG8_STAGE(PG8_SA(0, 0), cA + a_koff<MODE>(0), voffA); PG8_STAGE(PG8_SB(0, 1), cB + hstepB, voffB); PG8_STAGE(PG8_SA(0, 1), cA + a_koff<MODE>(0) + hstepA, voffA);
  if (wr == 1) PG8_BAR;
  PG8_WAIT_V(4); PG8_BAR;
  PG8_STAGE(PG8_SB(1, 0), cB + kstep, voffB); PG8_STAGE(PG8_SA(1, 0), cA + a_koff<MODE>(1), voffA); PG8_STAGE(PG8_SB(1, 1), cB + hstepB + kstep, voffB);
  PG8_WAIT_V(6); PG8_BAR;
  for (;;) {
    const bool has_next = S.next(ui + 1, nxt);
    const char* nA = has_next ? (const char*)A + (size_t)nxt.pm * tstepA : cA; const char* nB = has_next ? (const char*)Bt + (size_t)nxt.pn * tstepB : cB;
#pragma unroll 1
    for (int t = 0; t < nt; t += 2) {
      const bool last = (t == nt - 2);
      const char* a1 = cA + a_koff<MODE>(t + 1);
      const char* a2 = last ? nA + a_koff<MODE>(0) : cA + a_koff<MODE>(t + 2);
      const char* a3 = last ? nA + a_koff<MODE>(1) : cA + a_koff<MODE>(t + 3);
      const char* b2 = last ? nB : cB + (size_t)(t + 2) * kstep;
      const char* b3 = b2 + kstep;
      PG8_LDB(B0, 0, 0); PG8_SCHED; PG8_LDA(At, 0, 0); PG8_STAGE(PG8_SA(1, 1), a1 + hstepA, voffA);
      PG8_WAIT_L(8); PG8_BAR; PG8_WAIT_L(0); PG8_MMA(0, 0, At, B0); PG8_BAR; PG8_SCHED;
      PG8_LDB(B1, 0, 1); PG8_STAGE(PG8_SB(0, 0), b2, voffB);
      PG8_BAR; PG8_WAIT_L(0); PG8_MMA(0, 1, At, B1); PG8_BAR;
      PG8_LDA(At, 0, 1); PG8_STAGE(PG8_SA(0, 0), a2, voffA);
      PG8_BAR; PG8_WAIT_L(0); PG8_MMA(1, 0, At, B0); PG8_BAR; PG8_SCHED;
      PG8_STAGE(PG8_SB(0, 1), b2 + hstepB, voffB);
      PG8_WAIT_V(6); PG8_BAR; PG8_MMA(1, 1, At, B1); PG8_BAR;
      PG8_LDB(B0, 1, 0); PG8_SCHED; PG8_LDA(At, 1, 0); PG8_STAGE(PG8_SA(0, 1), a2 + hstepA, voffA);
      PG8_WAIT_L(8); PG8_BAR; PG8_WAIT_L(0); PG8_MMA(0, 0, At, B0); PG8_BAR; PG8_SCHED;
      PG8_LDB(B1, 1, 1); PG8_STAGE(PG8_SB(1, 0), b3, voffB);
      PG8_BAR; PG8_WAIT_L(0); PG8_MMA(0, 1, At, B1); PG8_BAR;
      PG8_LDA(At, 1, 1); PG8_STAGE(PG8_SA(1, 0), a3, voffA);
      PG8_BAR; PG8_WAIT_L(0); PG8_MMA(1, 0, At, B0); PG8_BAR; PG8_SCHED;
      PG8_STAGE(PG8_SB(1, 1), b3 + hstepB, voffB);
      PG8_WAIT_V(6); PG8_BAR; PG8_MMA(1, 1, At, B1); PG8_BAR;
    }
    E(acc, cur, wr, wc, fr, fq);
    if (!has_next) break;
#pragma unroll
    for (int a = 0; a < 2; ++a)
#pragma unroll
      for (int b = 0; b < 2; ++b)
#pragma unroll
        for (int m = 0; m < 4; ++m)
#pragma unroll
          for (int n = 0; n < 2; ++n) acc[a][b][m][n] = (f32x4){0.f, 0.f, 0.f, 0.f};
    cur = nxt; cA = nA; cB = nB; ++ui;
  }
  PG8_WAIT_V(0);
  if (wr == 0) PG8_BAR;
  PG8_BAR;
#undef PG8_SA
#undef PG8_SB
#undef PG8_STAGE
#undef PG8_LDA
#undef PG8_LDB
#undef PG8_MMA
#undef PG8_WAIT_V
#undef PG8_WAIT_L
#undef PG8_BAR
#undef PG8_SCHED
}
struct EpiProj {
  static constexpr bool PERM = true;
  unsigned char* ws;
  __device__ __forceinline__ void operator()(const f32x4 (&acc)[2][2][4][2], const Unit& u, int wr, int wc, int fr, int fq) const {
    bf16r* projw = (bf16r*)(ws + OFF_PROJ);
    float* gsc = (float*)(ws + OFF_GSC);
    bf16r* halo = (bf16r*)(ws + OFF_HALO);
#pragma unroll
    for (int ai = 0; ai < 2; ++ai)
#pragma unroll
      for (int m = 0; m < 4; ++m) {
        const int row = u.pm * BM + ai * HALF + wr * 64 + m * 16 + fr;
        const float rsr = ((const float*)(ws + OFF_RS))[row];
#pragma unroll
        for (int bj = 0; bj < 2; ++bj) {
          const int c0 = u.pn * BM + bj * HALF + wc * 32 + 8 * fq;
          if (c0 < NCOL) {
            const f32x4 v0 = acc[ai][bj][m][0] * rsr, v1 = acc[ai][bj][m][1] * rsr;
            if (c0 >= 1536 && c0 < 1552) {
              *(f32x4*)(gsc + row * 16 + (c0 - 1536)) = v0;
              *(f32x4*)(gsc + row * 16 + (c0 - 1536) + 4) = v1;
            } else {
              const int cs = (c0 < 1536) ? c0 : c0 - 16;
              uint4 pk;
              pk.x = cvt_pk_bf16(v0[0], v0[1]); pk.y = cvt_pk_bf16(v0[2], v0[3]);
              pk.z = cvt_pk_bf16(v1[0], v1[1]); pk.w = cvt_pk_bf16(v1[2], v1[3]);
              *(uint4*)(projw + (size_t)row * PD + cs) = pk;
              if ((row & 63) == 63 && cs >= RWKV_B && cs < HGRN_B) *(uint4*)(halo + (size_t)(row >> 6) * 2176 + (cs - RWKV_B)) = pk;
              if ((row & 63) >= 61 && cs < 1536) *(uint4*)((bf16r*)(ws + OFF_HALO2) + ((size_t)(row >> 6) * 3 + ((row & 63) - 61)) * 1536 + cs) = pk;
            }
          }
        }
      }
  }
};
struct EpiResid {
  static constexpr bool PERM = false;
  const float* xin; float* out; unsigned char* ws; bool next_in;
  __device__ __forceinline__ void operator()(const f32x4 (&acc)[2][2][4][2], const Unit& u, int wr, int wc, int fr, int fq) const {
    bf16r* hbf = (bf16r*)(ws + OFF_HBF);
    float* ssp = (float*)(ws + OFF_SSP) + (size_t)(u.pn * 4 + wc) * T;
#pragma unroll
    for (int ai = 0; ai < 2; ++ai)
#pragma unroll
      for (int m = 0; m < 4; ++m) {
        const int row = u.pm * BM + ai * HALF + wr * 64 + m * 16 + fr;
        float ss = 0.f;
#pragma unroll
        for (int bj = 0; bj < 2; ++bj)
#pragma unroll
          for (int n = 0; n < 2; ++n) {
            const int c0 = u.pn * BM + bj * HALF + wc * 32 + 16 * n + 4 * fq;
            const size_t o = (size_t)row * DM + c0;
            const f32x4 x = *(const f32x4*)(xin + o);
            const f32x4 y = x + acc[ai][bj][m][n];
            *(f32x4*)(out + o) = y;
            if (next_in) {
              ss += y[0] * y[0] + y[1] * y[1] + y[2] * y[2] + y[3] * y[3];
              *(uint2*)(hbf + o) = uint2{cvt_pk_bf16(y[0], y[1]), cvt_pk_bf16(y[2], y[3])};
            }
          }
        if (next_in) {
          ss += __shfl_xor(ss, 16);
          ss += __shfl_xor(ss, 32);
          if (fq == 0) ssp[row] = ss;
        }
      }
  }
};
}

__device__ void rows_bf16_rs(const float* __restrict__ xin, bf16r* __restrict__ dst, float* __restrict__ rsout) {
  const int tid_ = opaque(threadIdx.x);
  const int lane = tid_ & 63;
  const int gw = blockIdx.x * (NTHR / 64) + (tid_ >> 6);
  const int nw = gridDim.x * (NTHR / 64);
  for (int row = gw; row < T; row += nw) {
    const float4* xr = (const float4*)(xin + (size_t)row * DM);
    float4 v[4];
    float ss = 0.f;
#pragma unroll
    for (int i = 0; i < 4; ++i) {
      v[i] = xr[lane + 64 * i];
      ss += v[i].x * v[i].x + v[i].y * v[i].y + v[i].z * v[i].z + v[i].w * v[i].w;
    }
    ss = red64(ss);
    if (lane == 0) rsout[row] = rsqrtf(ss * (1.f / DM) + 1e-6f);
#pragma unroll
    for (int i = 0; i < 4; ++i) {
      uint2 o;
      o.x = cvt_pk_bf16(v[i].x, v[i].y);
      o.y = cvt_pk_bf16(v[i].z, v[i].w);
      *(uint2*)(dst + (size_t)row * DM + (lane + 64 * i) * 4) = o;
    }
  }
}
__device__ void reduce_rs(const float* __restrict__ ssp, float* __restrict__ rsout) {
  const int tid_ = opaque(threadIdx.x);
  for (int row = blockIdx.x * NTHR + tid_; row < T; row += gridDim.x * NTHR) {
    float ss = 0.f;
#pragma unroll
    for (int i = 0; i < 16; ++i) ss += ssp[(size_t)i * T + row];
    rsout[row] = rsqrtf(ss * (1.f / DM) + 1e-6f);
  }
}

__device__ __forceinline__ void shifted8(const bf16r* pc, const bf16r* pp, const float* mu, bool hasprev, int col, float* o8) {
  float cur[8], prv[8];
  unpack8(*(const uint4*)(pc + col), cur);
  uint4 z = hasprev ? *(const uint4*)(pp + col) : uint4{0u, 0u, 0u, 0u};
  unpack8(z, prv);
#pragma unroll
  for (int j = 0; j < 8; ++j) o8[j] = cur[j] + mu[col + j] * (prv[j] - cur[j]);
}

__device__ void mixer_naive(const Params& p, int l, int br, int h, unsigned char* smem) {
  float* sW = (float*)smem;
  float* sA = sW + 4096;
  float* sB = sA + 4096;
  float* sK = sB + 4096;
  float* sQ = sK + 4096;
  float* sV = sQ + 4096;
  float* sO = sV + 4096;
  float* sX = sO + 4096;
  bf16r* proj = (bf16r*)(wsp(p) + OFF_PROJ);
  const float* gsc = (const float*)(wsp(p) + OFF_GSC);
  const bf16r* halo = (const bf16r*)(wsp(p) + OFF_HALO);
  const float* lb = (const float*)(wsp(p) + OFF_LB) + l * 512;
  const int tid = opaque(threadIdx.x), lane = tid & 63, wid = tid >> 6;
  const int tt = tid >> 3, js = tid & 7, j0 = js * 8;
  const int rv = wid * 8 + (lane >> 3);
  const int kq = (lane & 7) * 8;
  float s[8];
#pragma unroll
  for (int i = 0; i < 8; ++i) s[i] = 0.f;

#pragma unroll 1
  for (int c = 0; c < T / 64; ++c) {
    const int t = c * 64 + tt;
    __syncthreads();
    if (br == 0) {
      float cq[8], ck[8], cv[8];
#pragma unroll
      for (int j = 0; j < 8; ++j) { cq[j] = 0.f; ck[j] = 0.f; cv[j] = 0.f; }
      const float* cw = p.conv_w + (size_t)l * 4 * 1536;
#pragma unroll
      for (int i = 0; i < 4; ++i) {
        int ts = t - 3 + i;
        if (ts >= 0) {
          float fq_[8], fk_[8], fv_[8];
          const bf16r* pr = proj + (size_t)ts * PD + h * 64 + j0;
          unpack8(*(const uint4*)(pr), fq_);
          unpack8(*(const uint4*)(pr + 512), fk_);
          unpack8(*(const uint4*)(pr + 1024), fv_);
#pragma unroll
          for (int j = 0; j < 8; ++j) {
            cq[j] += cw[i * 1536 + h * 64 + j0 + j] * fq_[j];
            ck[j] += cw[i * 1536 + 512 + h * 64 + j0 + j] * fk_[j];
            cv[j] += cw[i * 1536 + 1024 + h * 64 + j0 + j] * fv_[j];
          }
        }
      }
      float sq = 0.f, sk = 0.f;
#pragma unroll
      for (int j = 0; j < 8; ++j) {
        cq[j] = siluf_(cq[j]); ck[j] = siluf_(ck[j]); cv[j] = siluf_(cv[j]);
        sq += cq[j] * cq[j]; sk += ck[j] * ck[j];
      }
      sq = red8(sq); sk = red8(sk);
      float nq = rsqrtf(sq + 1e-6f) * 0.125f, nk = rsqrtf(sk + 1e-6f);
      float beta = sigmoidf_(gsc[t * 16 + h]);
      float g = -__expf(p.a_log[l * 8 + h]) * softplusf_(gsc[t * 16 + 8 + h] + p.dt_bias[l * 8 + h]);
      float eg = __expf(g);
#pragma unroll
      for (int j = 0; j < 8; ++j) {
        float kn = ck[j] * nk;
        int o = tt * 64 + j0 + j;
        sQ[o] = cq[j] * nq; sA[o] = kn; sK[o] = beta * kn; sB[o] = -eg * beta * kn; sW[o] = eg; sV[o] = cv[j];
      }
    } else if (br == 1) {
      const float* mu = p.mu + (size_t)l * 2176;
      const bf16r* pc = proj + (size_t)t * PD + RWKV_B;
      const bf16r* pp = (tt == 0) ? (halo + (size_t)(c - 1) * 2176) : (pc - PD);
      const bool hasprev = (t > 0);
      {
        float wd[8], ad[8];
        shifted8(pc, pp, mu, hasprev, 1536 + j0, wd);
        shifted8(pc, pp, mu, hasprev, 1600 + j0, ad);
#pragma unroll
        for (int j = 0; j < 8; ++j) { sO[tt * 64 + j0 + j] = tanhf(wd[j]); sX[tt * 64 + j0 + j] = ad[j]; }
      }
      __syncthreads();
      float aw[8], aa[8];
      const int ch0 = h * 64 + j0;
#pragma unroll
      for (int j = 0; j < 8; ++j) { aw[j] = p.w0[l * 512 + ch0 + j]; aa[j] = p.a0[l * 512 + ch0 + j]; }
      const float* wu = p.w_up + (size_t)l * 64 * 512 + ch0;
      const float* au = p.a_up + (size_t)l * 64 * 512 + ch0;
#pragma unroll 2
      for (int i = 0; i < 64; ++i) {
        float xw = sO[tt * 64 + i], xa = sX[tt * 64 + i];
        float4 w1 = *(const float4*)(wu + i * 512), w2 = *(const float4*)(wu + i * 512 + 4);
        float4 a1 = *(const float4*)(au + i * 512), a2 = *(const float4*)(au + i * 512 + 4);
        aw[0] += xw * w1.x; aw[1] += xw * w1.y; aw[2] += xw * w1.z; aw[3] += xw * w1.w;
        aw[4] += xw * w2.x; aw[5] += xw * w2.y; aw[6] += xw * w2.z; aw[7] += xw * w2.w;
        aa[0] += xa * a1.x; aa[1] += xa * a1.y; aa[2] += xa * a1.z; aa[3] += xa * a1.w;
        aa[4] += xa * a2.x; aa[5] += xa * a2.y; aa[6] += xa * a2.z; aa[7] += xa * a2.w;
      }
      float r8[8], k8[8], v8[8];
      shifted8(pc, pp, mu, hasprev, ch0, r8); shifted8(pc, pp, mu, hasprev, 512 + ch0, k8); shifted8(pc, pp, mu, hasprev, 1024 + ch0, v8);
      float kk[8], ssk = 0.f;
#pragma unroll
      for (int j = 0; j < 8; ++j) { kk[j] = k8[j] * p.k_k[l * 512 + ch0 + j]; ssk += kk[j] * kk[j]; }
      ssk = red8(ssk);
      float nk = rsqrtf(ssk + 1e-6f);
      __syncthreads();
#pragma unroll
      for (int j = 0; j < 8; ++j) {
        float w_raw = -softplusf_(-aw[j]) - 0.5f;
        float dec = __expf(-__expf(w_raw));
        float ic = sigmoidf_(aa[j]);
        float kn = kk[j] * nk;
        int o = tt * 64 + j0 + j;
        sW[o] = dec; sA[o] = -kn; sB[o] = kn * ic;
        sK[o] = k8[j] * (1.f + (ic - 1.f) * p.k_a[l * 512 + ch0 + j]);
        sV[o] = v8[j]; sQ[o] = r8[j];
      }
    } else {
      const bf16r* pc = proj + (size_t)t * PD + HGRN_B + h * 64 + j0;
      float q8[8], f8[8], i8[8];
      unpack8(*(const uint4*)(pc), q8);
      unpack8(*(const uint4*)(pc + 512), f8);
      unpack8(*(const uint4*)(pc + 1024), i8);
#pragma unroll
      for (int j = 0; j < 8; ++j) {
        float lbv = lb[h * 64 + j0 + j];
        float sg = sigmoidf_(f8[j]);
        int o = tt * 64 + j0 + j;
        sW[o] = lbv + (1.f - lbv) * sg;
        sA[o] = 0.f; sB[o] = 0.f;
        sK[o] = (1.f - lbv) * (1.f - sg);
        sQ[o] = siluf_(q8[j]); sV[o] = i8[j];
      }
    }
    __syncthreads();
#pragma unroll 2
    for (int st = 0; st < 64; ++st) {
      const float4* w4 = (const float4*)(sW + st * 64 + kq);
      const float4* a4 = (const float4*)(sA + st * 64 + kq);
      const float4* b4 = (const float4*)(sB + st * 64 + kq);
      const float4* k4 = (const float4*)(sK + st * 64 + kq);
      const float4* q4 = (const float4*)(sQ + st * 64 + kq);
      float4 wa = w4[0], wb = w4[1], aa_ = a4[0], ab = a4[1], ba = b4[0], bb = b4[1];
      float4 ka = k4[0], kb = k4[1], qa = q4[0], qb = q4[1];
      float vv = sV[st * 64 + rv];
      float d = s[0] * aa_.x + s[1] * aa_.y + s[2] * aa_.z + s[3] * aa_.w + s[4] * ab.x + s[5] * ab.y + s[6] * ab.z + s[7] * ab.w;
      d = red8(d);
      s[0] = s[0] * wa.x + d * ba.x + vv * ka.x;
      s[1] = s[1] * wa.y + d * ba.y + vv * ka.y;
      s[2] = s[2] * wa.z + d * ba.z + vv * ka.z;
      s[3] = s[3] * wa.w + d * ba.w + vv * ka.w;
      s[4] = s[4] * wb.x + d * bb.x + vv * kb.x;
      s[5] = s[5] * wb.y + d * bb.y + vv * kb.y;
      s[6] = s[6] * wb.z + d * bb.z + vv * kb.z;
      s[7] = s[7] * wb.w + d * bb.w + vv * kb.w;
      float od = s[0] * qa.x + s[1] * qa.y + s[2] * qa.z + s[3] * qa.w + s[4] * qb.x + s[5] * qb.y + s[6] * qb.z + s[7] * qb.w;
      od = red8(od);
      if ((lane & 7) == 0) sO[st * 64 + rv] = od;
    }
    __syncthreads();
    float o8[8];
#pragma unroll
    for (int j = 0; j < 8; ++j) o8[j] = sO[tt * 64 + j0 + j];
    if (br == 0) {
      float ss = 0.f;
#pragma unroll
      for (int j = 0; j < 8; ++j) ss += o8[j] * o8[j];
      ss = red8(ss);
      float rs = rsqrtf(ss * (1.f / 64.f) + 1e-6f);
      bf16r* gp = proj + (size_t)t * PD + GDN_GATE + h * 64 + j0;
      float g8[8], y8[8];
      unpack8(*(const uint4*)gp, g8);
#pragma unroll
      for (int j = 0; j < 8; ++j) y8[j] = o8[j] * rs * p.gdn_norm_w[l * 64 + j0 + j] * siluf_(g8[j]);
      *(uint4*)gp = pack8(y8);
    } else if (br == 1) {
      float sm = 0.f;
#pragma unroll
      for (int j = 0; j < 8; ++j) sm += o8[j];
      sm = red8(sm);
      float mean = sm * (1.f / 64.f);
      float sv = 0.f;
#pragma unroll
      for (int j = 0; j < 8; ++j) { float d = o8[j] - mean; sv += d * d; }
      sv = red8(sv);
      float rs = rsqrtf(sv * (1.f / 64.f) + 64e-5f);
      float bs = 0.f;
      const int ch0 = h * 64 + j0;
#pragma unroll
      for (int j = 0; j < 8; ++j) bs += sQ[tt * 64 + j0 + j] * sK[tt * 64 + j0 + j] * p.r_k[l * 512 + ch0 + j];
      bs = red8(bs);
      const float* mu = p.mu + (size_t)l * 2176;
      bf16r* gp = proj + (size_t)t * PD + RWKV_B + 1664 + ch0;
      const bf16r* gpp = (tt == 0) ? (halo + (size_t)(c - 1) * 2176 + 1664 + ch0) : (gp - PD);
      float cur[8], prv[8], y8[8];
      unpack8(*(const uint4*)gp, cur);
      if (t > 0) unpack8(*(const uint4*)gpp, prv);
      else {
#pragma unroll
        for (int j = 0; j < 8; ++j) prv[j] = 0.f;
      }
#pragma unroll
      for (int j = 0; j < 8; ++j) {
        float gt = cur[j] + mu[1664 + ch0 + j] * (prv[j] - cur[j]);
        float on = (o8[j] - mean) * rs * p.ln_w[l * 512 + ch0 + j] + p.ln_b[l * 512 + ch0 + j];
        on += bs * sV[tt * 64 + j0 + j];
        y8[j] = on * siluf_(gt);
      }
      __syncthreads();
      *(uint4*)gp = pack8(y8);
    } else {
      bf16r* op = proj + (size_t)t * PD + HGRN_B + h * 64 + j0;
      *(uint4*)op = pack8(o8);
    }
  }
}

__device__ void hgrn_norm_phase(const Params& p, int l) {
  bf16r* proj = (bf16r*)(wsp(p) + OFF_PROJ);
  const int tid_ = opaque(threadIdx.x);
  const int lane = tid_ & 63;
  const int gw = blockIdx.x * (NTHR / 64) + (tid_ >> 6);
  const int nw = gridDim.x * (NTHR / 64);
  for (int t = gw; t < T; t += nw) {
    float o8[8], g8[8], y8[8];
    unpack8(*(const uint4*)(proj + (size_t)t * PD + HGRN_B + lane * 8), o8);
    bf16r* gp = proj + (size_t)t * PD + HGRN_B + 1536 + lane * 8;
    unpack8(*(const uint4*)gp, g8);
    float ss = 0.f;
#pragma unroll
    for (int j = 0; j < 8; ++j) ss += o8[j] * o8[j];
    ss = red64(ss);
    float rs = rsqrtf(ss * (1.f / 512.f) + 1e-6f);
#pragma unroll
    for (int j = 0; j < 8; ++j) y8[j] = o8[j] * rs * p.hgrn_norm_w[l * 512 + lane * 8 + j] * siluf_(g8[j]);
    *(uint4*)gp = pack8(y8);
  }
}


__device__ __forceinline__ void mm64(const bf16r* A, const bf16r* Bt, int lane, int wid, f32x4& c0, f32x4& c1) {
  const int fr = lane & 15, fq = lane >> 4, rt = wid >> 1, ct = (wid & 1) * 2;
#pragma unroll
  for (int s2 = 0; s2 < 2; ++s2) {
    bf16x8 a = *(const bf16x8*)(A + (rt * 16 + fr) * LS + s2 * 32 + fq * 8);
    bf16x8 b0 = *(const bf16x8*)(Bt + (ct * 16 + fr) * LS + s2 * 32 + fq * 8);
    bf16x8 b1 = *(const bf16x8*)(Bt + ((ct + 1) * 16 + fr) * LS + s2 * 32 + fq * 8);
    c0 = __builtin_amdgcn_mfma_f32_16x16x32_bf16(a, b0, c0, 0, 0, 0);
    c1 = __builtin_amdgcn_mfma_f32_16x16x32_bf16(a, b1, c1, 0, 0, 0);
  }
}

typedef short s16x4 __attribute__((ext_vector_type(4)));
__device__ __forceinline__ bf16x8 frag_tr(const bf16r* img, int ntile, int s2, int lane) {
  const int g = lane >> 4, q = (lane & 15) >> 2, pp = lane & 3;
  const bf16r* a0 = img + (32 * s2 + 8 * g + q) * LS + 16 * ntile + 4 * pp;
  s16x4 lo = __builtin_amdgcn_ds_read_tr16_b64_v4i16((__attribute__((address_space(3))) s16x4*)a0);
  s16x4 hi = __builtin_amdgcn_ds_read_tr16_b64_v4i16((__attribute__((address_space(3))) s16x4*)(a0 + 4 * LS));
  return bf16x8{lo[0], lo[1], lo[2], lo[3], hi[0], hi[1], hi[2], hi[3]};
}
template <bool ATR, bool BTR>
__device__ __forceinline__ void mm64t(const bf16r* A, const bf16r* B, int lane, int wid, f32x4& c0, f32x4& c1) {
  const int fr = lane & 15, fq = lane >> 4, rt = wid >> 1, ct = (wid & 1) * 2;
#pragma unroll
  for (int s2 = 0; s2 < 2; ++s2) {
    bf16x8 a, b0, b1;
    if (ATR) a = frag_tr(A, rt, s2, lane);
    else a = *(const bf16x8*)(A + (rt * 16 + fr) * LS + s2 * 32 + fq * 8);
    if (BTR) { b0 = frag_tr(B, ct, s2, lane); b1 = frag_tr(B, ct + 1, s2, lane); }
    else {
      b0 = *(const bf16x8*)(B + (ct * 16 + fr) * LS + s2 * 32 + fq * 8);
      b1 = *(const bf16x8*)(B + ((ct + 1) * 16 + fr) * LS + s2 * 32 + fq * 8);
    }
    c0 = __builtin_amdgcn_mfma_f32_16x16x32_bf16(a, b0, c0, 0, 0, 0);
    c1 = __builtin_amdgcn_mfma_f32_16x16x32_bf16(a, b1, c1, 0, 0, 0);
  }
}

__device__ __forceinline__ void cumsum_tokens(float* v, float* tot, float* sTot, int lane, int wid, int j0) {
#pragma unroll
  for (int d = 8; d < 64; d <<= 1) {
#pragma unroll
    for (int j = 0; j < 8; ++j) {
      float x = __shfl_up(v[j], d);
      if (lane >= d) v[j] += x;
    }
  }
  if ((lane >> 3) == 7) {
#pragma unroll
    for (int j = 0; j < 8; ++j) sTot[wid * 64 + j0 + j] = v[j];
  }
  __syncthreads();
#pragma unroll
  for (int j = 0; j < 8; ++j) tot[j] = 0.f;
#pragma unroll
  for (int w = 0; w < 8; ++w) {
#pragma unroll
    for (int j = 0; j < 8; ++j) {
      float x = sTot[w * 64 + j0 + j];
      if (w < wid) v[j] += x;
      tot[j] += x;
    }
  }
}

__device__ __forceinline__ void store_nacc(bf16r* nb, int lane, int wid, const f32x4& c0, const f32x4& c1) {
  const int rt = wid >> 1, ct = (wid & 1) * 2;
  *(uint2*)(nb + ((ct * 64 + lane) * 4 + rt) * 4) = uint2{cvt_pk_bf16(c0[0], c0[1]), cvt_pk_bf16(c0[2], c0[3])};
  *(uint2*)(nb + (((ct + 1) * 64 + lane) * 4 + rt) * 4) = uint2{cvt_pk_bf16(c1[0], c1[1]), cvt_pk_bf16(c1[2], c1[3])};
}

__device__ __forceinline__ void touch_prep(const Params& p, int c, int hh, int tid, unsigned& ta, unsigned& tb) {
  const bf16r* proj = (const bf16r*)(wsp(p) + OFF_PROJ) + (size_t)c * 64 * PD;
  const int br = hh >> 3, h = hh & 7;
  const int nper = (br == 1) ? 6 : 3;
  if (tid < 64 * nper) {
    const int row = (br == 1) ? tid / 6 : tid / 3, si = tid - row * nper;
    int col;
    if (br == 0) col = si * 512 + h * 64;
    else if (br == 2) col = HGRN_B + si * 512 + h * 64;
    else col = RWKV_B + (si < 3 ? si * 512 + h * 64 : (si == 3 ? 1664 + h * 64 : (si == 4 ? 1536 : 1600)));
    const unsigned* a = (const unsigned*)(proj + (size_t)row * PD + col);
    ta = a[0];
    tb = a[31];
  }
}

__device__ __forceinline__ void hgrn_load(const Params& p, int l, int t, int h, int j0, float* q, float* lg, float* k, float* v) {
  const bf16r* proj = (const bf16r*)(wsp(p) + OFF_PROJ);
  const float* lb = (const float*)(wsp(p) + OFF_LB) + l * 512;
  const bf16r* pc = proj + (size_t)t * PD + HGRN_B + h * 64 + j0;
  float q8[8], f8[8];
  unpack8(*(const uint4*)(pc), q8);
  unpack8(*(const uint4*)(pc + 512), f8);
  unpack8(*(const uint4*)(pc + 1024), v);
#pragma unroll
  for (int j = 0; j < 8; ++j) {
    float lbv = lb[h * 64 + j0 + j];
    float f = f8[j];
    float sg = sigmoidf_(f);
    float g = lbv + (1.f - lbv) * sg;
    lg[j] = __logf(fmaxf(g, 1e-37f));
    k[j] = (1.f - lbv) * (1.f - sg);
    q[j] = siluf_(q8[j]);
  }
}

__device__ void hgrn_prep(const Params& p, int l, int c, int cl, int h, unsigned char* smem, int nc, int nhh) {
  unsigned ta = 0u, tb = 0u;
  bf16r* sKT = (bf16r*)smem;
  bf16r* sVT = sKT + 64 * LS;
  bf16r* sQt = sVT + 64 * LS;
  bf16r* sKt = sQt + 64 * LS;
  bf16r* sAtt = sKt + 4 * 64 * LS;
  float* sTot = (float*)(sAtt + 64 * LS);
  bf16r* sO0 = sQt;
  const int tid = opaque(threadIdx.x), lane = tid & 63, wid = tid >> 6;
  const int tt = tid >> 3, j0 = (tid & 7) * 8;
  const int fr = lane & 15, fq = lane >> 4, rt = wid >> 1, ct = (wid & 1) * 2;
  const int t = c * 64 + tt;
  float q[8], b[8], k[8], v[8], tot[8];
  hgrn_load(p, l, t, h, j0, q, b, k, v);
  __syncthreads();
  cumsum_tokens(b, tot, sTot, lane, wid, j0);
  float P[4][8];
#pragma unroll
  for (int j = 0; j < 8; ++j) {
    float a0 = sTot[0 * 64 + j0 + j] + sTot[1 * 64 + j0 + j];
    float a1 = sTot[2 * 64 + j0 + j] + sTot[3 * 64 + j0 + j];
    float a2 = sTot[4 * 64 + j0 + j] + sTot[5 * 64 + j0 + j];
    P[0][j] = 0.f; P[1][j] = a0; P[2][j] = a0 + a1; P[3][j] = a0 + a1 + a2;
  }
  const int I = tt >> 4;
  bf16r* pr = (bf16r*)(wsp(p) + OFF_PROJ) + (size_t)t * PD + HGRN_B + h * 64 + j0;
  {
    float qd[8], qt[8], kh[8];
#pragma unroll
    for (int j = 0; j < 8; ++j) {
      float pi = (I == 0) ? P[0][j] : (I == 1 ? P[1][j] : (I == 2 ? P[2][j] : P[3][j]));
      qd[j] = q[j] * __expf(b[j]);
      qt[j] = q[j] * __expf(b[j] - pi);
      kh[j] = k[j] * __expf(tot[j] - b[j]);
    }
    *(uint4*)(sKT + tt * LS + j0) = pack8(kh);
    *(uint4*)(sVT + tt * LS + j0) = pack8(v);
    *(uint4*)(pr) = pack8(qd);
    *(uint4*)(sQt + tt * LS + j0) = pack8(qt);
#pragma unroll
    for (int ii = 0; ii < 4; ++ii) {
      if (ii >= I) {
        float kt[8];
#pragma unroll
        for (int j = 0; j < 8; ++j) kt[j] = k[j] * __expf(fminf(P[ii][j] - b[j], 80.f));
        *(uint4*)(sKt + ii * 64 * LS + tt * LS + j0) = pack8(kt);
      }
    }
    if (tt == 63) {
      float* gam = (float*)(wsp(p) + OFF_GAM) + ((size_t)h * CH + cl) * 64;
#pragma unroll
      for (int j = 0; j < 8; ++j) gam[j0 + j] = __expf(tot[j]);
    }
  }
  __syncthreads();
  {
    f32x4 a0 = {0.f, 0.f, 0.f, 0.f}, a1 = {0.f, 0.f, 0.f, 0.f};
    if (ct <= rt) mm64(sQt, sKt + rt * 64 * LS, lane, wid, a0, a1);
#pragma unroll
    for (int j = 0; j < 4; ++j) {
      int row = rt * 16 + fq * 4 + j;
      int col0 = ct * 16 + fr, col1 = col0 + 16;
      float x0 = (col0 <= row && ct <= rt) ? a0[j] : 0.f;
      float x1 = (col1 <= row && ct + 1 <= rt) ? a1[j] : 0.f;
      sAtt[row * LS + col0] = f2bf(x0);
      sAtt[row * LS + col1] = f2bf(x1);
    }
    f32x4 n0 = {0.f, 0.f, 0.f, 0.f}, n1 = {0.f, 0.f, 0.f, 0.f};
    mm64t<true, true>(sKT, sVT, lane, wid, n0, n1);
    bf16r* nb = (bf16r*)(wsp(p) + OFF_NBUF) + ((size_t)(16 + h) * CH + cl) * 4096;
    store_nacc(nb, lane, wid, n0, n1);
  }
  __syncthreads();
  if (nhh >= 0) touch_prep(p, nc, nhh, tid, ta, tb);
  {
    f32x4 o0 = {0.f, 0.f, 0.f, 0.f}, o1 = {0.f, 0.f, 0.f, 0.f};
    mm64t<false, true>(sAtt, sVT, lane, wid, o0, o1);
#pragma unroll
    for (int j = 0; j < 4; ++j) {
      int row = rt * 16 + fq * 4 + j;
      sO0[row * LS + ct * 16 + fr] = f2bf(o0[j]);
      sO0[row * LS + (ct + 1) * 16 + fr] = f2bf(o1[j]);
    }
  }
  __syncthreads();
  *(uint4*)(pr + 1024) = *(const uint4*)(sO0 + tt * LS + j0);
  asm volatile("" ::"v"(ta), "v"(tb));
}

__device__ void hgrn_output(const Params& p, int l, int c, int cl, int h, unsigned char* smem) {
  bf16r* sP = (bf16r*)smem;
  bf16r* sHT = sP + 64 * LS;
  float* sO = (float*)(sHT + 64 * LS);
  const int tid = opaque(threadIdx.x), lane = tid & 63, wid = tid >> 6;
  const int tt = tid >> 3, j0 = (tid & 7) * 8;
  const int fr = lane & 15, fq = lane >> 4, rt = wid >> 1, ct = (wid & 1) * 2;
  const int t = c * 64 + tt;
  bf16r* pr = (bf16r*)(wsp(p) + OFF_PROJ) + (size_t)t * PD + HGRN_B + h * 64 + j0;
  const uint4 p_raw = *(const uint4*)(pr);
  const uint4 o0_raw = *(const uint4*)(pr + 1024);
  const uint4 ht_raw = *(const uint4*)((const bf16r*)(wsp(p) + OFF_HTBUF) + ((size_t)(16 + h) * CH + cl) * 4096 + tt * 64 + j0);
  __syncthreads();
  *(uint4*)(sP + tt * LS + j0) = p_raw;
  *(uint4*)(sHT + tt * LS + j0) = ht_raw;
  __syncthreads();
  {
    f32x4 c0 = {0.f, 0.f, 0.f, 0.f}, c1 = {0.f, 0.f, 0.f, 0.f};
    mm64(sP, sHT, lane, wid, c0, c1);
#pragma unroll
    for (int j = 0; j < 4; ++j) {
      int row = rt * 16 + fq * 4 + j;
      sO[row * FS + ct * 16 + fr] = c0[j];
      sO[row * FS + (ct + 1) * 16 + fr] = c1[j];
    }
  }
  __syncthreads();
  {
    float o8[8], a8[8];
    unpack8(o0_raw, a8);
#pragma unroll
    for (int j = 0; j < 8; ++j) o8[j] = sO[tt * FS + j0 + j] + a8[j];
    *(uint4*)(pr) = pack8(o8);
  }
}

template <int CTRL> __device__ __forceinline__ float quad_bcast(float v) {
  return __int_as_float(__builtin_amdgcn_update_dpp(__float_as_int(v), __float_as_int(v), CTRL, 0xf, 0xf, false));
}
constexpr int SAS = 68;
template <int J0, int PF>
__device__ __forceinline__ void tri_solve_part(const float* abase, f32x2_t (&x2)[8], f32x4 (&ab)[PF + 1][4]) {
#pragma unroll
  for (int jj = 0; jj < 16; ++jj) {
    const int j = J0 + jj;
    if (j + PF < 64) {
#pragma unroll
      for (int m4 = ((j + PF) >> 4); m4 < 4; ++m4) ab[(j + PF) % (PF + 1)][m4] = *(const f32x4*)(abase + (j + PF) * SAS + m4 * 4);
    }
    __builtin_amdgcn_sched_barrier(0);
    float xj;
    const float xs = (((j >> 2) & 1) == 0) ? x2[j >> 3][0] : x2[j >> 3][1];
    if ((j & 3) == 0) xj = quad_bcast<0x00>(xs);
    else if ((j & 3) == 1) xj = quad_bcast<0x55>(xs);
    else if ((j & 3) == 2) xj = quad_bcast<0xAA>(xs);
    else xj = quad_bcast<0xFF>(xs);
    const f32x2_t xj2 = {xj, xj};
#pragma unroll
    for (int m4 = (j >> 4); m4 < 4; ++m4) {
      const f32x4 a = ab[j % (PF + 1)][m4];
      if (m4 * 4 + 1 >= (j >> 2)) x2[m4 * 2 + 0] = x2[m4 * 2 + 0] - f32x2_t{a[0], a[1]} * xj2;
      if (m4 * 4 + 3 >= (j >> 2)) x2[m4 * 2 + 1] = x2[m4 * 2 + 1] - f32x2_t{a[2], a[3]} * xj2;
    }
  }
}
__device__ __forceinline__ void tri_solve(const float* sAT, int r, float* x) {
  constexpr int PF = 3;
  f32x2_t x2[8];
#pragma unroll
  for (int k = 0; k < 8; ++k) x2[k] = f32x2_t{x[2 * k], x[2 * k + 1]};
  f32x4 ab[PF + 1][4];
  const float* abase = sAT + r * 16;
#pragma unroll
  for (int j = 0; j < PF; ++j) {
#pragma unroll
    for (int m4 = (j >> 4); m4 < 4; ++m4) ab[j % (PF + 1)][m4] = *(const f32x4*)(abase + j * SAS + m4 * 4);
  }
  __builtin_amdgcn_sched_barrier(0);
  tri_solve_part<0, PF>(abase, x2, ab);
  tri_solve_part<16, PF>(abase, x2, ab);
  tri_solve_part<32, PF>(abase, x2, ab);
  tri_solve_part<48, PF>(abase, x2, ab);
#pragma unroll
  for (int k = 0; k < 8; ++k) { x[2 * k] = x2[k][0]; x[2 * k + 1] = x2[k][1]; }
}

__device__ __forceinline__ void gdn_load(const Params& p, int l, int t, int h, int j0, float* cq, float* ck, float* cv,
                                         float& beta, float& g) {
  const bf16r* proj = (const bf16r*)(wsp(p) + OFF_PROJ);
  const float* gsc = (const float*)(wsp(p) + OFF_GSC);
#pragma unroll
  for (int j = 0; j < 8; ++j) { cq[j] = 0.f; ck[j] = 0.f; cv[j] = 0.f; }
  const float* cw = p.conv_w + (size_t)l * 4 * 1536 + h * 64 + j0;
#pragma unroll
  for (int i = 0; i < 4; ++i) {
    int ts = t - 3 + i;
    if (ts >= 0) {
      float fq_[8], fk_[8], fv_[8];
      const int cs = t & ~63;
      const bf16r* pr = (ts >= cs) ? (proj + (size_t)ts * PD + h * 64 + j0)
                                   : ((const bf16r*)(wsp(p) + OFF_HALO2) + ((size_t)((cs >> 6) - 1) * 3 + (ts - cs + 3)) * 1536 + h * 64 + j0);
      unpack8(*(const uint4*)(pr), fq_);
      unpack8(*(const uint4*)(pr + 512), fk_);
      unpack8(*(const uint4*)(pr + 1024), fv_);
#pragma unroll
      for (int j = 0; j < 8; ++j) {
        cq[j] += cw[i * 1536 + j] * fq_[j];
        ck[j] += cw[i * 1536 + 512 + j] * fk_[j];
        cv[j] += cw[i * 1536 + 1024 + j] * fv_[j];
      }
    }
  }
  float sq = 0.f, sk = 0.f;
#pragma unroll
  for (int j = 0; j < 8; ++j) {
    cq[j] = siluf_(cq[j]); ck[j] = siluf_(ck[j]); cv[j] = siluf_(cv[j]);
    sq += cq[j] * cq[j]; sk += ck[j] * ck[j];
  }
  sq = red8(sq); sk = red8(sk);
  float nq = rsqrtf(sq + 1e-6f) * 0.125f, nk = rsqrtf(sk + 1e-6f);
#pragma unroll
  for (int j = 0; j < 8; ++j) { cq[j] *= nq; ck[j] *= nk; }
  beta = sigmoidf_(gsc[t * 16 + h]);
  g = -__expf(p.a_log[l * 8 + h]) * softplusf_(gsc[t * 16 + 8 + h] + p.dt_bias[l * 8 + h]);
}

__device__ __forceinline__ void cumsum_scalar(float g, float* sG, int tt, int js, float& gc, float& gtot) {
  if (js == 0) sG[tt] = g;
  __syncthreads();
  if (threadIdx.x < 64) {
    float v = sG[threadIdx.x];
#pragma unroll
    for (int d = 1; d < 64; d <<= 1) {
      float x = __shfl_up(v, d);
      if ((int)threadIdx.x >= d) v += x;
    }
    sG[64 + threadIdx.x] = v;
  }
  __syncthreads();
  gc = sG[64 + tt];
  gtot = sG[64 + 63];
}

__device__ void gdn_prep(const Params& p, int l, int c, int cl, int h, unsigned char* smem, int nc, int nhh) {
  unsigned ta = 0u, tb = 0u;
  bf16r* sK = (bf16r*)smem;
  bf16r* sKdT = sK + 64 * LS;
  bf16r* sXT = sKdT + 64 * LS;
  bf16r* sQ = sXT + 128 * LS;
  bf16r* sAtt = sQ + 64 * LS;
  float* sAT = (float*)(sAtt + 64 * LS);
  float* sR = sAT + 64 * SAS;
  float* sQdF = sR + 64 * 136;
  float* sG = sQdF + 64 * FS;
  float* sGc = sG + 64;
  float* sBeta = sGc + 64;
  bf16r* sM = sQ;
  bf16r* sP = (bf16r*)sR;
  bf16r* sO0 = sP + 64 * LS;
  const int tid = opaque(threadIdx.x), lane = tid & 63, wid = tid >> 6;
  const int tt = tid >> 3, js = tid & 7, j0 = js * 8;
  const int fr = lane & 15, fq = lane >> 4, rt = wid >> 1, ct = (wid & 1) * 2;
  const int t = c * 64 + tt;
  float q[8], k[8], v[8], beta, g, gc, gtot;
  gdn_load(p, l, t, h, j0, q, k, v, beta, g);
  __syncthreads();
  cumsum_scalar(g, sG, tt, js, gc, gtot);
  {
    if (js == 0) { sGc[tt] = gc; sBeta[tt] = beta; }
    *(uint4*)(sK + tt * LS + j0) = pack8(k);
    *(uint4*)(sQ + tt * LS + j0) = pack8(q);
    const float egc = __expf(gc), ekd = __expf(gtot - gc);
    float kd[8];
#pragma unroll
    for (int j = 0; j < 8; ++j) {
      kd[j] = k[j] * ekd;
      sR[tt * 136 + j0 + j] = beta * v[j];
      sR[tt * 136 + 64 + j0 + j] = beta * k[j] * egc;
      sQdF[tt * FS + j0 + j] = q[j] * egc;
    }
    *(uint4*)(sKdT + tt * LS + j0) = pack8(kd);
  }
  __syncthreads();
  {
    f32x4 a0 = {0.f, 0.f, 0.f, 0.f}, a1 = {0.f, 0.f, 0.f, 0.f};
    f32x4 b0 = {0.f, 0.f, 0.f, 0.f}, b1 = {0.f, 0.f, 0.f, 0.f};
    mm64(sK, sK, lane, wid, a0, a1);
    mm64(sQ, sK, lane, wid, b0, b1);
#pragma unroll
    for (int j = 0; j < 4; ++j) {
      int row = rt * 16 + fq * 4 + j;
      float br_ = sBeta[row], gr = sGc[row];
      int c0i = ct * 16 + fr, c1i = c0i + 16;
      float e0 = __expf(fminf(gr - sGc[c0i], 0.f)), e1 = __expf(fminf(gr - sGc[c1i], 0.f));
      sAT[c0i * SAS + (row & 3) * 16 + (row >> 2)] = (c0i < row) ? br_ * a0[j] * e0 : 0.f;
      sAT[c1i * SAS + (row & 3) * 16 + (row >> 2)] = (c1i < row) ? br_ * a1[j] * e1 : 0.f;
      sAtt[row * LS + c0i] = f2bf((c0i <= row) ? b0[j] * e0 : 0.f);
      sAtt[row * LS + c1i] = f2bf((c1i <= row) ? b1[j] * e1 : 0.f);
    }
  }
  __syncthreads();
  if (nhh >= 0) touch_prep(p, nc, nhh, tid, ta, tb);
  {
    const int col = tid >> 2, r = tid & 3;
    float x[16];
#pragma unroll
    for (int m = 0; m < 16; ++m) x[m] = sR[(4 * m + r) * 136 + col];
    tri_solve(sAT, r, x);
#pragma unroll
    for (int m = 0; m < 16; ++m) sXT[col * LS + 4 * m + r] = f2bf(x[m]);
  }
  __syncthreads();
  {
    f32x4 n0 = {0.f, 0.f, 0.f, 0.f}, n1 = {0.f, 0.f, 0.f, 0.f}, w0 = {0.f, 0.f, 0.f, 0.f}, w1 = {0.f, 0.f, 0.f, 0.f};
    f32x4 p0 = {0.f, 0.f, 0.f, 0.f}, p1 = {0.f, 0.f, 0.f, 0.f}, o0 = {0.f, 0.f, 0.f, 0.f}, o1 = {0.f, 0.f, 0.f, 0.f};
    mm64t<true, false>(sKdT, sXT, lane, wid, n0, n1);
    mm64t<true, false>(sKdT, sXT + 64 * LS, lane, wid, w0, w1);
    mm64(sAtt, sXT + 64 * LS, lane, wid, p0, p1);
    mm64(sAtt, sXT, lane, wid, o0, o1);
    bf16r* nb = (bf16r*)(wsp(p) + OFF_NBUF) + ((size_t)h * CH + cl) * 4096;
    store_nacc(nb, lane, wid, n0, n1);
    const float eg = __expf(gtot);
#pragma unroll
    for (int j = 0; j < 4; ++j) {
      int row = rt * 16 + fq * 4 + j;
      int c0i = ct * 16 + fr, c1i = c0i + 16;
      sM[row * LS + c0i] = f2bf((row == c0i ? eg : 0.f) - w0[j]);
      sM[row * LS + c1i] = f2bf((row == c1i ? eg : 0.f) - w1[j]);
      sP[row * LS + c0i] = f2bf(sQdF[row * FS + c0i] - p0[j]);
      sP[row * LS + c1i] = f2bf(sQdF[row * FS + c1i] - p1[j]);
      sO0[row * LS + c0i] = f2bf(o0[j]);
      sO0[row * LS + c1i] = f2bf(o1[j]);
    }
  }
  __syncthreads();
  {
    const int fi = tid >> 6, s2 = fi & 1, rtm = fi >> 1;
    const int row = rtm * 16 + fr;
    uint2 lo = *(const uint2*)(sM + row * LS + (2 * s2) * 16 + fq * 4);
    uint2 hi = *(const uint2*)(sM + row * LS + (2 * s2 + 1) * 16 + fq * 4);
    bf16r* mb = (bf16r*)(wsp(p) + OFF_MBUF) + ((size_t)h * CH + cl) * 4096;
    *(uint4*)(mb + (fi * 64 + lane) * 8) = uint4{lo.x, lo.y, hi.x, hi.y};
    bf16r* pr = (bf16r*)(wsp(p) + OFF_PROJ) + (size_t)t * PD + h * 64 + j0;
    *(uint4*)(pr) = *(const uint4*)(sP + tt * LS + j0);
    *(uint4*)(pr + 1024) = *(const uint4*)(sO0 + tt * LS + j0);
  }
  asm volatile("" ::"v"(ta), "v"(tb));
}

__device__ void gdn_output(const Params& p, int l, int c, int cl, int h, unsigned char* smem) {
  bf16r* sP = (bf16r*)smem;
  bf16r* sHT = sP + 64 * LS;
  float* sO = (float*)(sHT + 64 * LS);
  const int tid = opaque(threadIdx.x), lane = tid & 63, wid = tid >> 6;
  const int tt = tid >> 3, js = tid & 7, j0 = js * 8;
  const int fr = lane & 15, fq = lane >> 4, rt = wid >> 1, ct = (wid & 1) * 2;
  const int t = c * 64 + tt;
  bf16r* pr = (bf16r*)(wsp(p) + OFF_PROJ) + (size_t)t * PD + h * 64 + j0;
  const uint4 p_raw = *(const uint4*)(pr);
  const uint4 o0_raw = *(const uint4*)(pr + 1024);
  const uint4 ht_raw = *(const uint4*)((const bf16r*)(wsp(p) + OFF_HTBUF) + ((size_t)h * CH + cl) * 4096 + tt * 64 + j0);
  bf16r* gp = pr + GDN_GATE;
  const uint4 gate_raw = *(const uint4*)gp;
  __syncthreads();
  *(uint4*)(sP + tt * LS + j0) = p_raw;
  *(uint4*)(sHT + tt * LS + j0) = ht_raw;
  __syncthreads();
  {
    f32x4 c0 = {0.f, 0.f, 0.f, 0.f}, c1 = {0.f, 0.f, 0.f, 0.f};
    mm64(sP, sHT, lane, wid, c0, c1);
#pragma unroll
    for (int j = 0; j < 4; ++j) {
      int row = rt * 16 + fq * 4 + j;
      sO[row * FS + ct * 16 + fr] = c0[j];
      sO[row * FS + (ct + 1) * 16 + fr] = c1[j];
    }
  }
  __syncthreads();
  {
    float o8[8], a8[8], g8[8], y8[8], ss = 0.f;
    unpack8(o0_raw, a8);
    unpack8(gate_raw, g8);
#pragma unroll
    for (int j = 0; j < 8; ++j) { o8[j] = sO[tt * FS + j0 + j] + a8[j]; ss += o8[j] * o8[j]; }
    ss = red8(ss);
    float rs = rsqrtf(ss * (1.f / 64.f) + 1e-6f);
#pragma unroll
    for (int j = 0; j < 8; ++j) y8[j] = o8[j] * rs * p.gdn_norm_w[l * 64 + j0 + j] * siluf_(g8[j]);
    *(uint4*)gp = pack8(y8);
  }
}

__device__ __forceinline__ float tanh_fast(float x) { return 1.f - 2.f * __builtin_amdgcn_rcpf(1.f + __expf(2.f * x)); }
__device__ __forceinline__ void rwkv_load(const Params& p, int l, int c, int tt, int h, int j0, unsigned char* smem,
                                          float* r8, float* k8, float* v8, float* kk8, float* ic8, float* lw8) {
  bf16r* tA1 = (bf16r*)smem;
  bf16r* tA2 = tA1 + 64 * LS;
  bf16r* tB1 = tA2 + 64 * LS;
  bf16r* tB2 = tB1 + 64 * LS;
  float* res1 = (float*)(tB2 + 64 * LS);
  float* res2 = res1 + 4096;
  const bf16r* proj = (const bf16r*)(wsp(p) + OFF_PROJ);
  const bf16r* halo = (const bf16r*)(wsp(p) + OFF_HALO);
  const bf16r* lora = (const bf16r*)(wsp(p) + OFF_LORA);
  const int t = c * 64 + tt;
  const int tid = tt * 8 + (j0 >> 3), lane = tid & 63, wid = tid >> 6;
  const float* mu = p.mu + (size_t)l * 2176;
  const bf16r* pc = proj + (size_t)t * PD + RWKV_B;
  const bf16r* pp = (tt == 0) ? (halo + (size_t)(c - 1) * 2176) : (pc - PD);
  const bool hasprev = (t > 0);
  const int ch0 = h * 64 + j0;
  {
    float wd[8], ad[8];
    shifted8(pc, pp, mu, hasprev, 1536 + j0, wd);
    shifted8(pc, pp, mu, hasprev, 1600 + j0, ad);
#pragma unroll
    for (int j = 0; j < 8; ++j) wd[j] = tanh_fast(wd[j]);
    *(uint4*)(tA1 + tt * LS + j0) = pack8(wd);
    *(uint4*)(tA2 + tt * LS + j0) = pack8(ad);
    *(uint4*)(tB1 + tt * LS + j0) = *(const uint4*)(lora + (size_t)(h * 64 + tt) * 64 + j0);
    *(uint4*)(tB2 + tt * LS + j0) = *(const uint4*)(lora + (size_t)(512 + h * 64 + tt) * 64 + j0);
  }
  shifted8(pc, pp, mu, hasprev, ch0, r8);
  shifted8(pc, pp, mu, hasprev, 512 + ch0, k8);
  shifted8(pc, pp, mu, hasprev, 1024 + ch0, v8);
  __syncthreads();
  {
    f32x4 a0 = {0.f, 0.f, 0.f, 0.f}, a1 = {0.f, 0.f, 0.f, 0.f}, b0 = {0.f, 0.f, 0.f, 0.f}, b1 = {0.f, 0.f, 0.f, 0.f};
    mm64(tA1, tB1, lane, wid, a0, a1);
    mm64(tA2, tB2, lane, wid, b0, b1);
    const int fr = lane & 15, fq = lane >> 4, rt = wid >> 1, ct = (wid & 1) * 2;
#pragma unroll
    for (int j = 0; j < 4; ++j) {
      int row = rt * 16 + fq * 4 + j;
      res1[row * 64 + ct * 16 + fr] = a0[j];
      res1[row * 64 + (ct + 1) * 16 + fr] = a1[j];
      res2[row * 64 + ct * 16 + fr] = b0[j];
      res2[row * 64 + (ct + 1) * 16 + fr] = b1[j];
    }
  }
  __syncthreads();
  float aw[8], aa[8];
#pragma unroll
  for (int j = 0; j < 8; ++j) {
    aw[j] = p.w0[l * 512 + ch0 + j] + res1[tt * 64 + j0 + j];
    aa[j] = p.a0[l * 512 + ch0 + j] + res2[tt * 64 + j0 + j];
  }
  float ssk = 0.f;
#pragma unroll
  for (int j = 0; j < 8; ++j) { kk8[j] = k8[j] * p.k_k[l * 512 + ch0 + j]; ssk += kk8[j] * kk8[j]; }
  ssk = red8(ssk);
  const float nk = rsqrtf(ssk + 1e-6f);
#pragma unroll
  for (int j = 0; j < 8; ++j) {
    float w_raw = -softplusf_(-aw[j]) - 0.5f;
    lw8[j] = -__expf(w_raw);
    ic8[j] = sigmoidf_(aa[j]);
    kk8[j] *= nk;
    k8[j] = k8[j] * (1.f + (ic8[j] - 1.f) * p.k_a[l * 512 + ch0 + j]);
  }
}

__device__ void rwkv_prep(const Params& p, int l, int c, int cl, int h, unsigned char* smem, int nc, int nhh) {
  unsigned ta = 0u, tb = 0u;
  bf16r* sAt = (bf16r*)smem;
  bf16r* sRt = sAt + 64 * LS;
  bf16r* sBK = sRt + 64 * LS;
  bf16r* sVT = sBK + 128 * LS;
  bf16r* sBhT = sVT + 64 * LS;
  bf16r* sKhT = sBhT + 64 * LS;
  bf16r* sMak = sKhT + 64 * LS;
  bf16r* sMrb = sMak + 64 * LS;
  bf16r* sMrk = sMrb + 64 * LS;
  float* sAT = (float*)(sMrk + 64 * LS);
  float* sR = sAT + 64 * SAS;
  float* sTot = sR + 64 * FS;
  bf16r* sXT = sBK;
  bf16r* sM = sMak;
  bf16r* sP = (bf16r*)sAT;
  bf16r* sO0 = (bf16r*)sR;
  const int tid = opaque(threadIdx.x), lane = tid & 63, wid = tid >> 6;
  const int tt = tid >> 3, js = tid & 7, j0 = js * 8;
  const int fr = lane & 15, fq = lane >> 4, rt = wid >> 1, ct = (wid & 1) * 2;
  const int t = c * 64 + tt;
  float r8[8], k8[8], v8[8], kk8[8], ic8[8], lc[8], tot[8];
  __syncthreads();
  rwkv_load(p, l, c, tt, h, j0, smem, r8, k8, v8, kk8, ic8, lc);
  float lw[8];
#pragma unroll
  for (int j = 0; j < 8; ++j) lw[j] = lc[j];
  cumsum_tokens(lc, tot, sTot, lane, wid, j0);
  uint4 v_pk;
  {
    float at[8], rt_[8], bt[8], kt[8], bh[8], kh[8], bs = 0.f;
#pragma unroll
    for (int j = 0; j < 8; ++j) {
      float eil = __expf(-lc[j]), ekd = __expf(tot[j] - lc[j]);
      at[j] = -kk8[j] * __expf(lc[j] - lw[j]);
      rt_[j] = r8[j] * __expf(lc[j]);
      float b = kk8[j] * ic8[j];
      bt[j] = b * eil;
      kt[j] = k8[j] * eil;
      bs += r8[j] * k8[j] * p.r_k[l * 512 + h * 64 + j0 + j];
      bh[j] = b * ekd;
      kh[j] = k8[j] * ekd;
    }
    bs = red8(bs);
    if (js == 0) ((float*)(wsp(p) + OFF_BON))[t * 8 + h] = bs;
    v_pk = pack8(v8);
    *(uint4*)(sVT + tt * LS + j0) = v_pk;
    *(uint4*)(sBhT + tt * LS + j0) = pack8(bh);
    *(uint4*)(sKhT + tt * LS + j0) = pack8(kh);
    *(uint4*)(sAt + tt * LS + j0) = pack8(at);
    *(uint4*)(sRt + tt * LS + j0) = pack8(rt_);
    *(uint4*)(sBK + tt * LS + j0) = pack8(bt);
    *(uint4*)(sBK + (64 + tt) * LS + j0) = pack8(kt);
  }
  __syncthreads();
  {
    f32x4 a0 = {0.f, 0.f, 0.f, 0.f}, a1 = {0.f, 0.f, 0.f, 0.f}, b0 = {0.f, 0.f, 0.f, 0.f}, b1 = {0.f, 0.f, 0.f, 0.f};
    f32x4 e0 = {0.f, 0.f, 0.f, 0.f}, e1 = {0.f, 0.f, 0.f, 0.f}, f0 = {0.f, 0.f, 0.f, 0.f}, f1 = {0.f, 0.f, 0.f, 0.f};
    mm64(sAt, sBK, lane, wid, a0, a1);
    mm64(sAt, sBK + 64 * LS, lane, wid, b0, b1);
    mm64(sRt, sBK, lane, wid, e0, e1);
    mm64(sRt, sBK + 64 * LS, lane, wid, f0, f1);
#pragma unroll
    for (int j = 0; j < 4; ++j) {
      int row = rt * 16 + fq * 4 + j;
      int c0i = ct * 16 + fr, c1i = c0i + 16;
      sAT[c0i * SAS + (row & 3) * 16 + (row >> 2)] = (c0i < row) ? -a0[j] : 0.f;
      sAT[c1i * SAS + (row & 3) * 16 + (row >> 2)] = (c1i < row) ? -a1[j] : 0.f;
      sMak[row * LS + c0i] = f2bf((c0i < row) ? b0[j] : 0.f);
      sMak[row * LS + c1i] = f2bf((c1i < row) ? b1[j] : 0.f);
      sMrb[row * LS + c0i] = f2bf((c0i <= row) ? e0[j] : 0.f);
      sMrb[row * LS + c1i] = f2bf((c1i <= row) ? e1[j] : 0.f);
      sMrk[row * LS + c0i] = f2bf((c0i <= row) ? f0[j] : 0.f);
      sMrk[row * LS + c1i] = f2bf((c1i <= row) ? f1[j] : 0.f);
    }
  }
  __syncthreads();
  {
    f32x4 y0 = {0.f, 0.f, 0.f, 0.f}, y1 = {0.f, 0.f, 0.f, 0.f};
    mm64t<false, true>(sMak, sVT, lane, wid, y0, y1);
#pragma unroll
    for (int j = 0; j < 4; ++j) {
      int row = rt * 16 + fq * 4 + j;
      sR[row * FS + ct * 16 + fr] = y0[j];
      sR[row * FS + (ct + 1) * 16 + fr] = y1[j];
    }
  }
  __syncthreads();
  if (nhh >= 0) touch_prep(p, nc, nhh, tid, ta, tb);
  {
    const int col = tid >> 2, r = tid & 3;
    float x[16];
    if (col < 64) {
#pragma unroll
      for (int m = 0; m < 16; ++m) x[m] = sR[(4 * m + r) * FS + col];
    } else {
#pragma unroll
      for (int m = 0; m < 16; ++m) x[m] = bf2f(sAt[(4 * m + r) * LS + (col - 64)]);
    }
    tri_solve(sAT, r, x);
#pragma unroll
    for (int m = 0; m < 16; ++m) sXT[col * LS + 4 * m + r] = f2bf(x[m]);
  }
  __syncthreads();
  {
    f32x4 n0 = {0.f, 0.f, 0.f, 0.f}, n1 = {0.f, 0.f, 0.f, 0.f}, w0 = {0.f, 0.f, 0.f, 0.f}, w1 = {0.f, 0.f, 0.f, 0.f};
    f32x4 p0 = {0.f, 0.f, 0.f, 0.f}, p1 = {0.f, 0.f, 0.f, 0.f}, o0 = {0.f, 0.f, 0.f, 0.f}, o1 = {0.f, 0.f, 0.f, 0.f};
    mm64t<true, false>(sBhT, sXT, lane, wid, n0, n1);
    mm64t<true, true>(sKhT, sVT, lane, wid, n0, n1);
    mm64t<true, false>(sBhT, sXT + 64 * LS, lane, wid, w0, w1);
    mm64(sMrb, sXT + 64 * LS, lane, wid, p0, p1);
    mm64(sMrb, sXT, lane, wid, o0, o1);
    mm64t<false, true>(sMrk, sVT, lane, wid, o0, o1);
    bf16r* nb = (bf16r*)(wsp(p) + OFF_NBUF) + ((size_t)(8 + h) * CH + cl) * 4096;
    store_nacc(nb, lane, wid, n0, n1);
#pragma unroll
    for (int j = 0; j < 4; ++j) {
      int row = rt * 16 + fq * 4 + j;
      int c0i = ct * 16 + fr, c1i = c0i + 16;
      float gt = 0.f;
#pragma unroll
      for (int w = 0; w < 8; ++w) gt += sTot[w * 64 + row];
      float eg = __expf(gt);
      sM[row * LS + c0i] = f2bf((row == c0i ? eg : 0.f) + w0[j]);
      sM[row * LS + c1i] = f2bf((row == c1i ? eg : 0.f) + w1[j]);
      sP[row * LS + c0i] = f2bf(bf2f(sRt[row * LS + c0i]) + p0[j]);
      sP[row * LS + c1i] = f2bf(bf2f(sRt[row * LS + c1i]) + p1[j]);
      sO0[row * LS + c0i] = f2bf(o0[j]);
      sO0[row * LS + c1i] = f2bf(o1[j]);
    }
  }
  __syncthreads();
  {
    const int fi = tid >> 6, s2 = fi & 1, rtm = fi >> 1;
    const int row = rtm * 16 + fr;
    uint2 lo = *(const uint2*)(sM + row * LS + (2 * s2) * 16 + fq * 4);
    uint2 hi = *(const uint2*)(sM + row * LS + (2 * s2 + 1) * 16 + fq * 4);
    bf16r* mb = (bf16r*)(wsp(p) + OFF_MBUF) + ((size_t)(8 + h) * CH + cl) * 4096;
    *(uint4*)(mb + (fi * 64 + lane) * 8) = uint4{lo.x, lo.y, hi.x, hi.y};
    bf16r* pr = (bf16r*)(wsp(p) + OFF_PROJ) + (size_t)t * PD + RWKV_B + h * 64 + j0;
    *(uint4*)(pr) = *(const uint4*)(sP + tt * LS + j0);
    *(uint4*)(pr + 512) = *(const uint4*)(sO0 + tt * LS + j0);
    *(uint4*)(pr + 1024) = v_pk;
  }
  asm volatile("" ::"v"(ta), "v"(tb));
}

__device__ void rwkv_output(const Params& p, int l, int c, int cl, int h, unsigned char* smem) {
  bf16r* sP = (bf16r*)smem;
  bf16r* sHT = sP + 64 * LS;
  float* sO = (float*)(sHT + 64 * LS);
  const int tid = opaque(threadIdx.x), lane = tid & 63, wid = tid >> 6;
  const int tt = tid >> 3, js = tid & 7, j0 = js * 8;
  const int fr = lane & 15, fq = lane >> 4, rt = wid >> 1, ct = (wid & 1) * 2;
  const int t = c * 64 + tt;
  const int ch0 = h * 64 + j0;
  bf16r* pr = (bf16r*)(wsp(p) + OFF_PROJ) + (size_t)t * PD + RWKV_B + ch0;
  const uint4 p_raw = *(const uint4*)(pr);
  const uint4 o0_raw = *(const uint4*)(pr + 512);
  const uint4 v_raw = *(const uint4*)(pr + 1024);
  const uint4 ht_raw = *(const uint4*)((const bf16r*)(wsp(p) + OFF_HTBUF) + ((size_t)(8 + h) * CH + cl) * 4096 + tt * 64 + j0);
  bf16r* gp = pr + 1664;
  const uint4 gate_cur = *(const uint4*)gp;
  uint4 gate_prv = uint4{0u, 0u, 0u, 0u};
  if (t > 0) gate_prv = (tt == 0) ? *(const uint4*)((const bf16r*)(wsp(p) + OFF_HALO) + (size_t)(c - 1) * 2176 + 1664 + ch0) : *(const uint4*)(gp - PD);
  const float bs = ((const float*)(wsp(p) + OFF_BON))[t * 8 + h];
  __syncthreads();
  *(uint4*)(sP + tt * LS + j0) = p_raw;
  *(uint4*)(sHT + tt * LS + j0) = ht_raw;
  __syncthreads();
  {
    f32x4 c0 = {0.f, 0.f, 0.f, 0.f}, c1 = {0.f, 0.f, 0.f, 0.f};
    mm64(sP, sHT, lane, wid, c0, c1);
#pragma unroll
    for (int j = 0; j < 4; ++j) {
      int row = rt * 16 + fq * 4 + j;
      sO[row * FS + ct * 16 + fr] = c0[j];
      sO[row * FS + (ct + 1) * 16 + fr] = c1[j];
    }
  }
  __syncthreads();
  {
    float o8[8], a8[8], v8[8], cur[8], prv[8], y8[8], sm = 0.f;
    unpack8(o0_raw, a8);
    unpack8(v_raw, v8);
    unpack8(gate_cur, cur);
    unpack8(gate_prv, prv);
#pragma unroll
    for (int j = 0; j < 8; ++j) { o8[j] = sO[tt * FS + j0 + j] + a8[j]; sm += o8[j]; }
    sm = red8(sm);
    const float mean = sm * (1.f / 64.f);
    float sv = 0.f;
#pragma unroll
    for (int j = 0; j < 8; ++j) { float d = o8[j] - mean; sv += d * d; }
    sv = red8(sv);
    const float rs = rsqrtf(sv * (1.f / 64.f) + 64e-5f);
    const float* mu = p.mu + (size_t)l * 2176;
#pragma unroll
    for (int j = 0; j < 8; ++j) {
      float gt = cur[j] + mu[1664 + ch0 + j] * (prv[j] - cur[j]);
      float on = (o8[j] - mean) * rs * p.ln_w[l * 512 + ch0 + j] + p.ln_b[l * 512 + ch0 + j];
      on += bs * v8[j];
      y8[j] = on * siluf_(gt);
    }
    *(uint4*)gp = pack8(y8);
  }
}

__device__ void scan_phase(const Params& p, int seg, int head, int ns, int lane_) {
  const int lane = opaque(lane_);
  const int fr = lane & 15, fq = lane >> 4;
  const int br = head >> 3;
  f32x4 acc[4];
  float* hst = (float*)(wsp(p) + OFF_HSTATE) + ((size_t)head * 4 + ns) * 1024;
  if (seg == 0) {
#pragma unroll
    for (int rt = 0; rt < 4; ++rt) acc[rt] = f32x4{0.f, 0.f, 0.f, 0.f};
  } else {
#pragma unroll
    for (int rt = 0; rt < 4; ++rt) acc[rt] = *(const f32x4*)(hst + (rt * 64 + lane) * 4);
  }
  const bf16r* nbase = (const bf16r*)(wsp(p) + OFF_NBUF) + (size_t)head * CH * 4096 + (ns * 64 + lane) * 16;
  bf16r* htbase = (bf16r*)(wsp(p) + OFF_HTBUF) + (size_t)head * CH * 4096 + (ns * 16 + fr) * 64 + fq * 4;
  constexpr int PFD = 4;
  if (br == 2) {
    const float* gbase = (const float*)(wsp(p) + OFF_GAM) + (size_t)(head - 16) * CH * 64 + fq * 4;
    uint2 n[PFD][4];
    f32x4 g[PFD][4];
#pragma unroll
    for (int k = 0; k < PFD; ++k)
#pragma unroll
      for (int rt = 0; rt < 4; ++rt) {
        n[k][rt] = *(const uint2*)(nbase + (size_t)k * 4096 + rt * 4);
        g[k][rt] = *(const f32x4*)(gbase + k * 64 + rt * 16);
      }
#pragma unroll 1
    for (int cl = 0; cl < CH; cl += PFD) {
#pragma unroll
      for (int k = 0; k < PFD; ++k) {
        const int cc = cl + k;
        if (cc >= CH) break;
        uint2 hv[4];
#pragma unroll
        for (int rt = 0; rt < 4; ++rt) {
          hv[rt].x = cvt_pk_bf16(acc[rt][0], acc[rt][1]);
          hv[rt].y = cvt_pk_bf16(acc[rt][2], acc[rt][3]);
          const f32x4 nf = {__uint_as_float(n[k][rt].x << 16), __uint_as_float(n[k][rt].x & 0xffff0000u),
                            __uint_as_float(n[k][rt].y << 16), __uint_as_float(n[k][rt].y & 0xffff0000u)};
          acc[rt] = acc[rt] * g[k][rt] + nf;
        }
#pragma unroll
        for (int rt = 0; rt < 4; ++rt) *(uint2*)(htbase + (size_t)cc * 4096 + rt * 16) = hv[rt];
        const int cn = (cc + PFD < CH) ? cc + PFD : CH - 1;
#pragma unroll
        for (int rt = 0; rt < 4; ++rt) {
          n[k][rt] = *(const uint2*)(nbase + (size_t)cn * 4096 + rt * 4);
          g[k][rt] = *(const f32x4*)(gbase + cn * 64 + rt * 16);
        }
      }
    }
  } else {
    const bf16r* mbase = (const bf16r*)(wsp(p) + OFF_MBUF) + (size_t)head * CH * 4096 + lane * 8;
    uint2 n[PFD][4];
    bf16x8 m[PFD][8];
#pragma unroll
    for (int k = 0; k < PFD; ++k) {
      { const uint4 q0 = *(const uint4*)(nbase + (size_t)k * 4096), q1 = *(const uint4*)(nbase + (size_t)k * 4096 + 8);
        n[k][0] = uint2{q0.x, q0.y}; n[k][1] = uint2{q0.z, q0.w}; n[k][2] = uint2{q1.x, q1.y}; n[k][3] = uint2{q1.z, q1.w}; }
#pragma unroll
      for (int i = 0; i < 8; ++i) m[k][i] = *(const bf16x8*)(mbase + (size_t)k * 4096 + i * 512);
    }
#pragma unroll 1
    for (int cl = 0; cl < CH; cl += PFD) {
#pragma unroll
      for (int k = 0; k < PFD; ++k) {
        const int cc = cl + k;
        if (cc >= CH) break;
        uint4 b0u, b1u;
        b0u.x = cvt_pk_bf16(acc[0][0], acc[0][1]);
        b0u.y = cvt_pk_bf16(acc[0][2], acc[0][3]);
        b0u.z = cvt_pk_bf16(acc[1][0], acc[1][1]);
        b0u.w = cvt_pk_bf16(acc[1][2], acc[1][3]);
        b1u.x = cvt_pk_bf16(acc[2][0], acc[2][1]);
        b1u.y = cvt_pk_bf16(acc[2][2], acc[2][3]);
        b1u.z = cvt_pk_bf16(acc[3][0], acc[3][1]);
        b1u.w = cvt_pk_bf16(acc[3][2], acc[3][3]);
        bf16x8 b0 = *(bf16x8*)&b0u, b1 = *(bf16x8*)&b1u;
#pragma unroll
        for (int rt = 0; rt < 4; ++rt) {
          const f32x4 nf = {__uint_as_float(n[k][rt].x << 16), __uint_as_float(n[k][rt].x & 0xffff0000u),
                            __uint_as_float(n[k][rt].y << 16), __uint_as_float(n[k][rt].y & 0xffff0000u)};
          f32x4 a = __builtin_amdgcn_mfma_f32_16x16x32_bf16(m[k][rt * 2], b0, nf, 0, 0, 0);
          acc[rt] = __builtin_amdgcn_mfma_f32_16x16x32_bf16(m[k][rt * 2 + 1], b1, a, 0, 0, 0);
        }
        *(uint2*)(htbase + (size_t)cc * 4096 + 0) = uint2{b0u.x, b0u.y};
        *(uint2*)(htbase + (size_t)cc * 4096 + 16) = uint2{b0u.z, b0u.w};
        *(uint2*)(htbase + (size_t)cc * 4096 + 32) = uint2{b1u.x, b1u.y};
        *(uint2*)(htbase + (size_t)cc * 4096 + 48) = uint2{b1u.z, b1u.w};
        const int cn = (cc + PFD < CH) ? cc + PFD : CH - 1;
        { const uint4 q0 = *(const uint4*)(nbase + (size_t)cn * 4096), q1 = *(const uint4*)(nbase + (size_t)cn * 4096 + 8);
          n[k][0] = uint2{q0.x, q0.y}; n[k][1] = uint2{q0.z, q0.w}; n[k][2] = uint2{q1.x, q1.y}; n[k][3] = uint2{q1.z, q1.w}; }
#pragma unroll
        for (int i = 0; i < 8; ++i) m[k][i] = *(const bf16x8*)(mbase + (size_t)cn * 4096 + i * 512);
      }
    }
  }
#pragma unroll
  for (int rt = 0; rt < 4; ++rt) *(f32x4*)(hst + (rt * 64 + lane) * 4) = acc[rt];
}

__device__ void final_norm_phase(const Params& p) {
  const int tid_ = opaque(threadIdx.x);
  const int lane = tid_ & 63;
  const int gw = blockIdx.x * (NTHR / 64) + (tid_ >> 6);
  const int nw = gridDim.x * (NTHR / 64);
  for (int row = gw; row < T; row += nw) {
    float4* xr = (float4*)(p.out + (size_t)row * DM);
    float4 v[4];
    float ss = 0.f;
#pragma unroll
    for (int i = 0; i < 4; ++i) {
      v[i] = xr[lane + 64 * i];
      ss += v[i].x * v[i].x + v[i].y * v[i].y + v[i].z * v[i].z + v[i].w * v[i].w;
    }
    ss = red64(ss);
    float rs = rsqrtf(ss * (1.f / DM) + 1e-6f);
#pragma unroll
    for (int i = 0; i < 4; ++i) {
      float4 ww = ((const float4*)p.final_norm_w)[lane + 64 * i];
      float4 o;
      o.x = v[i].x * rs * ww.x; o.y = v[i].y * rs * ww.y; o.z = v[i].z * rs * ww.z; o.w = v[i].w * rs * ww.w;
      xr[lane + 64 * i] = o;
    }
  }
}

#define XB_TMO      128
#define XB_XCNT(j)  (256  + 64 * (j))
#define XB_XSUB(j)  (1280 + 64 * (j))
#define XB_XGEN(j)  (2304 + 64 * (j))
#define XB_TOP      3328
#define XB_TOPGEN   3392
#define XCD_BAR_WORDS 3456
#define XB_SPIN_CAP (1u << 18)
#define LAS __attribute__((address_space(3)))
__device__ __forceinline__ unsigned xb_ld(unsigned* p)              { return __hip_atomic_load(p, __ATOMIC_RELAXED, __HIP_MEMORY_SCOPE_AGENT); }
__device__ __forceinline__ unsigned xb_add(unsigned* p, unsigned v) { return __hip_atomic_fetch_add(p, v, __ATOMIC_RELAXED, __HIP_MEMORY_SCOPE_AGENT); }
__device__ __forceinline__ unsigned xb_xcc_id() { return (unsigned)__builtin_amdgcn_s_getreg((3 << 11) | 20) & 0xFu; }
#define XB_SPIN(cond, bar) do { unsigned _sp = 0; while (cond) { __builtin_amdgcn_s_sleep(1); \
    if ((++_sp & 255u) == 0u) { if (xb_ld(&(bar)[XB_TMO])) break; if (_sp > XB_SPIN_CAP) { atomicAdd(&(bar)[XB_TMO], 1u); break; } } } } while (0)
struct XcdBarrier { unsigned* bar; unsigned x; volatile LAS unsigned* st; };
__device__ __forceinline__ XcdBarrier xcd_barrier_post(unsigned* bar, volatile LAS unsigned* st) {
  XcdBarrier b; b.bar = bar; b.x = xb_xcc_id(); b.st = st;
  if (threadIdx.x == 0) (void)xb_add(&bar[XB_XCNT(b.x)], 1u);
  return b;
}
__device__ __forceinline__ void xcd_barrier_complete(unsigned* bar, unsigned x, unsigned& nloc, unsigned& nx) {
  const unsigned G = gridDim.x * gridDim.y * gridDim.z;
  unsigned sum, cnt, mine, sp = 0u;
  for (;;) {
    sum = 0u; cnt = 0u; mine = 0u;
#pragma unroll
    for (unsigned j = 0; j < 16; ++j) { const unsigned c = xb_ld(&bar[XB_XCNT(j)]); sum += c; cnt += (c > 0u) ? 1u : 0u; mine = (j == x) ? c : mine; }
    if (sum == G) break;
    __builtin_amdgcn_s_sleep(1);
    if ((++sp & 255u) == 0u) { if (xb_ld(&bar[XB_TMO])) break; if (sp > XB_SPIN_CAP) { atomicAdd(&bar[XB_TMO], 1u); break; } }
  }
  nloc = mine > 0u ? mine : 1u; nx = cnt > 0u ? cnt : 1u;
}
__device__ __forceinline__ void xcd_barrier(const XcdBarrier& b) {
  asm volatile("s_waitcnt vmcnt(0)" ::: "memory");
  __syncthreads();
  if (threadIdx.x == 0) {
    size_t zb = 0;
    asm volatile("" : "+s"(zb));
    unsigned* bar = b.bar + zb;
    __builtin_amdgcn_s_waitcnt(0);
    unsigned nloc = b.st[0], nx = b.st[1];
    if (nloc == 0u) { xcd_barrier_complete(bar, b.x, nloc, nx); b.st[0] = nloc; b.st[1] = nx; }
    const unsigned old = xb_add(&bar[XB_XSUB(b.x)], 1u);
    const unsigned gen = old / nloc;
    if (old + 1u == (gen + 1u) * nloc) {
      __builtin_amdgcn_fence(__ATOMIC_RELEASE, "agent");
      asm volatile("s_waitcnt vmcnt(0)" ::: "memory");
      const unsigned og = xb_add(&bar[XB_TOP], 1u);
      const unsigned tg = og / nx;
      if (og + 1u == (tg + 1u) * nx) xb_add(&bar[XB_TOPGEN], 1u);
      else XB_SPIN(xb_ld(&bar[XB_TOPGEN]) == tg, bar);
      __builtin_amdgcn_fence(__ATOMIC_ACQUIRE, "agent");
      xb_add(&bar[XB_XGEN(b.x)], 1u);
      asm volatile("s_waitcnt vmcnt(0)" ::: "memory");
    } else {
      XB_SPIN(xb_ld(&bar[XB_XGEN(b.x)]) == gen, bar);
      __builtin_amdgcn_fence(__ATOMIC_ACQUIRE, "agent");
      asm volatile("s_waitcnt vmcnt(0)" ::: "memory");
    }
  }
  __syncthreads();
}

__global__ void __launch_bounds__(NTHR) mega(Params p) {
  cg::grid_group grid = cg::this_grid();
  __shared__ __attribute__((aligned(16))) unsigned char smem[SMEM_BYTES];
  const int nb = gridDim.x, bid = blockIdx.x;
  __shared__ uint4 xb_words;
  if (threadIdx.x == 0) xb_words = make_uint4(0u, 0u, 0u, 0u);
  __syncthreads();
  XcdBarrier xb = xcd_barrier_post((unsigned*)(wsp(p) + OFF_BAR), (volatile LAS unsigned*)&xb_words);
  if (bid == 0) {
    float* lb = (float*)(wsp(p) + OFF_LB);
    int i = threadIdx.x;
    float b0 = p.lbnd[i], b1 = p.lbnd[512 + i];
    float m = fmaxf(b0, b1);
    float e0 = __expf(b0 - m), e1 = __expf(b1 - m);
    lb[i] = 0.f;
    lb[512 + i] = e1 / (e0 + e1);
  }
  grid.sync();
  for (int l = 0; l < 2; ++l) {
    const float* xin = (l == 0) ? p.x : p.out;
    if (l == 0) rows_bf16_rs(xin, (bf16r*)(wsp(p) + OFF_HBF), (float*)(wsp(p) + OFF_RS));
    else reduce_rs((const float*)(wsp(p) + OFF_SSP), (float*)(wsp(p) + OFF_RS));
    for (int tile = bid; tile < 1600 + 384; tile += nb) {
      if (tile < 1600) {
        int kt = tile & 15, ntile = tile >> 4;
        transpose_tile<true>(p.w_in + (size_t)l * DM * NCOL, (bf16r*)(wsp(p) + OFF_WIN), DM, NCOL, kt * 64, ntile * 64, smem, p.norm_w + l * DM);
      } else {
        int tt = tile - 1600;
        int kt = tt % 24, ntile = tt / 24;
        transpose_tile<false>(p.w_out + (size_t)l * DMIX * DM, (bf16r*)(wsp(p) + OFF_WOUT), DMIX, DM, kt * 64, ntile * 64, smem, nullptr);
      }
    }
    {
      bf16r* lora = (bf16r*)(wsp(p) + OFF_LORA);
      for (int e = bid * NTHR + opaque(threadIdx.x); e < 2 * 512 * 8; e += nb * NTHR) {
        int which = e >> 12, ch = (e >> 3) & 511, is = e & 7;
        const float* src = (which ? p.a_up : p.w_up) + (size_t)l * 64 * 512 + ch;
        float f[8];
#pragma unroll
        for (int j = 0; j < 8; ++j) f[j] = src[(is * 8 + j) * 512];
        *(uint4*)(lora + ((size_t)which * 512 + ch) * 64 + is * 8) = pack8(f);
      }
    }
    xcd_barrier(xb);
    {
      pg8::StaticOrder so; so.init(T, PDP, nb, bid);
      pg8::EpiProj ep{wsp(p)};
      __syncthreads();
      pg8::gemm_phase<1>((PG8_LAS unsigned char*)smem, (const bf16r*)(wsp(p) + OFF_HBF), (const bf16r*)(wsp(p) + OFF_WIN), T, PDP, so, ep);
      __syncthreads();
    }
    xcd_barrier(xb);
    for (int seg = 0; seg < NSEG; ++seg) {
      for (int it = bid; it < 24 * CH; it += nb) {
        int hh = it / CH, cl = it % CH;
        if (seg > 0) {
          if (hh < 8) gdn_output(p, l, (seg - 1) * CH + cl, cl, hh, smem);
          else if (hh < 16) rwkv_output(p, l, (seg - 1) * CH + cl, cl, hh - 8, smem);
          else hgrn_output(p, l, (seg - 1) * CH + cl, cl, hh - 16, smem);
        }
        const int it2 = it + nb;
        const int nhh = (it2 < 24 * CH) ? it2 / CH : -1, nc = seg * CH + (it2 % CH);
        if (hh < 8) gdn_prep(p, l, seg * CH + cl, cl, hh, smem, nc, nhh);
        else if (hh < 16) rwkv_prep(p, l, seg * CH + cl, cl, hh - 8, smem, nc, nhh);
        else hgrn_prep(p, l, seg * CH + cl, cl, hh - 16, smem, nc, nhh);
      }
      xcd_barrier(xb);
      if (threadIdx.x < 64 && bid < 96) scan_phase(p, seg, bid >> 2, bid & 3, threadIdx.x);
      xcd_barrier(xb);
    }
    for (int it = bid; it < 24 * CH; it += nb) {
      int hh = it / CH, cl = it % CH;
      if (hh < 8) gdn_output(p, l, (NSEG - 1) * CH + cl, cl, hh, smem);
      else if (hh < 16) rwkv_output(p, l, (NSEG - 1) * CH + cl, cl, hh - 8, smem);
      else hgrn_output(p, l, (NSEG - 1) * CH + cl, cl, hh - 16, smem);
    }
    xcd_barrier(xb);
    hgrn_norm_phase(p, l);
    xcd_barrier(xb);
    {
      pg8::StaticOrder so; so.init(T, DM, nb, bid);
      pg8::EpiResid er{xin, p.out, wsp(p), l == 0};
      __syncthreads();
      pg8::gemm_phase<2>((PG8_LAS unsigned char*)smem, (const bf16r*)(wsp(p) + OFF_PROJ), (const bf16r*)(wsp(p) + OFF_WOUT), T, DM, so, er);
      __syncthreads();
    }
    xcd_barrier(xb);
  }
  final_norm_phase(p);
}

extern "C" void kernel_launch(void* const* d_in, const int* in_sizes, int n_in,
                              void* d_out, int out_size, void* d_ws, size_t ws_size,
                              hipStream_t stream) {
  static int grid_blocks = 0;
  if (!grid_blocks) {
    int dev = 0, cus = 0, per_cu = 0;
    (void)hipGetDevice(&dev);
    (void)hipDeviceGetAttribute(&cus, hipDeviceAttributeMultiprocessorCount, dev);
    (void)hipOccupancyMaxActiveBlocksPerMultiprocessor(&per_cu, mega, NTHR, 0);
    if (per_cu > 1) per_cu = 1;
    if (per_cu < 1) per_cu = 1;
    grid_blocks = cus * per_cu;
  }
  Params p{};
  p.x = (const float*)d_in[0]; p.norm_w = (const float*)d_in[1]; p.w_in = (const float*)d_in[2];
  p.conv_w = (const float*)d_in[3]; p.a_log = (const float*)d_in[4]; p.dt_bias = (const float*)d_in[5];
  p.gdn_norm_w = (const float*)d_in[6]; p.mu = (const float*)d_in[7]; p.w0 = (const float*)d_in[8];
  p.w_up = (const float*)d_in[9]; p.a0 = (const float*)d_in[10]; p.a_up = (const float*)d_in[11];
  p.k_k = (const float*)d_in[12]; p.k_a = (const float*)d_in[13]; p.r_k = (const float*)d_in[14];
  p.ln_w = (const float*)d_in[15]; p.ln_b = (const float*)d_in[16]; p.lbnd = (const float*)d_in[17];
  p.hgrn_norm_w = (const float*)d_in[18]; p.w_out = (const float*)d_in[19]; p.final_norm_w = (const float*)d_in[20];
  p.out = (float*)d_out; p.ws = (unsigned char*)d_ws;
  (void)hipMemsetAsync((unsigned char*)d_ws + OFF_BAR, 0, 16384, stream);
  void* args[] = {&p};
  hipError_t e = hipLaunchCooperativeKernel((void*)mega, dim3(grid_blocks), dim3(NTHR), args, 0, stream);
  if (e != hipSuccess) fprintf(stderr, "coop launch failed: %s\n", hipGetErrorString(e));
}
```

```cpp
#include <hip/hip_runtime.h>
#include <hip/hip_cooperative_groups.h>
#include <cstdio>
namespace cg = cooperative_groups;

typedef unsigned short bf16r;
using bf16x8 = __attribute__((ext_vector_type(8))) short;
using f32x4 = __attribute__((ext_vector_type(4))) float;

constexpr int T = 16384, DM = 1024, NCOL = 6288, PDP = 6400, DMIX = 1536;
constexpr int PD = 6272;
constexpr int GDN_GATE = 1536, RWKV_B = 2048, HGRN_B = 4224;
constexpr int NTHR = 512;
constexpr size_t OFF_PROJ = 0;
constexpr size_t OFF_WOUT = 206045184;
constexpr size_t OFF_GSC = OFF_WOUT + 3145728;
constexpr size_t OFF_HALO = OFF_GSC + 1048576;
constexpr size_t OFF_LB = OFF_HALO + 1179648;
constexpr size_t OFF_LORA = OFF_LB + 4096;
constexpr size_t OFF_BAR = OFF_LORA + 131072;
constexpr size_t OFF_SCR = OFF_BAR + 16384;
constexpr size_t OFF_HBF = OFF_SCR;
constexpr size_t OFF_WIN = OFF_SCR + 33554432;
constexpr int SMEM_BYTES = 131072;
constexpr int CH = 128, NSEG = 2;
constexpr size_t OFF_MBUF = OFF_SCR;
constexpr size_t OFF_GAM = OFF_MBUF + (size_t)16 * CH * 8192;
constexpr size_t OFF_NBUF = OFF_GAM + (size_t)8 * CH * 256;
constexpr size_t OFF_HTBUF = OFF_NBUF;
constexpr size_t OFF_HSTATE = OFF_NBUF + (size_t)24 * CH * 8192;
constexpr size_t OFF_HALO2 = OFF_SCR + 49807360;
constexpr size_t OFF_BON = OFF_HALO2 + 2359296;
constexpr size_t OFF_SSP = OFF_BON + 524288;
constexpr size_t OFF_RS = OFF_SSP + 1048576;
constexpr int LS = 72;
__host__ __device__ constexpr int permdk(int c) { return ((c >> 5) << 5) + (((c >> 2) & 3) << 3) + (((c >> 4) & 1) << 2) + (c & 3); }
constexpr int FS = 68;

struct Params {
  const float* x; const float* norm_w; const float* w_in; const float* conv_w; const float* a_log;
  const float* dt_bias; const float* gdn_norm_w; const float* mu; const float* w0; const float* w_up;
  const float* a0; const float* a_up; const float* k_k; const float* k_a; const float* r_k;
  const float* ln_w; const float* ln_b; const float* lbnd; const float* hgrn_norm_w; const float* w_out;
  const float* final_norm_w;
  float* out; unsigned char* ws;
};

typedef float f32x2_t __attribute__((ext_vector_type(2)));
typedef __bf16 bf16x2_t __attribute__((ext_vector_type(2)));
__device__ __forceinline__ unsigned char* wsp(const Params& p) {
  size_t z = 0;
  asm volatile("" : "+s"(z));
  return p.ws + z;
}
__device__ __forceinline__ unsigned cvt_pk_bf16(float lo, float hi) {
  f32x2_t f = {lo, hi};
  bf16x2_t b = __builtin_convertvector(f, bf16x2_t);
  return __builtin_bit_cast(unsigned, b);
}
__device__ __forceinline__ bf16r f2bf(float f) { return (bf16r)(cvt_pk_bf16(f, f) & 0xffffu); }
__device__ __forceinline__ int opaque(int v) { asm volatile("" : "+v"(v)); return v; }
__device__ __forceinline__ float bf2f(bf16r h) { return __uint_as_float(((unsigned)h) << 16); }
__device__ __forceinline__ float sigmoidf_(float x) { return __builtin_amdgcn_rcpf(1.f + __expf(-x)); }
__device__ __forceinline__ float siluf_(float x) { return x * __builtin_amdgcn_rcpf(1.f + __expf(-x)); }
__device__ __forceinline__ float softplusf_(float x) { return x > 20.f ? x : __logf(1.f + __expf(x)); }
template <int CTRL> __device__ __forceinline__ float dpp_mov(float v) {
  return __int_as_float(__builtin_amdgcn_update_dpp(0, __float_as_int(v), CTRL, 0xf, 0xf, true));
}
__device__ __forceinline__ float red8(float v) {
  v += dpp_mov<0xB1>(v);
  v += dpp_mov<0x4E>(v);
  v += dpp_mov<0x141>(v);
  return v;
}
__device__ __forceinline__ float red64(float v) {
  v = red8(v);
  v += dpp_mov<0x128>(v);
  v += __shfl_xor(v, 16); v += __shfl_xor(v, 32); return v;
}
__device__ __forceinline__ void unpack8(uint4 u, float* f) {
  f[0] = __uint_as_float(u.x << 16); f[1] = __uint_as_float(u.x & 0xffff0000u);
  f[2] = __uint_as_float(u.y << 16); f[3] = __uint_as_float(u.y & 0xffff0000u);
  f[4] = __uint_as_float(u.z << 16); f[5] = __uint_as_float(u.z & 0xffff0000u);
  f[6] = __uint_as_float(u.w << 16); f[7] = __uint_as_float(u.w & 0xffff0000u);
}
__device__ __forceinline__ uint4 pack8(const float* f) {
  uint4 u;
  u.x = cvt_pk_bf16(f[0], f[1]);
  u.y = cvt_pk_bf16(f[2], f[3]);
  u.z = cvt_pk_bf16(f[4], f[5]);
  u.w = cvt_pk_bf16(f[6], f[7]);
  return u;
}

template <bool SCALE>
__device__ void transpose_tile(const float* __restrict__ src, bf16r* __restrict__ dst, int K, int N, int k0, int n0,
                               unsigned char* smem, const float* __restrict__ kscale) {
  float* tile = (float*)smem;
  const int tid = opaque(threadIdx.x);
  __syncthreads();
#pragma unroll
  for (int i = 0; i < 2; ++i) {
    const int kk = i * 32 + (tid >> 4), n4 = (tid & 15) * 4;
    float4 v = (n0 + n4 < N) ? *(const float4*)(src + (size_t)(k0 + kk) * N + n0 + n4) : float4{0.f, 0.f, 0.f, 0.f};
    if (SCALE) { const float ks = kscale[k0 + kk]; v.x *= ks; v.y *= ks; v.z *= ks; v.w *= ks; }
    tile[kk * 65 + n4 + 0] = v.x; tile[kk * 65 + n4 + 1] = v.y; tile[kk * 65 + n4 + 2] = v.z; tile[kk * 65 + n4 + 3] = v.w;
  }
  __syncthreads();
  int n = tid >> 3, ks = tid & 7;
  float f[8];
#pragma unroll
  for (int j = 0; j < 8; ++j) f[j] = tile[(ks * 8 + j) * 65 + n];
  *(uint4*)(dst + (size_t)(n0 + n) * K + k0 + ks * 8) = pack8(f);
}

template <int MODE>
__device__ void gemm_tile(const Params& p, const float* __restrict__ xin, int mt, int nt, unsigned char* smem) {
  constexpr int K = (MODE == 1) ? 1024 : 1536;
  bf16r* As = (bf16r*)smem;
  bf16r* Bs = As + 256 * LS;
  const bf16r* proj = (const bf16r*)(wsp(p) + OFF_PROJ);
  const bf16r* hbf = (const bf16r*)(wsp(p) + OFF_HBF);
  const bf16r* Bm = (MODE == 1) ? (const bf16r*)(wsp(p) + OFF_WIN) : (const bf16r*)(wsp(p) + OFF_WOUT);
  const int tid = opaque(threadIdx.x), lane = tid & 63, wid = tid >> 6;
  const int wr = wid >> 1, wc = wid & 1, fr = lane & 15, fq = lane >> 4;
  const int m0 = mt * 256, n0 = nt * 128;
  f32x4 acc[4][4];
#pragma unroll
  for (int i = 0; i < 4; ++i)
#pragma unroll
    for (int j = 0; j < 4; ++j) acc[i][j] = f32x4{0.f, 0.f, 0.f, 0.f};
  uint4 ra0, ra1, ra2, ra3, rb0, rb1;
  const int lrow = tid >> 3, lkc = tid & 7;
  const bf16r* aptr;
  if (MODE == 1) aptr = hbf + (size_t)(m0 + lrow) * 1024 + lkc * 8;
  else aptr = proj + (size_t)(m0 + lrow) * PD + lkc * 8;
  constexpr size_t ASTR = (MODE == 1) ? (size_t)64 * 1024 : (size_t)64 * PD;
  const bf16r* bptr = Bm + (size_t)(n0 + lrow) * K + lkc * 8;
#define GLOAD(k0_)                                                                              \
  {                                                                                             \
    int kk_ = (k0_);                                                                            \
    if (MODE == 2) { int blk_ = kk_ >> 9; kk_ = (blk_ == 0 ? 1536 : (blk_ == 1 ? 3712 : 5760)) + (kk_ & 511); } \
    ra0 = *(const uint4*)(aptr + kk_);                                                          \
    ra1 = *(const uint4*)(aptr + ASTR + kk_);                                                   \
    ra2 = *(const uint4*)(aptr + 2 * ASTR + kk_);                                               \
    ra3 = *(const uint4*)(aptr + 3 * ASTR + kk_);                                               \
    rb0 = *(const uint4*)(bptr + (k0_));                                                        \
    rb1 = *(const uint4*)(bptr + (size_t)64 * K + (k0_));                                       \
  }
  GLOAD(0);
  constexpr int NK = K / 64;
#pragma unroll 1
  for (int kt = 0; kt < NK; ++kt) {
    __syncthreads();
    *(uint4*)(As + lrow * LS + lkc * 8) = ra0;
    *(uint4*)(As + (lrow + 64) * LS + lkc * 8) = ra1;
    *(uint4*)(As + (lrow + 128) * LS + lkc * 8) = ra2;
    *(uint4*)(As + (lrow + 192) * LS + lkc * 8) = ra3;
    *(uint4*)(Bs + lrow * LS + lkc * 8) = rb0;
    *(uint4*)(Bs + (lrow + 64) * LS + lkc * 8) = rb1;
    __syncthreads();
    if (kt + 1 < NK) GLOAD((kt + 1) * 64);
#pragma unroll
    for (int ks = 0; ks < 2; ++ks) {
      bf16x8 bfr[4];
#pragma unroll
      for (int ni = 0; ni < 4; ++ni)
        bfr[ni] = *(const bf16x8*)(Bs + (wc * 64 + ni * 16 + fr) * LS + ks * 32 + fq * 8);
#pragma unroll
      for (int mi = 0; mi < 4; ++mi) {
        bf16x8 afr = *(const bf16x8*)(As + (wr * 64 + mi * 16 + fr) * LS + ks * 32 + fq * 8);
#pragma unroll
        for (int ni = 0; ni < 4; ++ni)
          acc[mi][ni] = __builtin_amdgcn_mfma_f32_16x16x32_bf16(afr, bfr[ni], acc[mi][ni], 0, 0, 0);
      }
    }
  }
#undef GLOAD
  if (MODE == 1) {
    bf16r* projw = (bf16r*)(wsp(p) + OFF_PROJ);
    float* gsc = (float*)(wsp(p) + OFF_GSC);
    bf16r* halo = (bf16r*)(wsp(p) + OFF_HALO);
#pragma unroll
    for (int mi = 0; mi < 4; ++mi)
#pragma unroll
      for (int ni = 0; ni < 4; ++ni) {
        int col = n0 + wc * 64 + ni * 16 + fr;
        if (col < NCOL) {
#pragma unroll
          for (int j = 0; j < 4; ++j) {
            int row = m0 + wr * 64 + mi * 16 + fq * 4 + j;
            float v = acc[mi][ni][j];
            bf16r b = f2bf(v);
            projw[(size_t)row * PD + col] = b;
            if (col >= 1536 && col < 1552) gsc[row * 16 + col - 1536] = v;
            if ((row & 63) == 63 && col >= RWKV_B && col < HGRN_B) halo[(row >> 6) * 2176 + col - RWKV_B] = b;
          }
        }
      }
  } else {
#pragma unroll
    for (int mi = 0; mi < 4; ++mi)
#pragma unroll
      for (int ni = 0; ni < 4; ++ni) {
        int col = n0 + wc * 64 + ni * 16 + fr;
#pragma unroll
        for (int j = 0; j < 4; ++j) {
          int row = m0 + wr * 64 + mi * 16 + fq * 4 + j;
          size_t o = (size_t)row * DM + col;
          p.out[o] = xin[o] + acc[mi][ni][j];
        }
      }
  }
}

namespace pg8 {
#define PG8_LAS __attribute__((address_space(3)))
constexpr int BM = 256, BK = 64, HALF = 128, HTB = HALF * BK * 2, STAGE_BYTES = 8 * HTB, NXCD = 8, WGM = 8;
__device__ __forceinline__ int lds_byte(int r, int c) { const int st = (r >> 4) * 2 + (c >> 5), rr = r & 15, cc = c & 31, ob = rr * 64 + cc * 2; return st * 1024 + (ob ^ (((ob >> 9) & 1) << 5)); }
__device__ __forceinline__ void stage_rc(int b, int& R, int& C) { const int st = b / 1024, sb = b % 1024, swz = sb ^ (((sb >> 9) & 1) << 5); R = (st >> 1) * 16 + swz / 64; C = (st & 1) * 32 + (swz % 64) / 2; }
__device__ __forceinline__ int perm32(int rho) { const int n = rho >> 4, i = rho & 15; return 8 * (i >> 2) + 4 * n + (i & 3); }
struct Unit { int pm, pn; };
struct StaticOrder {
  int nM, nN, nwg, G, c;
  __device__ void init(int M, int N, int G_, int c_) { nM = M / BM; nN = N / BM; nwg = nM * nN; G = G_; c = c_; }
  __device__ bool next(int i, Unit& u) const {
    const long L = (long)i * G + c; if (L >= nwg) return false;
    int wgid = (int)L; { const int q = nwg / NXCD, r = nwg % NXCD, xcd = wgid % NXCD, off = wgid / NXCD; wgid = (xcd < r ? xcd * (q + 1) : r * (q + 1) + (xcd - r) * q) + off; }
    const int nig = WGM * nN, gid = wgid / nig, fm = gid * WGM, gsz = (nM - fm) < WGM ? (nM - fm) : WGM;
    u.pm = fm + ((wgid % nig) % gsz); u.pn = (wgid % nig) / gsz; return true;
  }
};
template <int MODE> __device__ __forceinline__ size_t a_koff(int t) {
  if (MODE == 1) return (size_t)t * (BK * 2);
  const int blk = t >> 3;
  const int cb = (blk == 0 ? 1536 : (blk == 1 ? 3712 : 5760));
  return (size_t)cb * 2 + (size_t)(t & 7) * (BK * 2);
}
template <int MODE, class Epi>
__device__ __forceinline__ void gemm_phase(PG8_LAS unsigned char* lds, const unsigned short* A, const unsigned short* Bt, int M, int N, const StaticOrder& S, const Epi& E) {
  constexpr int K = (MODE == 1) ? 1024 : 1536;
  constexpr int LDA = (MODE == 1) ? 1024 : PD;
  const int tid = opaque(threadIdx.x), wid = __builtin_amdgcn_readfirstlane(tid >> 6), lane = tid & 63, wr = wid >> 2, wc = wid & 3, fr = lane & 15, fq = lane >> 4;
  constexpr int nt = K / BK;
  unsigned voffA[2], voffB[2];
#pragma unroll
  for (int i = 0; i < 2; ++i) { int R, C; stage_rc(tid * 16 + i * 8192, R, C); const int Rb = Epi::PERM ? ((R & ~31) + perm32(R & 31)) : R;
    voffA[i] = (unsigned)(R * LDA + C) * 2u; voffB[i] = (unsigned)(Rb * K + C) * 2u; }
  const size_t kstep = (size_t)(BK * 2);
  const size_t hstepA = (size_t)HALF * LDA * 2, hstepB = (size_t)HALF * K * 2;
  const size_t tstepA = 2 * hstepA, tstepB = 2 * hstepB;
  const unsigned ldsw = (unsigned)wid * 1024u;
  const int aoff = lds_byte(wr * 64 + fr, fq * 8), boff = lds_byte(wc * 32 + fr, fq * 8);
#define PG8_SA(b, h) (((b) * 2 + (h)) * HTB)
#define PG8_SB(b, h) ((4 + (b) * 2 + (h)) * HTB)
#define PG8_STAGE(bufoff, gbase, voff) do { _Pragma("unroll") for (int _i = 0; _i < 2; ++_i) \
    __builtin_amdgcn_global_load_lds((const unsigned*)((const char*)(gbase) + (voff)[_i]), (PG8_LAS unsigned*)(lds + (bufoff) + ldsw + _i * 8192), 16, 0, 0); } while (0)
#define PG8_LDA(dst, b, h) do { _Pragma("unroll") for (int m = 0; m < 4; ++m) _Pragma("unroll") for (int k = 0; k < 2; ++k) dst[m][k] = *(const PG8_LAS bf16x8*)(lds + PG8_SA(b, h) + aoff + m * 2048 + k * 1024); } while (0)
#define PG8_LDB(dst, b, h) do { _Pragma("unroll") for (int n = 0; n < 2; ++n) _Pragma("unroll") for (int k = 0; k < 2; ++k) dst[n][k] = *(const PG8_LAS bf16x8*)(lds + PG8_SB(b, h) + boff + n * 2048 + k * 1024); } while (0)
#define PG8_MMA(ai, bj, At, Bt_) do { __builtin_amdgcn_s_setprio(1); _Pragma("unroll") for (int m = 0; m < 4; ++m) _Pragma("unroll") for (int n = 0; n < 2; ++n) _Pragma("unroll") for (int k = 0; k < 2; ++k) \
    acc[ai][bj][m][n] = __builtin_amdgcn_mfma_f32_16x16x32_bf16(Bt_[n][k], At[m][k], acc[ai][bj][m][n], 0, 0, 0); __builtin_amdgcn_s_setprio(0); } while (0)
#define PG8_WAIT_V(n) asm volatile("s_waitcnt vmcnt(" #n ")" ::: "memory")
#define PG8_WAIT_L(n) asm volatile("s_waitcnt lgkmcnt(" #n ")" ::: "memory")
#define PG8_BAR __builtin_amdgcn_s_barrier()
#define PG8_SCHED __builtin_amdgcn_sched_barrier(0)
  Unit cur, nxt; int ui = 0;
  if (!S.next(0, cur)) return;
  f32x4 acc[2][2][4][2];
#pragma unroll
  for (int a = 0; a < 2; ++a)
#pragma unroll
    for (int b = 0; b < 2; ++b)
#pragma unroll
      for (int m = 0; m < 4; ++m)
#pragma unroll
        for (int n = 0; n < 2; ++n) acc[a][b][m][n] = (f32x4){0.f, 0.f, 0.f, 0.f};
  bf16x8 At[4][2], B0[2][2], B1[2][2];
  const char* cA = (const char*)A + (size_t)cur.pm * tstepA; const char* cB = (const char*)Bt + (size_t)cur.pn * tstepB;
  PG8_STAGE(PG8_SB(0, 0), cB, voffB); PG8_STAGE(PG8_SA(0, 0), cA + a_koff<MODE>(0), voffA); PG8_STAGE(PG8_SB(0, 1), cB + hstepB, voffB); PG8_STAGE(PG8_SA(0, 1), cA + a_koff<MODE>(0) + hstepA, voffA);
  if (wr == 1) PG8_BAR;
  PG8_WAIT_V(4); PG8_BAR;
  PG8_STAGE(PG8_SB(1, 0), cB + kstep, voffB); PG8_STAGE(PG8_SA(1, 0), cA + a_koff<MODE>(1), voffA); PG8_STAGE(PG8_SB(1, 1), cB + hstepB + kstep, voffB);
  PG8_WAIT_V(6); PG8_BAR;
  for (;;) {
    const bool has_next = S.next(ui + 1, nxt);
    const char* nA = has_next ? (const char*)A + (size_t)nxt.pm * tstepA : cA; const char* nB = has_next ? (const char*)Bt + (size_t)nxt.pn * tstepB : cB;
#pragma unroll 1
    for (int t = 0; t < nt; t += 2) {
      const bool last = (t == nt - 2);
      const char* a1 = cA + a_koff<MODE>(t + 1);
      const char* a2 = last ? nA + a_koff<MODE>(0) : cA + a_koff<MODE>(t + 2);
      const char* a3 = last ? nA + a_koff<MODE>(1) : cA + a_koff<MODE>(t + 3);
      const char* b2 = last ? nB : cB + (size_t)(t + 2) * kstep;
      const char* b3 = b2 + kstep;
      PG8_LDB(B0, 0, 0); PG8_SCHED; PG8_LDA(At, 0, 0); PG8_STAGE(PG8_SA(1, 1), a1 + hstepA, voffA);
      PG8_WAIT_L(8); PG8_BAR; PG8_WAIT_L(0); PG8_MMA(0, 0, At, B0); PG8_BAR; PG8_SCHED;
      PG8_LDB(B1, 0, 1); PG8_STAGE(PG8_SB(0, 0), b2, voffB);
      PG8_BAR; PG8_WAIT_L(0); PG8_MMA(0, 1, At, B1); PG8_BAR;
      PG8_LDA(At, 0, 1); PG8_STAGE(PG8_SA(0, 0), a2, voffA);
      PG8_BAR; PG8_WAIT_L(0); PG8_MMA(1, 0, At, B0); PG8_BAR; PG8_SCHED;
      PG8_STAGE(PG8_SB(0, 1), b2 + hstepB, voffB);
      PG8_WAIT_V(6); PG8_BAR; PG8_MMA(1, 1, At, B1); PG8_BAR;
      PG8_LDB(B0, 1, 0); PG8_SCHED; PG8_LDA(At, 1, 0); PG8_STAGE(PG8_SA(0, 1), a2 + hstepA, voffA);
      PG8_WAIT_L(8); PG8_BAR; PG8_WAIT_L(0); PG8_MMA(0, 0, At, B0); PG8_BAR; PG8_SCHED;
      PG8_LDB(B1, 1, 1); PG8_STAGE(PG8_SB(1, 0), b3, voffB);
      PG8_BAR; PG8_WAIT_L(0); PG8_MMA(0, 1, At, B1); PG8_BAR;
      PG8_LDA(At, 1, 1); PG8_STAGE(PG8_SA(1, 0), a3, voffA);
      PG8_BAR; PG8_WAIT_L(0); PG8_MMA(1, 0, At, B0); PG8_BAR; PG8_SCHED;
      PG8_STAGE(PG8_SB(1, 1), b3 + hstepB, voffB);
      PG8_WAIT_V(6); PG8_BAR; PG8_MMA(1, 1, At, B1); PG8_BAR;
    }
    E(acc, cur, wr, wc, fr, fq);
    if (!has_next) break;
#pragma unroll
    for (int a = 0; a < 2; ++a)
#pragma unroll
      for (int b = 0; b < 2; ++b)
#pragma unroll
        for (int m = 0; m < 4; ++m)
#pragma unroll
          for (int n = 0; n < 2; ++n) acc[a][b][m][n] = (f32x4){0.f, 0.f, 0.f, 0.f};
    cur = nxt; cA = nA; cB = nB; ++ui;
  }
  PG8_WAIT_V(0);
  if (wr == 0) PG8_BAR;
  PG8_BAR;
#undef PG8_SA
#undef PG8_SB
#undef PG8_STAGE
#undef PG8_LDA
#undef PG8_LDB
#undef PG8_MMA
#undef PG8_WAIT_V
#undef PG8_WAIT_L
#undef PG8_BAR
#undef PG8_SCHED
}
struct EpiProj {
  static constexpr bool PERM = true;
  unsigned char* ws;
  __device__ __forceinline__ void operator()(const f32x4 (&acc)[2][2][4][2], const Unit& u, int wr, int wc, int fr, int fq) const {
    bf16r* projw = (bf16r*)(ws + OFF_PROJ);
    float* gsc = (float*)(ws + OFF_GSC);
    bf16r* halo = (bf16r*)(ws + OFF_HALO);
#pragma unroll
    for (int ai = 0; ai < 2; ++ai)
#pragma unroll
      for (int m = 0; m < 4; ++m) {
        const int row = u.pm * BM + ai * HALF + wr * 64 + m * 16 + fr;
        const float rsr = ((const float*)(ws + OFF_RS))[row];
#pragma unroll
        for (int bj = 0; bj < 2; ++bj) {
          const int c0 = u.pn * BM + bj * HALF + wc * 32 + 8 * fq;
          if (c0 < NCOL) {
            const f32x4 v0 = acc[ai][bj][m][0] * rsr, v1 = acc[ai][bj][m][1] * rsr;
            if (c0 >= 1536 && c0 < 1552) {
              *(f32x4*)(gsc + row * 16 + (c0 - 1536)) = v0;
              *(f32x4*)(gsc + row * 16 + (c0 - 1536) + 4) = v1;
            } else {
              const int cs = (c0 < 1536) ? c0 : c0 - 16;
              uint4 pk;
              pk.x = cvt_pk_bf16(v0[0], v0[1]); pk.y = cvt_pk_bf16(v0[2], v0[3]);
              pk.z = cvt_pk_bf16(v1[0], v1[1]); pk.w = cvt_pk_bf16(v1[2], v1[3]);
              *(uint4*)(projw + (size_t)row * PD + cs) = pk;
              if ((row & 63) == 63 && cs >= RWKV_B && cs < HGRN_B) *(uint4*)(halo + (size_t)(row >> 6) * 2176 + (cs - RWKV_B)) = pk;
              if ((row & 63) >= 61 && cs < 1536) *(uint4*)((bf16r*)(ws + OFF_HALO2) + ((size_t)(row >> 6) * 3 + ((row & 63) - 61)) * 1536 + cs) = pk;
            }
          }
        }
      }
  }
};
struct EpiResid {
  static constexpr bool PERM = false;
  const float* xin; float* out; unsigned char* ws; bool next_in;
  __device__ __forceinline__ void operator()(const f32x4 (&acc)[2][2][4][2], const Unit& u, int wr, int wc, int fr, int fq) const {
    bf16r* hbf = (bf16r*)(ws + OFF_HBF);
    float* ssp = (float*)(ws + OFF_SSP) + (size_t)(u.pn * 4 + wc) * T;
#pragma unroll
    for (int ai = 0; ai < 2; ++ai)
#pragma unroll
      for (int m = 0; m < 4; ++m) {
        const int row = u.pm * BM + ai * HALF + wr * 64 + m * 16 + fr;
        float ss = 0.f;
#pragma unroll
        for (int bj = 0; bj < 2; ++bj)
#pragma unroll
          for (int n = 0; n < 2; ++n) {
            const int c0 = u.pn * BM + bj * HALF + wc * 32 + 16 * n + 4 * fq;
            const size_t o = (size_t)row * DM + c0;
            const f32x4 x = *(const f32x4*)(xin + o);
            const f32x4 y = x + acc[ai][bj][m][n];
            *(f32x4*)(out + o) = y;
            if (next_in) {
              ss += y[0] * y[0] + y[1] * y[1] + y[2] * y[2] + y[3] * y[3];
              *(uint2*)(hbf + o) = uint2{cvt_pk_bf16(y[0], y[1]), cvt_pk_bf16(y[2], y[3])};
            }
          }
        if (next_in) {
          ss += __shfl_xor(ss, 16);
          ss += __shfl_xor(ss, 32);
          if (fq == 0) ssp[row] = ss;
        }
      }
  }
};
}

__device__ void rows_bf16_rs(const float* __restrict__ xin, bf16r* __restrict__ dst, float* __restrict__ rsout) {
  const int tid_ = opaque(threadIdx.x);
  const int lane = tid_ & 63;
  const int gw = blockIdx.x * (NTHR / 64) + (tid_ >> 6);
  const int nw = gridDim.x * (NTHR / 64);
  for (int row = gw; row < T; row += nw) {
    const float4* xr = (const float4*)(xin + (size_t)row * DM);
    float4 v[4];
    float ss = 0.f;
#pragma unroll
    for (int i = 0; i < 4; ++i) {
      v[i] = xr[lane + 64 * i];
      ss += v[i].x * v[i].x + v[i].y * v[i].y + v[i].z * v[i].z + v[i].w * v[i].w;
    }
    ss = red64(ss);
    if (lane == 0) rsout[row] = rsqrtf(ss * (1.f / DM) + 1e-6f);
#pragma unroll
    for (int i = 0; i < 4; ++i) {
      uint2 o;
      o.x = cvt_pk_bf16(v[i].x, v[i].y);
      o.y = cvt_pk_bf16(v[i].z, v[i].w);
      *(uint2*)(dst + (size_t)row * DM + (lane + 64 * i) * 4) = o;
    }
  }
}
__device__ void reduce_rs(const float* __restrict__ ssp, float* __restrict__ rsout) {
  const int tid_ = opaque(threadIdx.x);
  for (int row = blockIdx.x * NTHR + tid_; row < T; row += gridDim.x * NTHR) {
    float ss = 0.f;
#pragma unroll
    for (int i = 0; i < 16; ++i) ss += ssp[(size_t)i * T + row];
    rsout[row] = rsqrtf(ss * (1.f / DM) + 1e-6f);
  }
}

__device__ __forceinline__ void shifted8(const bf16r* pc, const bf16r* pp, const float* mu, bool hasprev, int col, float* o8) {
  float cur[8], prv[8];
  unpack8(*(const uint4*)(pc + col), cur);
  uint4 z = hasprev ? *(const uint4*)(pp + col) : uint4{0u, 0u, 0u, 0u};
  unpack8(z, prv);
#pragma unroll
  for (int j = 0; j < 8; ++j) o8[j] = cur[j] + mu[col + j] * (prv[j] - cur[j]);
}

__device__ void mixer_naive(const Params& p, int l, int br, int h, unsigned char* smem) {
  float* sW = (float*)smem;
  float* sA = sW + 4096;
  float* sB = sA + 4096;
  float* sK = sB + 4096;
  float* sQ = sK + 4096;
  float* sV = sQ + 4096;
  float* sO = sV + 4096;
  float* sX = sO + 4096;
  bf16r* proj = (bf16r*)(wsp(p) + OFF_PROJ);
  const float* gsc = (const float*)(wsp(p) + OFF_GSC);
  const bf16r* halo = (const bf16r*)(wsp(p) + OFF_HALO);
  const float* lb = (const float*)(wsp(p) + OFF_LB) + l * 512;
  const int tid = opaque(threadIdx.x), lane = tid & 63, wid = tid >> 6;
  const int tt = tid >> 3, js = tid & 7, j0 = js * 8;
  const int rv = wid * 8 + (lane >> 3);
  const int kq = (lane & 7) * 8;
  float s[8];
#pragma unroll
  for (int i = 0; i < 8; ++i) s[i] = 0.f;

#pragma unroll 1
  for (int c = 0; c < T / 64; ++c) {
    const int t = c * 64 + tt;
    __syncthreads();
    if (br == 0) {
      float cq[8], ck[8], cv[8];
#pragma unroll
      for (int j = 0; j < 8; ++j) { cq[j] = 0.f; ck[j] = 0.f; cv[j] = 0.f; }
      const float* cw = p.conv_w + (size_t)l * 4 * 1536;
#pragma unroll
      for (int i = 0; i < 4; ++i) {
        int ts = t - 3 + i;
        if (ts >= 0) {
          float fq_[8], fk_[8], fv_[8];
          const bf16r* pr = proj + (size_t)ts * PD + h * 64 + j0;
          unpack8(*(const uint4*)(pr), fq_);
          unpack8(*(const uint4*)(pr + 512), fk_);
          unpack8(*(const uint4*)(pr + 1024), fv_);
#pragma unroll
          for (int j = 0; j < 8; ++j) {
            cq[j] += cw[i * 1536 + h * 64 + j0 + j] * fq_[j];
            ck[j] += cw[i * 1536 + 512 + h * 64 + j0 + j] * fk_[j];
            cv[j] += cw[i * 1536 + 1024 + h * 64 + j0 + j] * fv_[j];
          }
        }
      }
      float sq = 0.f, sk = 0.f;
#pragma unroll
      for (int j = 0; j < 8; ++j) {
        cq[j] = siluf_(cq[j]); ck[j] = siluf_(ck[j]); cv[j] = siluf_(cv[j]);
        sq += cq[j] * cq[j]; sk += ck[j] * ck[j];
      }
      sq = red8(sq); sk = red8(sk);
      float nq = rsqrtf(sq + 1e-6f) * 0.125f, nk = rsqrtf(sk + 1e-6f);
      float beta = sigmoidf_(gsc[t * 16 + h]);
      float g = -__expf(p.a_log[l * 8 + h]) * softplusf_(gsc[t * 16 + 8 + h] + p.dt_bias[l * 8 + h]);
      float eg = __expf(g);
#pragma unroll
      for (int j = 0; j < 8; ++j) {
        float kn = ck[j] * nk;
        int o = tt * 64 + j0 + j;
        sQ[o] = cq[j] * nq; sA[o] = kn; sK[o] = beta * kn; sB[o] = -eg * beta * kn; sW[o] = eg; sV[o] = cv[j];
      }
    } else if (br == 1) {
      const float* mu = p.mu + (size_t)l * 2176;
      const bf16r* pc = proj + (size_t)t * PD + RWKV_B;
      const bf16r* pp = (tt == 0) ? (halo + (size_t)(c - 1) * 2176) : (pc - PD);
      const bool hasprev = (t > 0);
      {
        float wd[8], ad[8];
        shifted8(pc, pp, mu, hasprev, 1536 + j0, wd);
        shifted8(pc, pp, mu, hasprev, 1600 + j0, ad);
#pragma unroll
        for (int j = 0; j < 8; ++j) { sO[tt * 64 + j0 + j] = tanhf(wd[j]); sX[tt * 64 + j0 + j] = ad[j]; }
      }
      __syncthreads();
      float aw[8], aa[8];
      const int ch0 = h * 64 + j0;
#pragma unroll
      for (int j = 0; j < 8; ++j) { aw[j] = p.w0[l * 512 + ch0 + j]; aa[j] = p.a0[l * 512 + ch0 + j]; }
      const float* wu = p.w_up + (size_t)l * 64 * 512 + ch0;
      const float* au = p.a_up + (size_t)l * 64 * 512 + ch0;
#pragma unroll 2
      for (int i = 0; i < 64; ++i) {
        float xw = sO[tt * 64 + i], xa = sX[tt * 64 + i];
        float4 w1 = *(const float4*)(wu + i * 512), w2 = *(const float4*)(wu + i * 512 + 4);
        float4 a1 = *(const float4*)(au + i * 512), a2 = *(const float4*)(au + i * 512 + 4);
        aw[0] += xw * w1.x; aw[1] += xw * w1.y; aw[2] += xw * w1.z; aw[3] += xw * w1.w;
        aw[4] += xw * w2.x; aw[5] += xw * w2.y; aw[6] += xw * w2.z; aw[7] += xw * w2.w;
        aa[0] += xa * a1.x; aa[1] += xa * a1.y; aa[2] += xa * a1.z; aa[3] += xa * a1.w;
        aa[4] += xa * a2.x; aa[5] += xa * a2.y; aa[6] += xa * a2.z; aa[7] += xa * a2.w;
      }
      float r8[8], k8[8], v8[8];
      shifted8(pc, pp, mu, hasprev, ch0, r8); shifted8(pc, pp, mu, hasprev, 512 + ch0, k8); shifted8(pc, pp, mu, hasprev, 1024 + ch0, v8);
      float kk[8], ssk = 0.f;
#pragma unroll
      for (int j = 0; j < 8; ++j) { kk[j] = k8[j] * p.k_k[l * 512 + ch0 + j]; ssk += kk[j] * kk[j]; }
      ssk = red8(ssk);
      float nk = rsqrtf(ssk + 1e-6f);
      __syncthreads();
#pragma unroll
      for (int j = 0; j < 8; ++j) {
        float w_raw = -softplusf_(-aw[j]) - 0.5f;
        float dec = __expf(-__expf(w_raw));
        float ic = sigmoidf_(aa[j]);
        float kn = kk[j] * nk;
        int o = tt * 64 + j0 + j;
        sW[o] = dec; sA[o] = -kn; sB[o] = kn * ic;
        sK[o] = k8[j] * (1.f + (ic - 1.f) * p.k_a[l * 512 + ch0 + j]);
        sV[o] = v8[j]; sQ[o] = r8[j];
      }
    } else {
      const bf16r* pc = proj + (size_t)t * PD + HGRN_B + h * 64 + j0;
      float q8[8], f8[8], i8[8];
      unpack8(*(const uint4*)(pc), q8);
      unpack8(*(const uint4*)(pc + 512), f8);
      unpack8(*(const uint4*)(pc + 1024), i8);
#pragma unroll
      for (int j = 0; j < 8; ++j) {
        float lbv = lb[h * 64 + j0 + j];
        float sg = sigmoidf_(f8[j]);
        int o = tt * 64 + j0 + j;
        sW[o] = lbv + (1.f - lbv) * sg;
        sA[o] = 0.f; sB[o] = 0.f;
        sK[o] = (1.f - lbv) * (1.f - sg);
        sQ[o] = siluf_(q8[j]); sV[o] = i8[j];
      }
    }
    __syncthreads();
#pragma unroll 2
    for (int st = 0; st < 64; ++st) {
      const float4* w4 = (const float4*)(sW + st * 64 + kq);
      const float4* a4 = (const float4*)(sA + st * 64 + kq);
      const float4* b4 = (const float4*)(sB + st * 64 + kq);
      const float4* k4 = (const float4*)(sK + st * 64 + kq);
      const float4* q4 = (const float4*)(sQ + st * 64 + kq);
      float4 wa = w4[0], wb = w4[1], aa_ = a4[0], ab = a4[1], ba = b4[0], bb = b4[1];
      float4 ka = k4[0], kb = k4[1], qa = q4[0], qb = q4[1];
      float vv = sV[st * 64 + rv];
      float d = s[0] * aa_.x + s[1] * aa_.y + s[2] * aa_.z + s[3] * aa_.w + s[4] * ab.x + s[5] * ab.y + s[6] * ab.z + s[7] * ab.w;
      d = red8(d);
      s[0] = s[0] * wa.x + d * ba.x + vv * ka.x;
      s[1] = s[1] * wa.y + d * ba.y + vv * ka.y;
      s[2] = s[2] * wa.z + d * ba.z + vv * ka.z;
      s[3] = s[3] * wa.w + d * ba.w + vv * ka.w;
      s[4] = s[4] * wb.x + d * bb.x + vv * kb.x;
      s[5] = s[5] * wb.y + d * bb.y + vv * kb.y;
      s[6] = s[6] * wb.z + d * bb.z + vv * kb.z;
      s[7] = s[7] * wb.w + d * bb.w + vv * kb.w;
      float od = s[0] * qa.x + s[1] * qa.y + s[2] * qa.z + s[3] * qa.w + s[4] * qb.x + s[5] * qb.y + s[6] * qb.z + s[7] * qb.w;
      od = red8(od);
      if ((lane & 7) == 0) sO[st * 64 + rv] = od;
    }
    __syncthreads();
    float o8[8];
#pragma unroll
    for (int j = 0; j < 8; ++j) o8[j] = sO[tt * 64 + j0 + j];
    if (br == 0) {
      float ss = 0.f;
#pragma unroll
      for (int j = 0; j < 8; ++j) ss += o8[j] * o8[j];
      ss = red8(ss);
      float rs = rsqrtf(ss * (1.f / 64.f) + 1e-6f);
      bf16r* gp = proj + (size_t)t * PD + GDN_GATE + h * 64 + j0;
      float g8[8], y8[8];
      unpack8(*(const uint4*)gp, g8);
#pragma unroll
      for (int j = 0; j < 8; ++j) y8[j] = o8[j] * rs * p.gdn_norm_w[l * 64 + j0 + j] * siluf_(g8[j]);
      *(uint4*)gp = pack8(y8);
    } else if (br == 1) {
      float sm = 0.f;
#pragma unroll
      for (int j = 0; j < 8; ++j) sm += o8[j];
      sm = red8(sm);
      float mean = sm * (1.f / 64.f);
      float sv = 0.f;
#pragma unroll
      for (int j = 0; j < 8; ++j) { float d = o8[j] - mean; sv += d * d; }
      sv = red8(sv);
      float rs = rsqrtf(sv * (1.f / 64.f) + 64e-5f);
      float bs = 0.f;
      const int ch0 = h * 64 + j0;
#pragma unroll
      for (int j = 0; j < 8; ++j) bs += sQ[tt * 64 + j0 + j] * sK[tt * 64 + j0 + j] * p.r_k[l * 512 + ch0 + j];
      bs = red8(bs);
      const float* mu = p.mu + (size_t)l * 2176;
      bf16r* gp = proj + (size_t)t * PD + RWKV_B + 1664 + ch0;
      const bf16r* gpp = (tt == 0) ? (halo + (size_t)(c - 1) * 2176 + 1664 + ch0) : (gp - PD);
      float cur[8], prv[8], y8[8];
      unpack8(*(const uint4*)gp, cur);
      if (t > 0) unpack8(*(const uint4*)gpp, prv);
      else {
#pragma unroll
        for (int j = 0; j < 8; ++j) prv[j] = 0.f;
      }
#pragma unroll
      for (int j = 0; j < 8; ++j) {
        float gt = cur[j] + mu[1664 + ch0 + j] * (prv[j] - cur[j]);
        float on = (o8[j] - mean) * rs * p.ln_w[l * 512 + ch0 + j] + p.ln_b[l * 512 + ch0 + j];
        on += bs * sV[tt * 64 + j0 + j];
        y8[j] = on * siluf_(gt);
      }
      __syncthreads();
      *(uint4*)gp = pack8(y8);
    } else {
      bf16r* op = proj + (size_t)t * PD + HGRN_B + h * 64 + j0;
      *(uint4*)op = pack8(o8);
    }
  }
}

__device__ void hgrn_norm_phase(const Params& p, int l) {
  bf16r* proj = (bf16r*)(wsp(p) + OFF_PROJ);
  const int tid_ = opaque(threadIdx.x);
  const int lane = tid_ & 63;
  const int gw = blockIdx.x * (NTHR / 64) + (tid_ >> 6);
  const int nw = gridDim.x * (NTHR / 64);
  for (int t = gw; t < T; t += nw) {
    float o8[8], g8[8], y8[8];
    unpack8(*(const uint4*)(proj + (size_t)t * PD + HGRN_B + lane * 8), o8);
    bf16r* gp = proj + (size_t)t * PD + HGRN_B + 1536 + lane * 8;
    unpack8(*(const uint4*)gp, g8);
    float ss = 0.f;
#pragma unroll
    for (int j = 0; j < 8; ++j) ss += o8[j] * o8[j];
    ss = red64(ss);
    float rs = rsqrtf(ss * (1.f / 512.f) + 1e-6f);
#pragma unroll
    for (int j = 0; j < 8; ++j) y8[j] = o8[j] * rs * p.hgrn_norm_w[l * 512 + lane * 8 + j] * siluf_(g8[j]);
    *(uint4*)gp = pack8(y8);
  }
}


__device__ __forceinline__ void mm64(const bf16r* A, const bf16r* Bt, int lane, int wid, f32x4& c0, f32x4& c1) {
  const int fr = lane & 15, fq = lane >> 4, rt = wid >> 1, ct = (wid & 1) * 2;
#pragma unroll
  for (int s2 = 0; s2 < 2; ++s2) {
    bf16x8 a = *(const bf16x8*)(A + (rt * 16 + fr) * LS + s2 * 32 + fq * 8);
    bf16x8 b0 = *(const bf16x8*)(Bt + (ct * 16 + fr) * LS + s2 * 32 + fq * 8);
    bf16x8 b1 = *(const bf16x8*)(Bt + ((ct + 1) * 16 + fr) * LS + s2 * 32 + fq * 8);
    c0 = __builtin_amdgcn_mfma_f32_16x16x32_bf16(a, b0, c0, 0, 0, 0);
    c1 = __builtin_amdgcn_mfma_f32_16x16x32_bf16(a, b1, c1, 0, 0, 0);
  }
}

typedef short s16x4 __attribute__((ext_vector_type(4)));
__device__ __forceinline__ bf16x8 frag_tr(const bf16r* img, int ntile, int s2, int lane) {
  const int g = lane >> 4, q = (lane & 15) >> 2, pp = lane & 3;
  const bf16r* a0 = img + (32 * s2 + 8 * g + q) * LS + 16 * ntile + 4 * pp;
  s16x4 lo = __builtin_amdgcn_ds_read_tr16_b64_v4i16((__attribute__((address_space(3))) s16x4*)a0);
  s16x4 hi = __builtin_amdgcn_ds_read_tr16_b64_v4i16((__attribute__((address_space(3))) s16x4*)(a0 + 4 * LS));
  return bf16x8{lo[0], lo[1], lo[2], lo[3], hi[0], hi[1], hi[2], hi[3]};
}
template <bool ATR, bool BTR>
__device__ __forceinline__ void mm64t(const bf16r* A, const bf16r* B, int lane, int wid, f32x4& c0, f32x4& c1) {
  const int fr = lane & 15, fq = lane >> 4, rt = wid >> 1, ct = (wid & 1) * 2;
#pragma unroll
  for (int s2 = 0; s2 < 2; ++s2) {
    bf16x8 a, b0, b1;
    if (ATR) a = frag_tr(A, rt, s2, lane);
    else a = *(const bf16x8*)(A + (rt * 16 + fr) * LS + s2 * 32 + fq * 8);
    if (BTR) { b0 = frag_tr(B, ct, s2, lane); b1 = frag_tr(B, ct + 1, s2, lane); }
    else {
      b0 = *(const bf16x8*)(B + (ct * 16 + fr) * LS + s2 * 32 + fq * 8);
      b1 = *(const bf16x8*)(B + ((ct + 1) * 16 + fr) * LS + s2 * 32 + fq * 8);
    }
    c0 = __builtin_amdgcn_mfma_f32_16x16x32_bf16(a, b0, c0, 0, 0, 0);
    c1 = __builtin_amdgcn_mfma_f32_16x16x32_bf16(a, b1, c1, 0, 0, 0);
  }
}

__device__ __forceinline__ void cumsum_tokens(float* v, float* tot, float* sTot, int lane, int wid, int j0) {
#pragma unroll
  for (int d = 8; d < 64; d <<= 1) {
#pragma unroll
    for (int j = 0; j < 8; ++j) {
      float x = __shfl_up(v[j], d);
      if (lane >= d) v[j] += x;
    }
  }
  if ((lane >> 3) == 7) {
#pragma unroll
    for (int j = 0; j < 8; ++j) sTot[wid * 64 + j0 + j] = v[j];
  }
  __syncthreads();
#pragma unroll
  for (int j = 0; j < 8; ++j) tot[j] = 0.f;
#pragma unroll
  for (int w = 0; w < 8; ++w) {
#pragma unroll
    for (int j = 0; j < 8; ++j) {
      float x = sTot[w * 64 + j0 + j];
      if (w < wid) v[j] += x;
      tot[j] += x;
    }
  }
}

__device__ __forceinline__ void store_nacc(bf16r* nb, int lane, int wid, const f32x4& c0, const f32x4& c1) {
  const int rt = wid >> 1, ct = (wid & 1) * 2;
  *(uint2*)(nb + ((ct * 64 + lane) * 4 + rt) * 4) = uint2{cvt_pk_bf16(c0[0], c0[1]), cvt_pk_bf16(c0[2], c0[3])};
  *(uint2*)(nb + (((ct + 1) * 64 + lane) * 4 + rt) * 4) = uint2{cvt_pk_bf16(c1[0], c1[1]), cvt_pk_bf16(c1[2], c1[3])};
}

__device__ __forceinline__ void touch_prep(const Params& p, int c, int hh, int tid, unsigned& ta, unsigned& tb) {
  const bf16r* proj = (const bf16r*)(wsp(p) + OFF_PROJ) + (size_t)c * 64 * PD;
  const int br = hh >> 3, h = hh & 7;
  const int nper = (br == 1) ? 6 : 3;
  if (tid < 64 * nper) {
    const int row = (br == 1) ? tid / 6 : tid / 3, si = tid - row * nper;
    int col;
    if (br == 0) col = si * 512 + h * 64;
    else if (br == 2) col = HGRN_B + si * 512 + h * 64;
    else col = RWKV_B + (si < 3 ? si * 512 + h * 64 : (si == 3 ? 1664 + h * 64 : (si == 4 ? 1536 : 1600)));
    const unsigned* a = (const unsigned*)(proj + (size_t)row * PD + col);
    ta = a[0];
    tb = a[31];
  }
}

__device__ __forceinline__ void hgrn_load(const Params& p, int l, int t, int h, int j0, float* q, float* lg, float* k, float* v) {
  const bf16r* proj = (const bf16r*)(wsp(p) + OFF_PROJ);
  const float* lb = (const float*)(wsp(p) + OFF_LB) + l * 512;
  const bf16r* pc = proj + (size_t)t * PD + HGRN_B + h * 64 + j0;
  float q8[8], f8[8];
  unpack8(*(const uint4*)(pc), q8);
  unpack8(*(const uint4*)(pc + 512), f8);
  unpack8(*(const uint4*)(pc + 1024), v);
#pragma unroll
  for (int j = 0; j < 8; ++j) {
    float lbv = lb[h * 64 + j0 + j];
    float f = f8[j];
    float sg = sigmoidf_(f);
    float g = lbv + (1.f - lbv) * sg;
    lg[j] = __logf(fmaxf(g, 1e-37f));
    k[j] = (1.f - lbv) * (1.f - sg);
    q[j] = siluf_(q8[j]);
  }
}

__device__ void hgrn_prep(const Params& p, int l, int c, int cl, int h, unsigned char* smem, int nc, int nhh) {
  unsigned ta = 0u, tb = 0u;
  bf16r* sKT = (bf16r*)smem;
  bf16r* sVT = sKT + 64 * LS;
  bf16r* sQt = sVT + 64 * LS;
  bf16r* sKt = sQt + 64 * LS;
  bf16r* sAtt = sKt + 4 * 64 * LS;
  float* sTot = (float*)(sAtt + 64 * LS);
  bf16r* sO0 = sQt;
  const int tid = opaque(threadIdx.x), lane = tid & 63, wid = tid >> 6;
  const int tt = tid >> 3, j0 = (tid & 7) * 8;
  const int fr = lane & 15, fq = lane >> 4, rt = wid >> 1, ct = (wid & 1) * 2;
  const int t = c * 64 + tt;
  float q[8], b[8], k[8], v[8], tot[8];
  hgrn_load(p, l, t, h, j0, q, b, k, v);
  __syncthreads();
  cumsum_tokens(b, tot, sTot, lane, wid, j0);
  float P[4][8];
#pragma unroll
  for (int j = 0; j < 8; ++j) {
    float a0 = sTot[0 * 64 + j0 + j] + sTot[1 * 64 + j0 + j];
    float a1 = sTot[2 * 64 + j0 + j] + sTot[3 * 64 + j0 + j];
    float a2 = sTot[4 * 64 + j0 + j] + sTot[5 * 64 + j0 + j];
    P[0][j] = 0.f; P[1][j] = a0; P[2][j] = a0 + a1; P[3][j] = a0 + a1 + a2;
  }
  const int I = tt >> 4;
  bf16r* pr = (bf16r*)(wsp(p) + OFF_PROJ) + (size_t)t * PD + HGRN_B + h * 64 + j0;
  {
    float qd[8], qt[8], kh[8];
#pragma unroll
    for (int j = 0; j < 8; ++j) {
      float pi = (I == 0) ? P[0][j] : (I == 1 ? P[1][j] : (I == 2 ? P[2][j] : P[3][j]));
      qd[j] = q[j] * __expf(b[j]);
      qt[j] = q[j] * __expf(b[j] - pi);
      kh[j] = k[j] * __expf(tot[j] - b[j]);
    }
    *(uint4*)(sKT + tt * LS + j0) = pack8(kh);
    *(uint4*)(sVT + tt * LS + j0) = pack8(v);
    { const uint4 pk = pack8(qd);
      *(uint2*)(pr - j0 + permdk(j0)) = uint2{pk.x, pk.y};
      *(uint2*)(pr - j0 + permdk(j0 + 4)) = uint2{pk.z, pk.w}; }
    *(uint4*)(sQt + tt * LS + j0) = pack8(qt);
#pragma unroll
    for (int ii = 0; ii < 4; ++ii) {
      if (ii >= I) {
        float kt[8];
#pragma unroll
        for (int j = 0; j < 8; ++j) kt[j] = k[j] * __expf(fminf(P[ii][j] - b[j], 80.f));
        *(uint4*)(sKt + ii * 64 * LS + tt * LS + j0) = pack8(kt);
      }
    }
    if (tt == 63) {
      float* gam = (float*)(wsp(p) + OFF_GAM) + ((size_t)h * CH + cl) * 64;
#pragma unroll
      for (int j = 0; j < 8; ++j) gam[j0 + j] = __expf(tot[j]);
    }
  }
  __syncthreads();
  {
    f32x4 a0 = {0.f, 0.f, 0.f, 0.f}, a1 = {0.f, 0.f, 0.f, 0.f};
    if (ct <= rt) mm64(sQt, sKt + rt * 64 * LS, lane, wid, a0, a1);
#pragma unroll
    for (int j = 0; j < 4; ++j) {
      int row = rt * 16 + fq * 4 + j;
      int col0 = ct * 16 + fr, col1 = col0 + 16;
      float x0 = (col0 <= row && ct <= rt) ? a0[j] : 0.f;
      float x1 = (col1 <= row && ct + 1 <= rt) ? a1[j] : 0.f;
      sAtt[row * LS + col0] = f2bf(x0);
      sAtt[row * LS + col1] = f2bf(x1);
    }
    f32x4 n0 = {0.f, 0.f, 0.f, 0.f}, n1 = {0.f, 0.f, 0.f, 0.f};
    mm64t<true, true>(sKT, sVT, lane, wid, n0, n1);
    bf16r* nb = (bf16r*)(wsp(p) + OFF_NBUF) + ((size_t)(16 + h) * CH + cl) * 4096;
    store_nacc(nb, lane, wid, n0, n1);
  }
  __syncthreads();
  if (nhh >= 0) touch_prep(p, nc, nhh, tid, ta, tb);
  {
    f32x4 o0 = {0.f, 0.f, 0.f, 0.f}, o1 = {0.f, 0.f, 0.f, 0.f};
    mm64t<false, true>(sAtt, sVT, lane, wid, o0, o1);
#pragma unroll
    for (int j = 0; j < 4; ++j) {
      int row = rt * 16 + fq * 4 + j;
      sO0[row * LS + ct * 16 + fr] = f2bf(o0[j]);
      sO0[row * LS + (ct + 1) * 16 + fr] = f2bf(o1[j]);
    }
  }
  __syncthreads();
  *(uint4*)(pr + 1024) = *(const uint4*)(sO0 + tt * LS + j0);
  asm volatile("" ::"v"(ta), "v"(tb));
}

__device__ void hgrn_output(const Params& p, int l, int c, int cl, int h, unsigned char* smem) {
  bf16r* sP = (bf16r*)smem;
  bf16r* sHT = sP + 64 * LS;
  float* sO = (float*)(sHT + 64 * LS);
  const int tid = opaque(threadIdx.x), lane = tid & 63, wid = tid >> 6;
  const int tt = tid >> 3, j0 = (tid & 7) * 8;
  const int fr = lane & 15, fq = lane >> 4, rt = wid >> 1, ct = (wid & 1) * 2;
  const int t = c * 64 + tt;
  bf16r* pr = (bf16r*)(wsp(p) + OFF_PROJ) + (size_t)t * PD + HGRN_B + h * 64 + j0;
  const uint4 p_raw = *(const uint4*)(pr);
  const uint4 o0_raw = *(const uint4*)(pr + 1024);
  const uint4 ht_raw = *(const uint4*)((const bf16r*)(wsp(p) + OFF_HTBUF) + ((size_t)(16 + h) * CH + cl) * 4096 + tt * 64 + j0);
  __syncthreads();
  *(uint4*)(sP + tt * LS + j0) = p_raw;
  *(uint4*)(sHT + tt * LS + j0) = ht_raw;
  __syncthreads();
  {
    f32x4 c0 = {0.f, 0.f, 0.f, 0.f}, c1 = {0.f, 0.f, 0.f, 0.f};
    mm64(sP, sHT, lane, wid, c0, c1);
#pragma unroll
    for (int j = 0; j < 4; ++j) {
      int row = rt * 16 + fq * 4 + j;
      sO[row * FS + ct * 16 + fr] = c0[j];
      sO[row * FS + (ct + 1) * 16 + fr] = c1[j];
    }
  }
  __syncthreads();
  {
    float o8[8], a8[8];
    unpack8(o0_raw, a8);
#pragma unroll
    for (int j = 0; j < 8; ++j) o8[j] = sO[tt * FS + j0 + j] + a8[j];
    *(uint4*)(pr) = pack8(o8);
  }
}

template <int CTRL> __device__ __forceinline__ float quad_bcast(float v) {
  return __int_as_float(__builtin_amdgcn_update_dpp(__float_as_int(v), __float_as_int(v), CTRL, 0xf, 0xf, false));
}
constexpr int SAS = 68;
template <int J0, int PF>
__device__ __forceinline__ void tri_solve_part(const float* abase, f32x2_t (&x2)[8], f32x4 (&ab)[PF + 1][4]) {
#pragma unroll
  for (int jj = 0; jj < 16; ++jj) {
    const int j = J0 + jj;
    if (j + PF < 64) {
#pragma unroll
      for (int m4 = ((j + PF) >> 4); m4 < 4; ++m4) ab[(j + PF) % (PF + 1)][m4] = *(const f32x4*)(abase + (j + PF) * SAS + m4 * 4);
    }
    __builtin_amdgcn_sched_barrier(0);
    float xj;
    const float xs = (((j >> 2) & 1) == 0) ? x2[j >> 3][0] : x2[j >> 3][1];
    if ((j & 3) == 0) xj = quad_bcast<0x00>(xs);
    else if ((j & 3) == 1) xj = quad_bcast<0x55>(xs);
    else if ((j & 3) == 2) xj = quad_bcast<0xAA>(xs);
    else xj = quad_bcast<0xFF>(xs);
    const f32x2_t xj2 = {xj, xj};
#pragma unroll
    for (int m4 = (j >> 4); m4 < 4; ++m4) {
      const f32x4 a = ab[j % (PF + 1)][m4];
      if (m4 * 4 + 1 >= (j >> 2)) x2[m4 * 2 + 0] = x2[m4 * 2 + 0] - f32x2_t{a[0], a[1]} * xj2;
      if (m4 * 4 + 3 >= (j >> 2)) x2[m4 * 2 + 1] = x2[m4 * 2 + 1] - f32x2_t{a[2], a[3]} * xj2;
    }
  }
}
__device__ __forceinline__ void tri_solve(const float* sAT, int r, float* x) {
  constexpr int PF = 3;
  f32x2_t x2[8];
#pragma unroll
  for (int k = 0; k < 8; ++k) x2[k] = f32x2_t{x[2 * k], x[2 * k + 1]};
  f32x4 ab[PF + 1][4];
  const float* abase = sAT + r * 16;
#pragma unroll
  for (int j = 0; j < PF; ++j) {
#pragma unroll
    for (int m4 = (j >> 4); m4 < 4; ++m4) ab[j % (PF + 1)][m4] = *(const f32x4*)(abase + j * SAS + m4 * 4);
  }
  __builtin_amdgcn_sched_barrier(0);
  tri_solve_part<0, PF>(abase, x2, ab);
  tri_solve_part<16, PF>(abase, x2, ab);
  tri_solve_part<32, PF>(abase, x2, ab);
  tri_solve_part<48, PF>(abase, x2, ab);
#pragma unroll
  for (int k = 0; k < 8; ++k) { x[2 * k] = x2[k][0]; x[2 * k + 1] = x2[k][1]; }
}

__device__ __forceinline__ void gdn_load(const Params& p, int l, int t, int h, int j0, float* cq, float* ck, float* cv,
                                         float& beta, float& g) {
  const bf16r* proj = (const bf16r*)(wsp(p) + OFF_PROJ);
  const float* gsc = (const float*)(wsp(p) + OFF_GSC);
#pragma unroll
  for (int j = 0; j < 8; ++j) { cq[j] = 0.f; ck[j] = 0.f; cv[j] = 0.f; }
  const float* cw = p.conv_w + (size_t)l * 4 * 1536 + h * 64 + j0;
#pragma unroll
  for (int i = 0; i < 4; ++i) {
    int ts = t - 3 + i;
    if (ts >= 0) {
      float fq_[8], fk_[8], fv_[8];
      const int cs = t & ~63;
      const bf16r* pr = (ts >= cs) ? (proj + (size_t)ts * PD + h * 64 + j0)
                                   : ((const bf16r*)(wsp(p) + OFF_HALO2) + ((size_t)((cs >> 6) - 1) * 3 + (ts - cs + 3)) * 1536 + h * 64 + j0);
      unpack8(*(const uint4*)(pr), fq_);
      unpack8(*(const uint4*)(pr + 512), fk_);
      unpack8(*(const uint4*)(pr + 1024), fv_);
#pragma unroll
      for (int j = 0; j < 8; ++j) {
        cq[j] += cw[i * 1536 + j] * fq_[j];
        ck[j] += cw[i * 1536 + 512 + j] * fk_[j];
        cv[j] += cw[i * 1536 + 1024 + j] * fv_[j];
      }
    }
  }
  float sq = 0.f, sk = 0.f;
#pragma unroll
  for (int j = 0; j < 8; ++j) {
    cq[j] = siluf_(cq[j]); ck[j] = siluf_(ck[j]); cv[j] = siluf_(cv[j]);
    sq += cq[j] * cq[j]; sk += ck[j] * ck[j];
  }
  sq = red8(sq); sk = red8(sk);
  float nq = rsqrtf(sq + 1e-6f) * 0.125f, nk = rsqrtf(sk + 1e-6f);
#pragma unroll
  for (int j = 0; j < 8; ++j) { cq[j] *= nq; ck[j] *= nk; }
  beta = sigmoidf_(gsc[t * 16 + h]);
  g = -__expf(p.a_log[l * 8 + h]) * softplusf_(gsc[t * 16 + 8 + h] + p.dt_bias[l * 8 + h]);
}

__device__ __forceinline__ void cumsum_scalar(float g, float* sG, int tt, int js, float& gc, float& gtot) {
  if (js == 0) sG[tt] = g;
  __syncthreads();
  if (threadIdx.x < 64) {
    float v = sG[threadIdx.x];
#pragma unroll
    for (int d = 1; d < 64; d <<= 1) {
      float x = __shfl_up(v, d);
      if ((int)threadIdx.x >= d) v += x;
    }
    sG[64 + threadIdx.x] = v;
  }
  __syncthreads();
  gc = sG[64 + tt];
  gtot = sG[64 + 63];
}

__device__ void gdn_prep(const Params& p, int l, int c, int cl, int h, unsigned char* smem, int nc, int nhh) {
  unsigned ta = 0u, tb = 0u;
  bf16r* sK = (bf16r*)smem;
  bf16r* sKdT = sK + 64 * LS;
  bf16r* sXT = sKdT + 64 * LS;
  bf16r* sQ = sXT + 128 * LS;
  bf16r* sAtt = sQ + 64 * LS;
  float* sAT = (float*)(sAtt + 64 * LS);
  float* sR = sAT + 64 * SAS;
  float* sQdF = sR + 64 * 136;
  float* sG = sQdF + 64 * FS;
  float* sGc = sG + 64;
  float* sBeta = sGc + 64;
  bf16r* sM = sQ;
  bf16r* sP = (bf16r*)sR;
  bf16r* sO0 = sP + 64 * LS;
  const int tid = opaque(threadIdx.x), lane = tid & 63, wid = tid >> 6;
  const int tt = tid >> 3, js = tid & 7, j0 = js * 8;
  const int fr = lane & 15, fq = lane >> 4, rt = wid >> 1, ct = (wid & 1) * 2;
  const int t = c * 64 + tt;
  float q[8], k[8], v[8], beta, g, gc, gtot;
  gdn_load(p, l, t, h, j0, q, k, v, beta, g);
  __syncthreads();
  cumsum_scalar(g, sG, tt, js, gc, gtot);
  {
    if (js == 0) { sGc[tt] = gc; sBeta[tt] = beta; }
    *(uint4*)(sK + tt * LS + j0) = pack8(k);
    *(uint4*)(sQ + tt * LS + j0) = pack8(q);
    const float egc = __expf(gc), ekd = __expf(gtot - gc);
    float kd[8];
#pragma unroll
    for (int j = 0; j < 8; ++j) {
      kd[j] = k[j] * ekd;
      sR[tt * 136 + j0 + j] = beta * v[j];
      sR[tt * 136 + 64 + j0 + j] = beta * k[j] * egc;
      sQdF[tt * FS + j0 + j] = q[j] * egc;
    }
    *(uint4*)(sKdT + tt * LS + j0) = pack8(kd);
  }
  __syncthreads();
  {
    f32x4 a0 = {0.f, 0.f, 0.f, 0.f}, a1 = {0.f, 0.f, 0.f, 0.f};
    f32x4 b0 = {0.f, 0.f, 0.f, 0.f}, b1 = {0.f, 0.f, 0.f, 0.f};
    mm64(sK, sK, lane, wid, a0, a1);
    mm64(sQ, sK, lane, wid, b0, b1);
#pragma unroll
    for (int j = 0; j < 4; ++j) {
      int row = rt * 16 + fq * 4 + j;
      float br_ = sBeta[row], gr = sGc[row];
      int c0i = ct * 16 + fr, c1i = c0i + 16;
      float e0 = __expf(fminf(gr - sGc[c0i], 0.f)), e1 = __expf(fminf(gr - sGc[c1i], 0.f));
      sAT[c0i * SAS + (row & 3) * 16 + (row >> 2)] = (c0i < row) ? br_ * a0[j] * e0 : 0.f;
      sAT[c1i * SAS + (row & 3) * 16 + (row >> 2)] = (c1i < row) ? br_ * a1[j] * e1 : 0.f;
      sAtt[row * LS + c0i] = f2bf((c0i <= row) ? b0[j] * e0 : 0.f);
      sAtt[row * LS + c1i] = f2bf((c1i <= row) ? b1[j] * e1 : 0.f);
    }
  }
  __syncthreads();
  if (nhh >= 0) touch_prep(p, nc, nhh, tid, ta, tb);
  {
    const int col = tid >> 2, r = tid & 3;
    float x[16];
#pragma unroll
    for (int m = 0; m < 16; ++m) x[m] = sR[(4 * m + r) * 136 + col];
    tri_solve(sAT, r, x);
#pragma unroll
    for (int m = 0; m < 16; ++m) sXT[col * LS + 4 * m + r] = f2bf(x[m]);
  }
  __syncthreads();
  {
    f32x4 n0 = {0.f, 0.f, 0.f, 0.f}, n1 = {0.f, 0.f, 0.f, 0.f}, w0 = {0.f, 0.f, 0.f, 0.f}, w1 = {0.f, 0.f, 0.f, 0.f};
    f32x4 p0 = {0.f, 0.f, 0.f, 0.f}, p1 = {0.f, 0.f, 0.f, 0.f}, o0 = {0.f, 0.f, 0.f, 0.f}, o1 = {0.f, 0.f, 0.f, 0.f};
    mm64t<true, false>(sKdT, sXT, lane, wid, n0, n1);
    mm64t<true, false>(sKdT, sXT + 64 * LS, lane, wid, w0, w1);
    mm64(sAtt, sXT + 64 * LS, lane, wid, p0, p1);
    mm64(sAtt, sXT, lane, wid, o0, o1);
    bf16r* nb = (bf16r*)(wsp(p) + OFF_NBUF) + ((size_t)h * CH + cl) * 4096;
    store_nacc(nb, lane, wid, n0, n1);
    const float eg = __expf(gtot);
#pragma unroll
    for (int j = 0; j < 4; ++j) {
      int row = rt * 16 + fq * 4 + j;
      int c0i = ct * 16 + fr, c1i = c0i + 16;
      sM[row * LS + c0i] = f2bf((row == c0i ? eg : 0.f) - w0[j]);
      sM[row * LS + c1i] = f2bf((row == c1i ? eg : 0.f) - w1[j]);
      sP[row * LS + permdk(c0i)] = f2bf(sQdF[row * FS + c0i] - p0[j]);
      sP[row * LS + permdk(c1i)] = f2bf(sQdF[row * FS + c1i] - p1[j]);
      sO0[row * LS + c0i] = f2bf(o0[j]);
      sO0[row * LS + c1i] = f2bf(o1[j]);
    }
  }
  __syncthreads();
  {
    const int fi = tid >> 6, s2 = fi & 1, rtm = fi >> 1;
    const int row = rtm * 16 + fr;
    uint2 lo = *(const uint2*)(sM + row * LS + (2 * s2) * 16 + fq * 4);
    uint2 hi = *(const uint2*)(sM + row * LS + (2 * s2 + 1) * 16 + fq * 4);
    bf16r* mb = (bf16r*)(wsp(p) + OFF_MBUF) + ((size_t)h * CH + cl) * 4096;
    *(uint4*)(mb + (fi * 64 + lane) * 8) = uint4{lo.x, lo.y, hi.x, hi.y};
    bf16r* pr = (bf16r*)(wsp(p) + OFF_PROJ) + (size_t)t * PD + h * 64 + j0;
    *(uint4*)(pr) = *(const uint4*)(sP + tt * LS + j0);
    *(uint4*)(pr + 1024) = *(const uint4*)(sO0 + tt * LS + j0);
  }
  asm volatile("" ::"v"(ta), "v"(tb));
}

__device__ void gdn_output(const Params& p, int l, int c, int cl, int h, unsigned char* smem) {
  bf16r* sP = (bf16r*)smem;
  bf16r* sHT = sP + 64 * LS;
  float* sO = (float*)(sHT + 64 * LS);
  const int tid = opaque(threadIdx.x), lane = tid & 63, wid = tid >> 6;
  const int tt = tid >> 3, js = tid & 7, j0 = js * 8;
  const int fr = lane & 15, fq = lane >> 4, rt = wid >> 1, ct = (wid & 1) * 2;
  const int t = c * 64 + tt;
  bf16r* pr = (bf16r*)(wsp(p) + OFF_PROJ) + (size_t)t * PD + h * 64 + j0;
  const uint4 p_raw = *(const uint4*)(pr);
  const uint4 o0_raw = *(const uint4*)(pr + 1024);
  const uint4 ht_raw = *(const uint4*)((const bf16r*)(wsp(p) + OFF_HTBUF) + ((size_t)h * CH + cl) * 4096 + tt * 64 + j0);
  bf16r* gp = pr + GDN_GATE;
  const uint4 gate_raw = *(const uint4*)gp;
  __syncthreads();
  *(uint4*)(sP + tt * LS + j0) = p_raw;
  *(uint4*)(sHT + tt * LS + j0) = ht_raw;
  __syncthreads();
  {
    f32x4 c0 = {0.f, 0.f, 0.f, 0.f}, c1 = {0.f, 0.f, 0.f, 0.f};
    mm64(sP, sHT, lane, wid, c0, c1);
#pragma unroll
    for (int j = 0; j < 4; ++j) {
      int row = rt * 16 + fq * 4 + j;
      sO[row * FS + ct * 16 + fr] = c0[j];
      sO[row * FS + (ct + 1) * 16 + fr] = c1[j];
    }
  }
  __syncthreads();
  {
    float o8[8], a8[8], g8[8], y8[8], ss = 0.f;
    unpack8(o0_raw, a8);
    unpack8(gate_raw, g8);
#pragma unroll
    for (int j = 0; j < 8; ++j) { o8[j] = sO[tt * FS + j0 + j] + a8[j]; ss += o8[j] * o8[j]; }
    ss = red8(ss);
    float rs = rsqrtf(ss * (1.f / 64.f) + 1e-6f);
#pragma unroll
    for (int j = 0; j < 8; ++j) y8[j] = o8[j] * rs * p.gdn_norm_w[l * 64 + j0 + j] * siluf_(g8[j]);
    *(uint4*)gp = pack8(y8);
  }
}

__device__ __forceinline__ float tanh_fast(float x) { return 1.f - 2.f * __builtin_amdgcn_rcpf(1.f + __expf(2.f * x)); }
__device__ __forceinline__ void rwkv_load(const Params& p, int l, int c, int tt, int h, int j0, unsigned char* smem,
                                          float* r8, float* k8, float* v8, float* kk8, float* ic8, float* lw8) {
  bf16r* tA1 = (bf16r*)smem;
  bf16r* tA2 = tA1 + 64 * LS;
  bf16r* tB1 = tA2 + 64 * LS;
  bf16r* tB2 = tB1 + 64 * LS;
  float* res1 = (float*)(tB2 + 64 * LS);
  float* res2 = res1 + 4096;
  const bf16r* proj = (const bf16r*)(wsp(p) + OFF_PROJ);
  const bf16r* halo = (const bf16r*)(wsp(p) + OFF_HALO);
  const bf16r* lora = (const bf16r*)(wsp(p) + OFF_LORA);
  const int t = c * 64 + tt;
  const int tid = tt * 8 + (j0 >> 3), lane = tid & 63, wid = tid >> 6;
  const float* mu = p.mu + (size_t)l * 2176;
  const bf16r* pc = proj + (size_t)t * PD + RWKV_B;
  const bf16r* pp = (tt == 0) ? (halo + (size_t)(c - 1) * 2176) : (pc - PD);
  const bool hasprev = (t > 0);
  const int ch0 = h * 64 + j0;
  {
    float wd[8], ad[8];
    shifted8(pc, pp, mu, hasprev, 1536 + j0, wd);
    shifted8(pc, pp, mu, hasprev, 1600 + j0, ad);
#pragma unroll
    for (int j = 0; j < 8; ++j) wd[j] = tanh_fast(wd[j]);
    *(uint4*)(tA1 + tt * LS + j0) = pack8(wd);
    *(uint4*)(tA2 + tt * LS + j0) = pack8(ad);
    *(uint4*)(tB1 + tt * LS + j0) = *(const uint4*)(lora + (size_t)(h * 64 + tt) * 64 + j0);
    *(uint4*)(tB2 + tt * LS + j0) = *(const uint4*)(lora + (size_t)(512 + h * 64 + tt) * 64 + j0);
  }
  shifted8(pc, pp, mu, hasprev, ch0, r8);
  shifted8(pc, pp, mu, hasprev, 512 + ch0, k8);
  shifted8(pc, pp, mu, hasprev, 1024 + ch0, v8);
  __syncthreads();
  {
    f32x4 a0 = {0.f, 0.f, 0.f, 0.f}, a1 = {0.f, 0.f, 0.f, 0.f}, b0 = {0.f, 0.f, 0.f, 0.f}, b1 = {0.f, 0.f, 0.f, 0.f};
    mm64(tA1, tB1, lane, wid, a0, a1);
    mm64(tA2, tB2, lane, wid, b0, b1);
    const int fr = lane & 15, fq = lane >> 4, rt = wid >> 1, ct = (wid & 1) * 2;
#pragma unroll
    for (int j = 0; j < 4; ++j) {
      int row = rt * 16 + fq * 4 + j;
      res1[row * 64 + ct * 16 + fr] = a0[j];
      res1[row * 64 + (ct + 1) * 16 + fr] = a1[j];
      res2[row * 64 + ct * 16 + fr] = b0[j];
      res2[row * 64 + (ct + 1) * 16 + fr] = b1[j];
    }
  }
  __syncthreads();
  float aw[8], aa[8];
#pragma unroll
  for (int j = 0; j < 8; ++j) {
    aw[j] = p.w0[l * 512 + ch0 + j] + res1[tt * 64 + j0 + j];
    aa[j] = p.a0[l * 512 + ch0 + j] + res2[tt * 64 + j0 + j];
  }
  float ssk = 0.f;
#pragma unroll
  for (int j = 0; j < 8; ++j) { kk8[j] = k8[j] * p.k_k[l * 512 + ch0 + j]; ssk += kk8[j] * kk8[j]; }
  ssk = red8(ssk);
  const float nk = rsqrtf(ssk + 1e-6f);
#pragma unroll
  for (int j = 0; j < 8; ++j) {
    float w_raw = -softplusf_(-aw[j]) - 0.5f;
    lw8[j] = -__expf(w_raw);
    ic8[j] = sigmoidf_(aa[j]);
    kk8[j] *= nk;
    k8[j] = k8[j] * (1.f + (ic8[j] - 1.f) * p.k_a[l * 512 + ch0 + j]);
  }
}

__device__ void rwkv_prep(const Params& p, int l, int c, int cl, int h, unsigned char* smem, int nc, int nhh) {
  unsigned ta = 0u, tb = 0u;
  bf16r* sAt = (bf16r*)smem;
  bf16r* sRt = sAt + 64 * LS;
  bf16r* sBK = sRt + 64 * LS;
  bf16r* sVT = sBK + 128 * LS;
  bf16r* sBhT = sVT + 64 * LS;
  bf16r* sKhT = sBhT + 64 * LS;
  bf16r* sMak = sKhT + 64 * LS;
  bf16r* sMrb = sMak + 64 * LS;
  bf16r* sMrk = sMrb + 64 * LS;
  float* sAT = (float*)(sMrk + 64 * LS);
  float* sR = sAT + 64 * SAS;
  float* sTot = sR + 64 * FS;
  bf16r* sXT = sBK;
  bf16r* sM = sMak;
  bf16r* sP = (bf16r*)sAT;
  bf16r* sO0 = (bf16r*)sR;
  const int tid = opaque(threadIdx.x), lane = tid & 63, wid = tid >> 6;
  const int tt = tid >> 3, js = tid & 7, j0 = js * 8;
  const int fr = lane & 15, fq = lane >> 4, rt = wid >> 1, ct = (wid & 1) * 2;
  const int t = c * 64 + tt;
  float r8[8], k8[8], v8[8], kk8[8], ic8[8], lc[8], tot[8];
  __syncthreads();
  rwkv_load(p, l, c, tt, h, j0, smem, r8, k8, v8, kk8, ic8, lc);
  float lw[8];
#pragma unroll
  for (int j = 0; j < 8; ++j) lw[j] = lc[j];
  cumsum_tokens(lc, tot, sTot, lane, wid, j0);
  uint4 v_pk;
  {
    float at[8], rt_[8], bt[8], kt[8], bh[8], kh[8], bs = 0.f;
#pragma unroll
    for (int j = 0; j < 8; ++j) {
      float eil = __expf(-lc[j]), ekd = __expf(tot[j] - lc[j]);
      at[j] = -kk8[j] * __expf(lc[j] - lw[j]);
      rt_[j] = r8[j] * __expf(lc[j]);
      float b = kk8[j] * ic8[j];
      bt[j] = b * eil;
      kt[j] = k8[j] * eil;
      bs += r8[j] * k8[j] * p.r_k[l * 512 + h * 64 + j0 + j];
      bh[j] = b * ekd;
      kh[j] = k8[j] * ekd;
    }
    bs = red8(bs);
    if (js == 0) ((float*)(wsp(p) + OFF_BON))[t * 8 + h] = bs;
    v_pk = pack8(v8);
    *(uint4*)(sVT + tt * LS + j0) = v_pk;
    *(uint4*)(sBhT + tt * LS + j0) = pack8(bh);
    *(uint4*)(sKhT + tt * LS + j0) = pack8(kh);
    *(uint4*)(sAt + tt * LS + j0) = pack8(at);
    *(uint4*)(sRt + tt * LS + j0) = pack8(rt_);
    *(uint4*)(sBK + tt * LS + j0) = pack8(bt);
    *(uint4*)(sBK + (64 + tt) * LS + j0) = pack8(kt);
  }
  __syncthreads();
  {
    f32x4 a0 = {0.f, 0.f, 0.f, 0.f}, a1 = {0.f, 0.f, 0.f, 0.f}, b0 = {0.f, 0.f, 0.f, 0.f}, b1 = {0.f, 0.f, 0.f, 0.f};
    f32x4 e0 = {0.f, 0.f, 0.f, 0.f}, e1 = {0.f, 0.f, 0.f, 0.f}, f0 = {0.f, 0.f, 0.f, 0.f}, f1 = {0.f, 0.f, 0.f, 0.f};
    mm64(sAt, sBK, lane, wid, a0, a1);
    mm64(sAt, sBK + 64 * LS, lane, wid, b0, b1);
    mm64(sRt, sBK, lane, wid, e0, e1);
    mm64(sRt, sBK + 64 * LS, lane, wid, f0, f1);
#pragma unroll
    for (int j = 0; j < 4; ++j) {
      int row = rt * 16 + fq * 4 + j;
      int c0i = ct * 16 + fr, c1i = c0i + 16;
      sAT[c0i * SAS + (row & 3) * 16 + (row >> 2)] = (c0i < row) ? -a0[j] : 0.f;
      sAT[c1i * SAS + (row & 3) * 16 + (row >> 2)] = (c1i < row) ? -a1[j] : 0.f;
      sMak[row * LS + c0i] = f2bf((c0i < row) ? b0[j] : 0.f);
      sMak[row * LS + c1i] = f2bf((c1i < row) ? b1[j] : 0.f);
      sMrb[row * LS + c0i] = f2bf((c0i <= row) ? e0[j] : 0.f);
      sMrb[row * LS + c1i] = f2bf((c1i <= row) ? e1[j] : 0.f);
      sMrk[row * LS + c0i] = f2bf((c0i <= row) ? f0[j] : 0.f);
      sMrk[row * LS + c1i] = f2bf((c1i <= row) ? f1[j] : 0.f);
    }
  }
  __syncthreads();
  {
    f32x4 y0 = {0.f, 0.f, 0.f, 0.f}, y1 = {0.f, 0.f, 0.f, 0.f};
    mm64t<false, true>(sMak, sVT, lane, wid, y0, y1);
#pragma unroll
    for (int j = 0; j < 4; ++j) {
      int row = rt * 16 + fq * 4 + j;
      sR[row * FS + ct * 16 + fr] = y0[j];
      sR[row * FS + (ct + 1) * 16 + fr] = y1[j];
    }
  }
  __syncthreads();
  if (nhh >= 0) touch_prep(p, nc, nhh, tid, ta, tb);
  {
    const int col = tid >> 2, r = tid & 3;
    float x[16];
    if (col < 64) {
#pragma unroll
      for (int m = 0; m < 16; ++m) x[m] = sR[(4 * m + r) * FS + col];
    } else {
#pragma unroll
      for (int m = 0; m < 16; ++m) x[m] = bf2f(sAt[(4 * m + r) * LS + (col - 64)]);
    }
    tri_solve(sAT, r, x);
#pragma unroll
    for (int m = 0; m < 16; ++m) sXT[col * LS + 4 * m + r] = f2bf(x[m]);
  }
  __syncthreads();
  {
    f32x4 n0 = {0.f, 0.f, 0.f, 0.f}, n1 = {0.f, 0.f, 0.f, 0.f}, w0 = {0.f, 0.f, 0.f, 0.f}, w1 = {0.f, 0.f, 0.f, 0.f};
    f32x4 p0 = {0.f, 0.f, 0.f, 0.f}, p1 = {0.f, 0.f, 0.f, 0.f}, o0 = {0.f, 0.f, 0.f, 0.f}, o1 = {0.f, 0.f, 0.f, 0.f};
    mm64t<true, false>(sBhT, sXT, lane, wid, n0, n1);
    mm64t<true, true>(sKhT, sVT, lane, wid, n0, n1);
    mm64t<true, false>(sBhT, sXT + 64 * LS, lane, wid, w0, w1);
    mm64(sMrb, sXT + 64 * LS, lane, wid, p0, p1);
    mm64(sMrb, sXT, lane, wid, o0, o1);
    mm64t<false, true>(sMrk, sVT, lane, wid, o0, o1);
    bf16r* nb = (bf16r*)(wsp(p) + OFF_NBUF) + ((size_t)(8 + h) * CH + cl) * 4096;
    store_nacc(nb, lane, wid, n0, n1);
#pragma unroll
    for (int j = 0; j < 4; ++j) {
      int row = rt * 16 + fq * 4 + j;
      int c0i = ct * 16 + fr, c1i = c0i + 16;
      float gt = 0.f;
#pragma unroll
      for (int w = 0; w < 8; ++w) gt += sTot[w * 64 + row];
      float eg = __expf(gt);
      sM[row * LS + c0i] = f2bf((row == c0i ? eg : 0.f) + w0[j]);
      sM[row * LS + c1i] = f2bf((row == c1i ? eg : 0.f) + w1[j]);
      sP[row * LS + permdk(c0i)] = f2bf(bf2f(sRt[row * LS + c0i]) + p0[j]);
      sP[row * LS + permdk(c1i)] = f2bf(bf2f(sRt[row * LS + c1i]) + p1[j]);
      sO0[row * LS + c0i] = f2bf(o0[j]);
      sO0[row * LS + c1i] = f2bf(o1[j]);
    }
  }
  __syncthreads();
  {
    const int fi = tid >> 6, s2 = fi & 1, rtm = fi >> 1;
    const int row = rtm * 16 + fr;
    uint2 lo = *(const uint2*)(sM + row * LS + (2 * s2) * 16 + fq * 4);
    uint2 hi = *(const uint2*)(sM + row * LS + (2 * s2 + 1) * 16 + fq * 4);
    bf16r* mb = (bf16r*)(wsp(p) + OFF_MBUF) + ((size_t)(8 + h) * CH + cl) * 4096;
    *(uint4*)(mb + (fi * 64 + lane) * 8) = uint4{lo.x, lo.y, hi.x, hi.y};
    bf16r* pr = (bf16r*)(wsp(p) + OFF_PROJ) + (size_t)t * PD + RWKV_B + h * 64 + j0;
    *(uint4*)(pr) = *(const uint4*)(sP + tt * LS + j0);
    *(uint4*)(pr + 512) = *(const uint4*)(sO0 + tt * LS + j0);
    *(uint4*)(pr + 1024) = v_pk;
  }
  asm volatile("" ::"v"(ta), "v"(tb));
}

__device__ void rwkv_output(const Params& p, int l, int c, int cl, int h, unsigned char* smem) {
  bf16r* sP = (bf16r*)smem;
  bf16r* sHT = sP + 64 * LS;
  float* sO = (float*)(sHT + 64 * LS);
  const int tid = opaque(threadIdx.x), lane = tid & 63, wid = tid >> 6;
  const int tt = tid >> 3, js = tid & 7, j0 = js * 8;
  const int fr = lane & 15, fq = lane >> 4, rt = wid >> 1, ct = (wid & 1) * 2;
  const int t = c * 64 + tt;
  const int ch0 = h * 64 + j0;
  bf16r* pr = (bf16r*)(wsp(p) + OFF_PROJ) + (size_t)t * PD + RWKV_B + ch0;
  const uint4 p_raw = *(const uint4*)(pr);
  const uint4 o0_raw = *(const uint4*)(pr + 512);
  const uint4 v_raw = *(const uint4*)(pr + 1024);
  const uint4 ht_raw = *(const uint4*)((const bf16r*)(wsp(p) + OFF_HTBUF) + ((size_t)(8 + h) * CH + cl) * 4096 + tt * 64 + j0);
  bf16r* gp = pr + 1664;
  const uint4 gate_cur = *(const uint4*)gp;
  uint4 gate_prv = uint4{0u, 0u, 0u, 0u};
  if (t > 0) gate_prv = (tt == 0) ? *(const uint4*)((const bf16r*)(wsp(p) + OFF_HALO) + (size_t)(c - 1) * 2176 + 1664 + ch0) : *(const uint4*)(gp - PD);
  const float bs = ((const float*)(wsp(p) + OFF_BON))[t * 8 + h];
  __syncthreads();
  *(uint4*)(sP + tt * LS + j0) = p_raw;
  *(uint4*)(sHT + tt * LS + j0) = ht_raw;
  __syncthreads();
  {
    f32x4 c0 = {0.f, 0.f, 0.f, 0.f}, c1 = {0.f, 0.f, 0.f, 0.f};
    mm64(sP, sHT, lane, wid, c0, c1);
#pragma unroll
    for (int j = 0; j < 4; ++j) {
      int row = rt * 16 + fq * 4 + j;
      sO[row * FS + ct * 16 + fr] = c0[j];
      sO[row * FS + (ct + 1) * 16 + fr] = c1[j];
    }
  }
  __syncthreads();
  {
    float o8[8], a8[8], v8[8], cur[8], prv[8], y8[8], sm = 0.f;
    unpack8(o0_raw, a8);
    unpack8(v_raw, v8);
    unpack8(gate_cur, cur);
    unpack8(gate_prv, prv);
#pragma unroll
    for (int j = 0; j < 8; ++j) { o8[j] = sO[tt * FS + j0 + j] + a8[j]; sm += o8[j]; }
    sm = red8(sm);
    const float mean = sm * (1.f / 64.f);
    float sv = 0.f;
#pragma unroll
    for (int j = 0; j < 8; ++j) { float d = o8[j] - mean; sv += d * d; }
    sv = red8(sv);
    const float rs = rsqrtf(sv * (1.f / 64.f) + 64e-5f);
    const float* mu = p.mu + (size_t)l * 2176;
#pragma unroll
    for (int j = 0; j < 8; ++j) {
      float gt = cur[j] + mu[1664 + ch0 + j] * (prv[j] - cur[j]);
      float on = (o8[j] - mean) * rs * p.ln_w[l * 512 + ch0 + j] + p.ln_b[l * 512 + ch0 + j];
      on += bs * v8[j];
      y8[j] = on * siluf_(gt);
    }
    *(uint4*)gp = pack8(y8);
  }
}

__device__ void scan_phase(const Params& p, int seg, int head, int ns, int lane_) {
  const int lane = opaque(lane_);
  const int fr = lane & 15, fq = lane >> 4;
  const int br = head >> 3;
  f32x4 acc[4];
  float* hst = (float*)(wsp(p) + OFF_HSTATE) + ((size_t)head * 4 + ns) * 1024;
  if (seg == 0) {
#pragma unroll
    for (int rt = 0; rt < 4; ++rt) acc[rt] = f32x4{0.f, 0.f, 0.f, 0.f};
  } else {
#pragma unroll
    for (int rt = 0; rt < 4; ++rt) acc[rt] = *(const f32x4*)(hst + (rt * 64 + lane) * 4);
  }
  const bf16r* nbase = (const bf16r*)(wsp(p) + OFF_NBUF) + (size_t)head * CH * 4096 + (ns * 64 + lane) * 16;
  bf16r* htbase = (bf16r*)(wsp(p) + OFF_HTBUF) + (size_t)head * CH * 4096 + (ns * 16 + fr) * 64 + fq * 8;
  constexpr int PFD = 4;
  if (br == 2) {
    const float* gbase = (const float*)(wsp(p) + OFF_GAM) + (size_t)(head - 16) * CH * 64 + fq * 4;
    uint2 n[PFD][4];
    f32x4 g[PFD][4];
#pragma unroll
    for (int k = 0; k < PFD; ++k)
#pragma unroll
      for (int rt = 0; rt < 4; ++rt) {
        n[k][rt] = *(const uint2*)(nbase + (size_t)k * 4096 + rt * 4);
        g[k][rt] = *(const f32x4*)(gbase + k * 64 + rt * 16);
      }
#pragma unroll 1
    for (int cl = 0; cl < CH; cl += PFD) {
#pragma unroll
      for (int k = 0; k < PFD; ++k) {
        const int cc = cl + k;
        if (cc >= CH) break;
        uint2 hv[4];
#pragma unroll
        for (int rt = 0; rt < 4; ++rt) {
          hv[rt].x = cvt_pk_bf16(acc[rt][0], acc[rt][1]);
          hv[rt].y = cvt_pk_bf16(acc[rt][2], acc[rt][3]);
          const f32x4 nf = {__uint_as_float(n[k][rt].x << 16), __uint_as_float(n[k][rt].x & 0xffff0000u),
                            __uint_as_float(n[k][rt].y << 16), __uint_as_float(n[k][rt].y & 0xffff0000u)};
          acc[rt] = acc[rt] * g[k][rt] + nf;
        }
        *(uint4*)(htbase + (size_t)cc * 4096) = uint4{hv[0].x, hv[0].y, hv[1].x, hv[1].y};
        *(uint4*)(htbase + (size_t)cc * 4096 + 32) = uint4{hv[2].x, hv[2].y, hv[3].x, hv[3].y};
        const int cn = (cc + PFD < CH) ? cc + PFD : CH - 1;
#pragma unroll
        for (int rt = 0; rt < 4; ++rt) {
          n[k][rt] = *(const uint2*)(nbase + (size_t)cn * 4096 + rt * 4);
          g[k][rt] = *(const f32x4*)(gbase + cn * 64 + rt * 16);
        }
      }
    }
  } else {
    const bf16r* mbase = (const bf16r*)(wsp(p) + OFF_MBUF) + (size_t)head * CH * 4096 + lane * 8;
    uint2 n[PFD][4];
    bf16x8 m[PFD][8];
#pragma unroll
    for (int k = 0; k < PFD; ++k) {
      { const uint4 q0 = *(const uint4*)(nbase + (size_t)k * 4096), q1 = *(const uint4*)(nbase + (size_t)k * 4096 + 8);
        n[k][0] = uint2{q0.x, q0.y}; n[k][1] = uint2{q0.z, q0.w}; n[k][2] = uint2{q1.x, q1.y}; n[k][3] = uint2{q1.z, q1.w}; }
#pragma unroll
      for (int i = 0; i < 8; ++i) m[k][i] = *(const bf16x8*)(mbase + (size_t)k * 4096 + i * 512);
    }
#pragma unroll 1
    for (int cl = 0; cl < CH; cl += PFD) {
#pragma unroll
      for (int k = 0; k < PFD; ++k) {
        const int cc = cl + k;
        if (cc >= CH) break;
        uint4 b0u, b1u;
        b0u.x = cvt_pk_bf16(acc[0][0], acc[0][1]);
        b0u.y = cvt_pk_bf16(acc[0][2], acc[0][3]);
        b0u.z = cvt_pk_bf16(acc[1][0], acc[1][1]);
        b0u.w = cvt_pk_bf16(acc[1][2], acc[1][3]);
        b1u.x = cvt_pk_bf16(acc[2][0], acc[2][1]);
        b1u.y = cvt_pk_bf16(acc[2][2], acc[2][3]);
        b1u.z = cvt_pk_bf16(acc[3][0], acc[3][1]);
        b1u.w = cvt_pk_bf16(acc[3][2], acc[3][3]);
        bf16x8 b0 = *(bf16x8*)&b0u, b1 = *(bf16x8*)&b1u;
#pragma unroll
        for (int rt = 0; rt < 4; ++rt) {
          const f32x4 nf = {__uint_as_float(n[k][rt].x << 16), __uint_as_float(n[k][rt].x & 0xffff0000u),
                            __uint_as_float(n[k][rt].y << 16), __uint_as_float(n[k][rt].y & 0xffff0000u)};
          f32x4 a = __builtin_amdgcn_mfma_f32_16x16x32_bf16(m[k][rt * 2], b0, nf, 0, 0, 0);
          acc[rt] = __builtin_amdgcn_mfma_f32_16x16x32_bf16(m[k][rt * 2 + 1], b1, a, 0, 0, 0);
        }
        *(uint4*)(htbase + (size_t)cc * 4096) = b0u;
        *(uint4*)(htbase + (size_t)cc * 4096 + 32) = b1u;
        const int cn = (cc + PFD < CH) ? cc + PFD : CH - 1;
        { const uint4 q0 = *(const uint4*)(nbase + (size_t)cn * 4096), q1 = *(const uint4*)(nbase + (size_t)cn * 4096 + 8);
          n[k][0] = uint2{q0.x, q0.y}; n[k][1] = uint2{q0.z, q0.w}; n[k][2] = uint2{q1.x, q1.y}; n[k][3] = uint2{q1.z, q1.w}; }
#pragma unroll
        for (int i = 0; i < 8; ++i) m[k][i] = *(const bf16x8*)(mbase + (size_t)cn * 4096 + i * 512);
      }
    }
  }
#pragma unroll
  for (int rt = 0; rt < 4; ++rt) *(f32x4*)(hst + (rt * 64 + lane) * 4) = acc[rt];
}

__device__ void final_norm_phase(const Params& p) {
  const int tid_ = opaque(threadIdx.x);
  const int lane = tid_ & 63;
  const int gw = blockIdx.x * (NTHR / 64) + (tid_ >> 6);
  const int nw = gridDim.x * (NTHR / 64);
  for (int row = gw; row < T; row += nw) {
    float4* xr = (float4*)(p.out + (size_t)row * DM);
    float4 v[4];
    float ss = 0.f;
#pragma unroll
    for (int i = 0; i < 4; ++i) {
      v[i] = xr[lane + 64 * i];
      ss += v[i].x * v[i].x + v[i].y * v[i].y + v[i].z * v[i].z + v[i].w * v[i].w;
    }
    ss = red64(ss);
    float rs = rsqrtf(ss * (1.f / DM) + 1e-6f);
#pragma unroll
    for (int i = 0; i < 4; ++i) {
      float4 ww = ((const float4*)p.final_norm_w)[lane + 64 * i];
      float4 o;
      o.x = v[i].x * rs * ww.x; o.y = v[i].y * rs * ww.y; o.z = v[i].z * rs * ww.z; o.w = v[i].w * rs * ww.w;
      xr[lane + 64 * i] = o;
    }
  }
}

#define XB_TMO      128
#define XB_XCNT(j)  (256  + 64 * (j))
#define XB_XSUB(j)  (1280 + 64 * (j))
#define XB_XGEN(j)  (2304 + 64 * (j))
#define XB_TOP      3328
#define XB_TOPGEN   3392
#define XCD_BAR_WORDS 3456
#define XB_SPIN_CAP (1u << 18)
#define LAS __attribute__((address_space(3)))
__device__ __forceinline__ unsigned xb_ld(unsigned* p)              { return __hip_atomic_load(p, __ATOMIC_RELAXED, __HIP_MEMORY_SCOPE_AGENT); }
__device__ __forceinline__ unsigned xb_add(unsigned* p, unsigned v) { return __hip_atomic_fetch_add(p, v, __ATOMIC_RELAXED, __HIP_MEMORY_SCOPE_AGENT); }
__device__ __forceinline__ unsigned xb_xcc_id() { return (unsigned)__builtin_amdgcn_s_getreg((3 << 11) | 20) & 0xFu; }
#define XB_SPIN(cond, bar) do { unsigned _sp = 0; while (cond) { __builtin_amdgcn_s_sleep(1); \
    if ((++_sp & 255u) == 0u) { if (xb_ld(&(bar)[XB_TMO])) break; if (_sp > XB_SPIN_CAP) { atomicAdd(&(bar)[XB_TMO], 1u); break; } } } } while (0)
struct XcdBarrier { unsigned* bar; unsigned x; volatile LAS unsigned* st; };
__device__ __forceinline__ XcdBarrier xcd_barrier_post(unsigned* bar, volatile LAS unsigned* st) {
  XcdBarrier b; b.bar = bar; b.x = xb_xcc_id(); b.st = st;
  if (threadIdx.x == 0) (void)xb_add(&bar[XB_XCNT(b.x)], 1u);
  return b;
}
__device__ __forceinline__ void xcd_barrier_complete(unsigned* bar, unsigned x, unsigned& nloc, unsigned& nx) {
  const unsigned G = gridDim.x * gridDim.y * gridDim.z;
  unsigned sum, cnt, mine, sp = 0u;
  for (;;) {
    sum = 0u; cnt = 0u; mine = 0u;
#pragma unroll
    for (unsigned j = 0; j < 16; ++j) { const unsigned c = xb_ld(&bar[XB_XCNT(j)]); sum += c; cnt += (c > 0u) ? 1u : 0u; mine = (j == x) ? c : mine; }
    if (sum == G) break;
    __builtin_amdgcn_s_sleep(1);
    if ((++sp & 255u) == 0u) { if (xb_ld(&bar[XB_TMO])) break; if (sp > XB_SPIN_CAP) { atomicAdd(&bar[XB_TMO], 1u); break; } }
  }
  nloc = mine > 0u ? mine : 1u; nx = cnt > 0u ? cnt : 1u;
}
__device__ __forceinline__ void xcd_barrier(const XcdBarrier& b) {
  asm volatile("s_waitcnt vmcnt(0)" ::: "memory");
  __syncthreads();
  if (threadIdx.x == 0) {
    size_t zb = 0;
    asm volatile("" : "+s"(zb));
    unsigned* bar = b.bar + zb;
    __builtin_amdgcn_s_waitcnt(0);
    unsigned nloc = b.st[0], nx = b.st[1];
    if (nloc == 0u) { xcd_barrier_complete(bar, b.x, nloc, nx); b.st[0] = nloc; b.st[1] = nx; }
    const unsigned old = xb_add(&bar[XB_XSUB(b.x)], 1u);
    const unsigned gen = old / nloc;
    if (old + 1u == (gen + 1u) * nloc) {
      __builtin_amdgcn_fence(__ATOMIC_RELEASE, "agent");
      asm volatile("s_waitcnt vmcnt(0)" ::: "memory");
      const unsigned og = xb_add(&bar[XB_TOP], 1u);
      const unsigned tg = og / nx;
      if (og + 1u == (tg + 1u) * nx) xb_add(&bar[XB_TOPGEN], 1u);
      else XB_SPIN(xb_ld(&bar[XB_TOPGEN]) == tg, bar);
      __builtin_amdgcn_fence(__ATOMIC_ACQUIRE, "agent");
      xb_add(&bar[XB_XGEN(b.x)], 1u);
      asm volatile("s_waitcnt vmcnt(0)" ::: "memory");
    } else {
      XB_SPIN(xb_ld(&bar[XB_XGEN(b.x)]) == gen, bar);
      __builtin_amdgcn_fence(__ATOMIC_ACQUIRE, "agent");
      asm volatile("s_waitcnt vmcnt(0)" ::: "memory");
    }
  }
  __syncthreads();
}

__global__ void __launch_bounds__(NTHR) mega(Params p) {
  cg::grid_group grid = cg::this_grid();
  __shared__ __attribute__((aligned(16))) unsigned char smem[SMEM_BYTES];
  const int nb = gridDim.x, bid = blockIdx.x;
  __shared__ uint4 xb_words;
  if (threadIdx.x == 0) xb_words = make_uint4(0u, 0u, 0u, 0u);
  __syncthreads();
  XcdBarrier xb = xcd_barrier_post((unsigned*)(wsp(p) + OFF_BAR), (volatile LAS unsigned*)&xb_words);
  if (bid == 0) {
    float* lb = (float*)(wsp(p) + OFF_LB);
    int i = threadIdx.x;
    float b0 = p.lbnd[i], b1 = p.lbnd[512 + i];
    float m = fmaxf(b0, b1);
    float e0 = __expf(b0 - m), e1 = __expf(b1 - m);
    lb[i] = 0.f;
    lb[512 + i] = e1 / (e0 + e1);
  }
  grid.sync();
  for (int l = 0; l < 2; ++l) {
    const float* xin = (l == 0) ? p.x : p.out;
    if (l == 0) rows_bf16_rs(xin, (bf16r*)(wsp(p) + OFF_HBF), (float*)(wsp(p) + OFF_RS));
    else reduce_rs((const float*)(wsp(p) + OFF_SSP), (float*)(wsp(p) + OFF_RS));
    for (int tile = bid; tile < 1600 + 384; tile += nb) {
      if (tile < 1600) {
        int kt = tile & 15, ntile = tile >> 4;
        transpose_tile<true>(p.w_in + (size_t)l * DM * NCOL, (bf16r*)(wsp(p) + OFF_WIN), DM, NCOL, kt * 64, ntile * 64, smem, p.norm_w + l * DM);
      } else {
        int tt = tile - 1600;
        int kt = tt % 24, ntile = tt / 24;
        transpose_tile<false>(p.w_out + (size_t)l * DMIX * DM, (bf16r*)(wsp(p) + OFF_WOUT), DMIX, DM, kt * 64, ntile * 64, smem, nullptr);
      }
    }
    {
      bf16r* lora = (bf16r*)(wsp(p) + OFF_LORA);
      for (int e = bid * NTHR + opaque(threadIdx.x); e < 2 * 512 * 8; e += nb * NTHR) {
        int which = e >> 12, ch = (e >> 3) & 511, is = e & 7;
        const float* src = (which ? p.a_up : p.w_up) + (size_t)l * 64 * 512 + ch;
        float f[8];
#pragma unroll
        for (int j = 0; j < 8; ++j) f[j] = src[(is * 8 + j) * 512];
        *(uint4*)(lora + ((size_t)which * 512 + ch) * 64 + is * 8) = pack8(f);
      }
    }
    xcd_barrier(xb);
    {
      pg8::StaticOrder so; so.init(T, PDP, nb, bid);
      pg8::EpiProj ep{wsp(p)};
      __syncthreads();
      pg8::gemm_phase<1>((PG8_LAS unsigned char*)smem, (const bf16r*)(wsp(p) + OFF_HBF), (const bf16r*)(wsp(p) + OFF_WIN), T, PDP, so, ep);
      __syncthreads();
    }
    xcd_barrier(xb);
    for (int seg = 0; seg < NSEG; ++seg) {
      for (int it = bid; it < 24 * CH; it += nb) {
        int hh = it / CH, cl = it % CH;
        if (seg > 0) {
          if (hh < 8) gdn_output(p, l, (seg - 1) * CH + cl, cl, hh, smem);
          else if (hh < 16) rwkv_output(p, l, (seg - 1) * CH + cl, cl, hh - 8, smem);
          else hgrn_output(p, l, (seg - 1) * CH + cl, cl, hh - 16, smem);
        }
        const int it2 = it + nb;
        const int nhh = (it2 < 24 * CH) ? it2 / CH : -1, nc = seg * CH + (it2 % CH);
        if (hh < 8) gdn_prep(p, l, seg * CH + cl, cl, hh, smem, nc, nhh);
        else if (hh < 16) rwkv_prep(p, l, seg * CH + cl, cl, hh - 8, smem, nc, nhh);
        else hgrn_prep(p, l, seg * CH + cl, cl, hh - 16, smem, nc, nhh);
      }
      xcd_barrier(xb);
      if (threadIdx.x < 64 && bid < 96) scan_phase(p, seg, bid >> 2, bid & 3, threadIdx.x);
      xcd_barrier(xb);
    }
    for (int it = bid; it < 24 * CH; it += nb) {
      int hh = it / CH, cl = it % CH;
      if (hh < 8) gdn_output(p, l, (NSEG - 1) * CH + cl, cl, hh, smem);
      else if (hh < 16) rwkv_output(p, l, (NSEG - 1) * CH + cl, cl, hh - 8, smem);
      else hgrn_output(p, l, (NSEG - 1) * CH + cl, cl, hh - 16, smem);
    }
    xcd_barrier(xb);
    hgrn_norm_phase(p, l);
    xcd_barrier(xb);
    {
      pg8::StaticOrder so; so.init(T, DM, nb, bid);
      pg8::EpiResid er{xin, p.out, wsp(p), l == 0};
      __syncthreads();
      pg8::gemm_phase<2>((PG8_LAS unsigned char*)smem, (const bf16r*)(wsp(p) + OFF_PROJ), (const bf16r*)(wsp(p) + OFF_WOUT), T, DM, so, er);
      __syncthreads();
    }
    xcd_barrier(xb);
  }
  final_norm_phase(p);
}

extern "C" void kernel_launch(void* const* d_in, const int* in_sizes, int n_in,
                              void* d_out, int out_size, void* d_ws, size_t ws_size,
                              hipStream_t stream) {
  static int grid_blocks = 0;
  if (!grid_blocks) {
    int dev = 0, cus = 0, per_cu = 0;
    (void)hipGetDevice(&dev);
    (void)hipDeviceGetAttribute(&cus, hipDeviceAttributeMultiprocessorCount, dev);
    (void)hipOccupancyMaxActiveBlocksPerMultiprocessor(&per_cu, mega, NTHR, 0);
    if (per_cu > 1) per_cu = 1;
    if (per_cu < 1) per_cu = 1;
    grid_blocks = cus * per_cu;
  }
  Params p{};
  p.x = (const float*)d_in[0]; p.norm_w = (const float*)d_in[1]; p.w_in = (const float*)d_in[2];
  p.conv_w = (const float*)d_in[3]; p.a_log = (const float*)d_in[4]; p.dt_bias = (const float*)d_in[5];
  p.gdn_norm_w = (const float*)d_in[6]; p.mu = (const float*)d_in[7]; p.w0 = (const float*)d_in[8];
  p.w_up = (const float*)d_in[9]; p.a0 = (const float*)d_in[10]; p.a_up = (const float*)d_in[11];
  p.k_k = (const float*)d_in[12]; p.k_a = (const float*)d_in[13]; p.r_k = (const float*)d_in[14];
  p.ln_w = (const float*)d_in[15]; p.ln_b = (const float*)d_in[16]; p.lbnd = (const float*)d_in[17];
  p.hgrn_norm_w = (const float*)d_in[18]; p.w_out = (const float*)d_in[19]; p.final_norm_w = (const float*)d_in[20];
  p.out = (float*)d_out; p.ws = (unsigned char*)d_ws;
  (void)hipMemsetAsync((unsigned char*)d_ws + OFF_BAR, 0, 16384, stream);
  void* args[] = {&p};
  hipError_t e = hipLaunchCooperativeKernel((void*)mega, dim3(grid_blocks), dim3(NTHR), args, 0, stream);
  if (e != hipSuccess) fprintf(stderr, "coop launch failed: %s\n", hipGetErrorString(e));
}
```
